# Optimizing an MI355X kernel written in HIP

```python
import math
import jax, jax.numpy as jnp
from jax import lax
import numpy as np

D_MODEL = 1024
BATCH = 1
SEQ = 16384
DEPTH = 4

F32 = jnp.float32
N_MIXERS = 3
ROPE_THETA = 10000.0
LN_EPS = 1e-5
RMS_EPS = 1e-6
Q_BLOCK = 128
NEG = -1e30
ALPHA_DN = (2 * DEPTH) ** 0.25
BETA_DN = (8 * DEPTH) ** -0.25

DA_HEADS = 8
DA_HEAD_DIM = D_MODEL // (2 * DA_HEADS)
MLA_HEADS = 16
MLA_NOPE = 64
MLA_ROPE = 32
MLA_V = 64
MLA_Q_RANK = 256
MLA_KV_RANK = 128
NSA_HEADS = 16
NSA_GROUPS = 4
NSA_HEAD_DIM = 64
NSA_CMP_LEN = 32
NSA_CMP_STRIDE = 16
NSA_CMP_HIDDEN = 256
NSA_SLC_LEN = 64
NSA_SLC_TOPK = 16
NSA_WINDOW = 512
NSA_FORCE = 1e9
N_EXPERTS = 32
TOP_K = 4
D_EXPERT = 1024
SWIGLU_LIMIT = 7.0
SWIGLU_ALPHA = 1.702
MOE_BLOCK = 128

kernel_name = 'hybrid_diff_mla_nsa_moe_deepnorm'


def layer_norm(x, g, b):
    xf = x.astype(F32)
    mu = jnp.mean(xf, -1, keepdims=True)
    var = jnp.mean(jnp.square(xf - mu), -1, keepdims=True)
    return ((xf - mu) * lax.rsqrt(var + LN_EPS) * g.astype(F32) + b.astype(F32)).astype(x.dtype)


def rms_norm(x, g, eps):
    xf = x.astype(F32)
    return (xf * lax.rsqrt(jnp.mean(xf * xf, -1, keepdims=True) + eps) * g.astype(F32)).astype(x.dtype)


def rope_angles(pos, dim):
    inv = ROPE_THETA ** (-jnp.arange(0, dim, 2, dtype=F32) / dim)
    ang = pos.astype(F32)[:, None] * inv[None, :]
    return jnp.cos(ang), jnp.sin(ang)


def apply_rope(t, cos, sin):
    c = cos[None, :, None, :].astype(t.dtype)
    s = sin[None, :, None, :].astype(t.dtype)
    t1, t2 = jnp.split(t, 2, axis=-1)
    return jnp.concatenate([t1 * c - t2 * s, t2 * c + t1 * s], axis=-1)


def to_blocks(t):
    B, S = t.shape[:2]
    return jnp.moveaxis(t.reshape(B, S // Q_BLOCK, Q_BLOCK, *t.shape[2:]), 1, 0)


def from_blocks(t):
    nb, B, qb = t.shape[:3]
    return jnp.moveaxis(t, 0, 1).reshape(B, nb * qb, *t.shape[3:])


def causal_mask(bi, n_keys):
    qpos = bi * Q_BLOCK + jnp.arange(Q_BLOCK)
    return jnp.arange(n_keys)[None, :] <= qpos[:, None]


def diff_attention(x, w_in, lq1, lk1, lq2, lk2, subln_g, w_out, cos, sin, layer_idx):
    B, S, _ = x.shape
    H, d = DA_HEADS, DA_HEAD_DIM
    q, k, v = jnp.split(x @ w_in, 3, axis=-1)
    q = apply_rope(q.reshape(B, S, 2 * H, d), cos, sin)
    k = apply_rope(k.reshape(B, S, 2 * H, d), cos, sin)
    v = v.reshape(B, S, H, 2 * d)
    lam_init = 0.8 - 0.6 * math.exp(-0.3 * layer_idx)
    lam = (jnp.exp(jnp.sum(lq1.astype(F32) * lk1.astype(F32)))
           - jnp.exp(jnp.sum(lq2.astype(F32) * lk2.astype(F32))) + lam_init)
    scale = d ** -0.5

    def block(args):
        qi, bi = args
        s = jnp.einsum('bqhd,bkhd->bhqk', qi, k, preferred_element_type=F32) * scale
        s = jnp.where(causal_mask(bi, S), s, NEG)
        p = jax.nn.softmax(s, axis=-1).reshape(B, H, 2, Q_BLOCK, S)
        p = p[:, :, 0] - lam * p[:, :, 1]
        return jnp.einsum('bhqk,bkhe->bqhe', p.astype(v.dtype), v)

    o = from_blocks(lax.map(block, (to_blocks(q), jnp.arange(S // Q_BLOCK))))
    o = rms_norm(o, subln_g, LN_EPS) * (1.0 - lam_init)
    return o.reshape(B, S, H * 2 * d) @ w_out


def mla(x, w_in, q_norm_g, kv_norm_g, w_uq, w_ukv, w_out, cos, sin):
    B, S, _ = x.shape
    H = MLA_HEADS
    c_q, c_kv, k_rope = jnp.split(x @ w_in, [MLA_Q_RANK, MLA_Q_RANK + MLA_KV_RANK], axis=-1)
    q = (rms_norm(c_q, q_norm_g, RMS_EPS) @ w_uq).reshape(B, S, H, MLA_NOPE + MLA_ROPE)
    q_nope, q_rope = jnp.split(q, [MLA_NOPE], axis=-1)
    q_rope = apply_rope(q_rope, cos, sin)
    k_rope = apply_rope(k_rope[:, :, None, :], cos, sin)[:, :, 0]
    kv = (rms_norm(c_kv, kv_norm_g, RMS_EPS) @ w_ukv).reshape(B, S, H, MLA_NOPE + MLA_V)
    k_nope, v = jnp.split(kv, [MLA_NOPE], axis=-1)
    scale = (MLA_NOPE + MLA_ROPE) ** -0.5

    def block(args):
        qn, qr, bi = args
        s = (jnp.einsum('bqhd,bkhd->bhqk', qn, k_nope, preferred_element_type=F32)
             + jnp.einsum('bqhr,bkr->bhqk', qr, k_rope, preferred_element_type=F32)) * scale
        s = jnp.where(causal_mask(bi, S), s, NEG)
        p = jax.nn.softmax(s, axis=-1)
        return jnp.einsum('bhqk,bkhd->bqhd', p.astype(v.dtype), v)

    o = from_blocks(lax.map(block, (to_blocks(q_nope), to_blocks(q_rope), jnp.arange(S // Q_BLOCK))))
    return o.reshape(B, S, H * MLA_V) @ w_out


def nsa(x, w_in, pos_k, pos_v, ck_w1, ck_w2, cv_w1, cv_w2, w_out, cos, sin):
    B, S, _ = x.shape
    H, G, d = NSA_HEADS, NSA_GROUPS, NSA_HEAD_DIM
    R = H // G
    L, st, Ls, W = NSA_CMP_LEN, NSA_CMP_STRIDE, NSA_SLC_LEN, NSA_WINDOW
    n_cmp = (S - L) // st + 1
    n_slc = S // Ls
    n_top = min(NSA_SLC_TOPK, n_slc)
    ratio = Ls // st
    off = L // st - 1
    sizes = [H * d] + [G * d] * 6 + [3 * H]
    q, kc, vc, ks, vs, kw, vw, gl = jnp.split(x @ w_in, np.cumsum(sizes)[:-1].tolist(), axis=-1)
    q = apply_rope(q.reshape(B, S, H, d), cos, sin).reshape(B, S, G, R, d)
    ks = apply_rope(ks.reshape(B, S, G, d), cos, sin)
    kw = apply_rope(kw.reshape(B, S, G, d), cos, sin)
    vs = vs.reshape(B, S, G, d)
    vw = vw.reshape(B, S, G, d)
    gate = jax.nn.sigmoid(gl.astype(F32)).reshape(B, S, G, R, 3)

    blk_idx = jnp.arange(n_cmp)[:, None] * st + jnp.arange(L)[None, :]

    def compress(t, pos, w1, w2):
        tb = t.reshape(B, S, G, d)[:, blk_idx] + pos[:, None, :]
        tb = tb.transpose(0, 1, 3, 2, 4).reshape(B, n_cmp, G, L * d)
        return jax.nn.gelu(tb @ w1) @ w2

    cmp_end = jnp.arange(n_cmp) * st + L - 1
    cos_c, sin_c = rope_angles(cmp_end, d)
    k_cmp = apply_rope(compress(kc, pos_k, ck_w1, ck_w2), cos_c, sin_c)
    v_cmp = compress(vc, pos_v, cv_w1, cv_w2)

    ksT = ks.transpose(0, 2, 1, 3)
    vsT = vs.transpose(0, 2, 1, 3)
    kw_pad = jnp.pad(kw, ((0, 0), (W, 0), (0, 0), (0, 0)))
    vw_pad = jnp.pad(vw, ((0, 0), (W, 0), (0, 0), (0, 0)))
    b_ix = jnp.arange(B)[:, None, None, None]
    g_ix = jnp.arange(G)[None, :, None, None]
    scale = d ** -0.5
    back = ratio * n_slc - n_cmp
    jb = jnp.arange(n_slc)

    def block(args):
        qi, gi, bi = args
        qpos = bi * Q_BLOCK + jnp.arange(Q_BLOCK)
        s = jnp.einsum('bqgrd,bngd->bgrqn', qi, k_cmp, preferred_element_type=F32) * scale
        m_c = cmp_end[None, :] <= qpos[:, None]
        p_c = jax.nn.softmax(jnp.where(m_c, s, NEG), axis=-1) * jnp.any(m_c, -1).astype(F32)[:, None]
        o_c = jnp.einsum('bgrqn,bngd->bqgrd', p_c.astype(v_cmp.dtype), v_cmp)
        p_g = jnp.pad(p_c.sum(axis=2), ((0, 0), (0, 0), (0, 0), (off, back)))
        imp = jnp.zeros(p_g.shape[:3] + (n_slc,), F32)
        for mm in range(ratio):
            for nn in range(L // st):
                start = off + mm - nn
                imp = imp + lax.slice_in_dim(p_g, start, start + ratio * (n_slc - 1) + 1, stride=ratio, axis=-1)
        cur = qpos // Ls
        valid = jb[None, :] <= cur[:, None]
        forced = valid & ((jb[None, :] == 0) | (jb[None, :] >= cur[:, None] - 1))
        score = jnp.where(forced, NSA_FORCE, jnp.where(valid, imp, -1.0))
        _, sel = lax.top_k(score, n_top)
        tok = (sel[..., None] * Ls + jnp.arange(Ls)).reshape(B, G, Q_BLOCK, n_top * Ls)
        k_sel = ksT[b_ix, g_ix, tok]
        v_sel = vsT[b_ix, g_ix, tok]
        s = jnp.einsum('bqgrd,bgqtd->bgrqt', qi, k_sel, preferred_element_type=F32) * scale
        m_s = (tok <= qpos[None, None, :, None])[:, :, None]
        p_s = jax.nn.softmax(jnp.where(m_s, s, NEG), axis=-1)
        o_s = jnp.einsum('bgrqt,bgqtd->bqgrd', p_s.astype(v_sel.dtype), v_sel)
        k_w = lax.dynamic_slice_in_dim(kw_pad, bi * Q_BLOCK, W + Q_BLOCK, axis=1)
        v_w = lax.dynamic_slice_in_dim(vw_pad, bi * Q_BLOCK, W + Q_BLOCK, axis=1)
        kpos = bi * Q_BLOCK - W + jnp.arange(W + Q_BLOCK)
        m_w = ((kpos[None, :] <= qpos[:, None]) & (kpos[None, :] > qpos[:, None] - W)
               & (kpos[None, :] >= 0))
        s = jnp.einsum('bqgrd,bkgd->bgrqk', qi, k_w, preferred_element_type=F32) * scale
        p_w = jax.nn.softmax(jnp.where(m_w, s, NEG), axis=-1)
        o_w = jnp.einsum('bgrqk,bkgd->bqgrd', p_w.astype(v_w.dtype), v_w)
        o = gi[..., 0:1] * o_c + gi[..., 1:2] * o_s + gi[..., 2:3] * o_w
        return o.astype(qi.dtype)

    o = from_blocks(lax.map(block, (to_blocks(q), to_blocks(gate), jnp.arange(S // Q_BLOCK))))
    return o.reshape(B, S, H * d) @ w_out


def moe(x, w_router, b_router, w_gu, b_gu, w_down, b_down):
    B, S, Dm = x.shape
    N = B * S
    xt = x.reshape(N, Dm)
    logits = (xt @ w_router + b_router).astype(F32)
    top_logit, top_e = lax.top_k(logits, TOP_K)
    gate = jax.nn.softmax(top_logit, axis=-1)
    A = N * TOP_K
    e_flat = top_e.reshape(A)
    tok_flat = jnp.arange(A, dtype=jnp.int32) // TOP_K
    g_flat = gate.reshape(A)
    order = jnp.argsort(e_flat)
    e_sorted = e_flat[order]
    counts = jnp.zeros((N_EXPERTS,), jnp.int32).at[e_flat].add(1)
    starts = jnp.cumsum(counts) - counts
    padded = (counts + MOE_BLOCK - 1) // MOE_BLOCK * MOE_BLOCK
    pends = jnp.cumsum(padded)
    pstarts = pends - padded
    dest = pstarts[e_sorted] + (jnp.arange(A, dtype=jnp.int32) - starts[e_sorted])
    n_rows = (A + MOE_BLOCK - 1) // MOE_BLOCK * MOE_BLOCK + N_EXPERTS * MOE_BLOCK
    row_tok = jnp.full((n_rows,), N, jnp.int32).at[dest].set(tok_flat[order])
    row_gate = jnp.zeros((n_rows,), F32).at[dest].set(g_flat[order])
    nblk = n_rows // MOE_BLOCK
    blk_e = jnp.minimum(jnp.searchsorted(pends, jnp.arange(nblk, dtype=jnp.int32) * MOE_BLOCK, side='right'),
                        N_EXPERTS - 1)
    x_pad = jnp.concatenate([xt, jnp.zeros((1, Dm), xt.dtype)], axis=0)

    def expert_block(args):
        tok, e, gw = args
        hgu = x_pad[tok] @ w_gu[e] + b_gu[e]
        hg = jnp.minimum(hgu[:, 0::2], SWIGLU_LIMIT)
        hl = jnp.clip(hgu[:, 1::2], -SWIGLU_LIMIT, SWIGLU_LIMIT)
        act = hg * jax.nn.sigmoid(SWIGLU_ALPHA * hg) * (hl + 1.0)
        y = act @ w_down[e] + b_down[e]
        return y * gw[:, None].astype(y.dtype)

    y = lax.map(expert_block, (row_tok.reshape(nblk, MOE_BLOCK), blk_e, row_gate.reshape(nblk, MOE_BLOCK)))
    out = jnp.zeros((N + 1, Dm), y.dtype).at[row_tok].add(y.reshape(n_rows, Dm))
    return out[:N].reshape(B, S, Dm).astype(x.dtype)


def setup_inputs(seed: int = 0) -> dict:
    key = jax.random.key(seed)
    k = jax.random.split(key, 32)

    def nrm(i, shape, scale):
        return scale * jax.random.normal(k[i], shape, F32)

    nA = len(range(0, DEPTH, N_MIXERS))
    nB = len(range(1, DEPTH, N_MIXERS))
    nC = len(range(2, DEPTH, N_MIXERS))
    D = D_MODEL
    da_v = DA_HEADS * 2 * DA_HEAD_DIM
    mla_in = MLA_Q_RANK + MLA_KV_RANK + MLA_ROPE
    nsa_in = NSA_HEADS * NSA_HEAD_DIM + 6 * NSA_GROUPS * NSA_HEAD_DIM + 3 * NSA_HEADS
    cmp_in = NSA_CMP_LEN * NSA_HEAD_DIM
    return {
        'x': nrm(0, (BATCH, SEQ, D), 1.0),
        'da_w_in': nrm(1, (nA, D, 3 * da_v), D ** -0.5),
        'da_lambda_q1': nrm(2, (nA, DA_HEAD_DIM), 0.1),
        'da_lambda_k1': nrm(3, (nA, DA_HEAD_DIM), 0.1),
        'da_lambda_q2': nrm(4, (nA, DA_HEAD_DIM), 0.1),
        'da_lambda_k2': nrm(5, (nA, DA_HEAD_DIM), 0.1),
        'da_subln': 1.0 + nrm(6, (nA, 2 * DA_HEAD_DIM), 0.02),
        'da_w_out': nrm(7, (nA, da_v, D), BETA_DN * da_v ** -0.5),
        'mla_w_in': nrm(8, (nB, D, mla_in), D ** -0.5),
        'mla_q_norm': 1.0 + nrm(9, (nB, MLA_Q_RANK), 0.02),
        'mla_kv_norm': 1.0 + nrm(10, (nB, MLA_KV_RANK), 0.02),
        'mla_w_uq': nrm(11, (nB, MLA_Q_RANK, MLA_HEADS * (MLA_NOPE + MLA_ROPE)), MLA_Q_RANK ** -0.5),
        'mla_w_ukv': nrm(12, (nB, MLA_KV_RANK, MLA_HEADS * (MLA_NOPE + MLA_V)), MLA_KV_RANK ** -0.5),
        'mla_w_out': nrm(13, (nB, MLA_HEADS * MLA_V, D), BETA_DN * (MLA_HEADS * MLA_V) ** -0.5),
        'nsa_w_in': nrm(14, (nC, D, nsa_in), D ** -0.5),
        'nsa_cmp_pos_k': nrm(15, (nC, NSA_CMP_LEN, NSA_HEAD_DIM), 0.02),
        'nsa_cmp_pos_v': nrm(16, (nC, NSA_CMP_LEN, NSA_HEAD_DIM), 0.02),
        'nsa_cmp_k_w1': nrm(17, (nC, cmp_in, NSA_CMP_HIDDEN), cmp_in ** -0.5),
        'nsa_cmp_k_w2': nrm(18, (nC, NSA_CMP_HIDDEN, NSA_HEAD_DIM), NSA_CMP_HIDDEN ** -0.5),
        'nsa_cmp_v_w1': nrm(19, (nC, cmp_in, NSA_CMP_HIDDEN), cmp_in ** -0.5),
        'nsa_cmp_v_w2': nrm(20, (nC, NSA_CMP_HIDDEN, NSA_HEAD_DIM), NSA_CMP_HIDDEN ** -0.5),
        'nsa_w_out': nrm(21, (nC, NSA_HEADS * NSA_HEAD_DIM, D), BETA_DN * (NSA_HEADS * NSA_HEAD_DIM) ** -0.5),
        'ln1_g': 1.0 + nrm(22, (DEPTH, D), 0.02),
        'ln1_b': nrm(23, (DEPTH, D), 0.02),
        'ln2_g': 1.0 + nrm(24, (DEPTH, D), 0.02),
        'ln2_b': nrm(25, (DEPTH, D), 0.02),
        'moe_w_router': nrm(26, (DEPTH, D, N_EXPERTS), D ** -0.5),
        'moe_b_router': nrm(27, (DEPTH, N_EXPERTS), 0.01),
        'moe_w_gu': nrm(28, (DEPTH, N_EXPERTS, D, 2 * D_EXPERT), D ** -0.5),
        'moe_b_gu': nrm(29, (DEPTH, N_EXPERTS, 2 * D_EXPERT), 0.02),
        'moe_w_down': nrm(30, (DEPTH, N_EXPERTS, D_EXPERT, D), BETA_DN * D_EXPERT ** -0.5),
        'moe_b_down': nrm(31, (DEPTH, N_EXPERTS, D), 0.02),
    }


def reference(x, da_w_in, da_lambda_q1, da_lambda_k1, da_lambda_q2, da_lambda_k2, da_subln, da_w_out,
              mla_w_in, mla_q_norm, mla_kv_norm, mla_w_uq, mla_w_ukv, mla_w_out,
              nsa_w_in, nsa_cmp_pos_k, nsa_cmp_pos_v, nsa_cmp_k_w1, nsa_cmp_k_w2, nsa_cmp_v_w1,
              nsa_cmp_v_w2, nsa_w_out,
              ln1_g, ln1_b, ln2_g, ln2_b,
              moe_w_router, moe_b_router, moe_w_gu, moe_b_gu, moe_w_down, moe_b_down):
    S = x.shape[1]
    pos = jnp.arange(S)
    cos64, sin64 = rope_angles(pos, DA_HEAD_DIM)
    cos32, sin32 = rope_angles(pos, MLA_ROPE)
    h = x
    for i in range(DEPTH):
        m, j = i % N_MIXERS, i // N_MIXERS
        if m == 0:
            y = diff_attention(h, da_w_in[j], da_lambda_q1[j], da_lambda_k1[j], da_lambda_q2[j],
                               da_lambda_k2[j], da_subln[j], da_w_out[j], cos64, sin64, i)
        elif m == 1:
            y = mla(h, mla_w_in[j], mla_q_norm[j], mla_kv_norm[j], mla_w_uq[j], mla_w_ukv[j],
                    mla_w_out[j], cos32, sin32)
        else:
            y = nsa(h, nsa_w_in[j], nsa_cmp_pos_k[j], nsa_cmp_pos_v[j], nsa_cmp_k_w1[j],
                    nsa_cmp_k_w2[j], nsa_cmp_v_w1[j], nsa_cmp_v_w2[j], nsa_w_out[j], cos64, sin64)
        h = layer_norm(ALPHA_DN * h + y, ln1_g[i], ln1_b[i])
        y = moe(h, moe_w_router[i], moe_b_router[i], moe_w_gu[i], moe_b_gu[i], moe_w_down[i], moe_b_down[i])
        h = layer_norm(ALPHA_DN * h + y, ln2_g[i], ln2_b[i])
    return h
```

```cpp
#ifndef REP
#define REP 0
#endif
#include <hip/hip_runtime.h>
#include <cstdio>
#include <cstdint>
#include <cstring>
namespace pg8 {
#define PG8_LAS __attribute__((address_space(3)))
typedef unsigned short bf16_t;
typedef short bf16x8 __attribute__((ext_vector_type(8)));
typedef float f32x4 __attribute__((ext_vector_type(4)));
typedef int i32x4 __attribute__((ext_vector_type(4)));
typedef long i64x2 __attribute__((ext_vector_type(2)));
typedef unsigned u32x4 __attribute__((ext_vector_type(4)));
constexpr int BM = 256, BK = 64, HALF = 128, HTB = HALF * BK * 2  , STAGE_BYTES = 8 * HTB, NXCD = 8, WGM = 8;

__host__ __device__ __forceinline__ int lds_byte(int r, int c) { const int st = (r >> 4) * 2 + (c >> 5), rr = r & 15, cc = c & 31, ob = rr * 64 + cc * 2; return st * 1024 + (ob ^ (((ob >> 9) & 1) << 5)); }
__host__ __device__ __forceinline__ void stage_rc(int b, int& R, int& C) { const int st = b / 1024, sb = b % 1024, swz = sb ^ (((sb >> 9) & 1) << 5); R = (st >> 1) * 16 + swz / 64; C = (st & 1) * 32 + (swz % 64) / 2; }
__host__ __device__ __forceinline__ int perm32(int rho) { const int n = rho >> 4, i = rho & 15; return 8 * (i >> 2) + 4 * n + (i & 3); }

struct Unit { int pm, pn; };
struct Gemm { const bf16_t* A; const bf16_t* Bt; int M, N, K; const PG8_LAS unsigned short* gidx; int gtile0; };

struct StaticOrder {
    int nM, nN, nwg, G, c;
    __host__ __device__ void init(int M, int N, int G_, int c_) { nM = M / BM; nN = N / BM; nwg = nM * nN; G = G_; c = c_; }
    __host__ __device__ bool next(int i, Unit& u) const {
        long L = (long)i * G + c;
#if defined(REP) && ((REP >> 8) & 1)
        if (L >= 2 * nwg) return false; if (L >= nwg) L -= nwg;
#else
        if (L >= nwg) return false;
#endif
        int wgid = (int)L; { const int q = nwg / NXCD, r = nwg % NXCD, xcd = wgid % NXCD, off = wgid / NXCD; wgid = (xcd < r ? xcd * (q + 1) : r * (q + 1) + (xcd - r) * q) + off; }
        const int nig = WGM * nN, gid = wgid / nig, fm = gid * WGM, gsz = (nM - fm) < WGM ? (nM - fm) : WGM;
        u.pm = fm + ((wgid % nig) % gsz); u.pn = (wgid % nig) / gsz; return true;
    }
    __device__ __forceinline__ void a_ready(const Unit&) const {}
    __device__ __forceinline__ void done(const Unit&) const {}
};

__device__ __forceinline__ unsigned cvt_pk_bf16(float lo, float hi) { unsigned r; asm volatile("v_cvt_pk_bf16_f32 %0, %1, %2" : "=v"(r) : "v"(lo), "v"(hi)); return r; }
typedef float f32x2 __attribute__((ext_vector_type(2)));
typedef unsigned u32x2 __attribute__((ext_vector_type(2)));
struct __attribute__((aligned(8))) cs_t { float c, s; };
struct EpiBf16P {
    static constexpr bool PERM = true, AFTER_DRAIN = false, AMAX = false;
    bf16_t* O; int ldc; float scale;
    __device__ __forceinline__ void operator()(const f32x4 (&acc)[2][2][4][2], const Unit& u, int wr, int wc, int fr, int fq) const {
        const int row0 = u.pm * BM + wr * 64 + fr, col0 = u.pn * BM + wc * 32 + 8 * fq;
#pragma unroll
        for (int ai = 0; ai < 2; ++ai)
#pragma unroll
            for (int m = 0; m < 4; ++m) { bf16_t* rowp = O + (size_t)(row0 + ai * HALF + m * 16) * ldc + col0;
#pragma unroll
                for (int bj = 0; bj < 2; ++bj) { const f32x4 v0 = acc[ai][bj][m][0] * scale, v1 = acc[ai][bj][m][1] * scale;
                    u32x4 w; w.x = cvt_pk_bf16(v0[0], v0[1]); w.y = cvt_pk_bf16(v0[2], v0[3]); w.z = cvt_pk_bf16(v1[0], v1[1]); w.w = cvt_pk_bf16(v1[2], v1[3]);
                    *(u32x4*)(rowp + bj * HALF) = w; } }
    }
};
struct EpiResAdd {
    static constexpr bool PERM = true, AFTER_DRAIN = false, AMAX = false;
    bf16_t* O; const bf16_t* R; float alpha;
    __device__ __forceinline__ void operator()(const f32x4 (&acc)[2][2][4][2], const Unit& u, int wr, int wc, int fr, int fq) const {
        const int row0 = u.pm * BM + wr * 64 + fr, col0 = u.pn * BM + wc * 32 + 8 * fq;
#pragma unroll
        for (int ai = 0; ai < 2; ++ai)
#pragma unroll
            for (int m = 0; m < 4; ++m) { const size_t ro = (size_t)(row0 + ai * HALF + m * 16) * 1024 + col0;
#pragma unroll
                for (int bj = 0; bj < 2; ++bj) { const u32x4 r = *(const u32x4*)(R + ro + bj * HALF); const f32x4 a0 = acc[ai][bj][m][0], a1 = acc[ai][bj][m][1];
                    u32x4 w;
                    w.x = cvt_pk_bf16(alpha * __builtin_bit_cast(float, r.x << 16) + a0[0], alpha * __builtin_bit_cast(float, r.x & 0xffff0000u) + a0[1]);
                    w.y = cvt_pk_bf16(alpha * __builtin_bit_cast(float, r.y << 16) + a0[2], alpha * __builtin_bit_cast(float, r.y & 0xffff0000u) + a0[3]);
                    w.z = cvt_pk_bf16(alpha * __builtin_bit_cast(float, r.z << 16) + a1[0], alpha * __builtin_bit_cast(float, r.z & 0xffff0000u) + a1[1]);
                    w.w = cvt_pk_bf16(alpha * __builtin_bit_cast(float, r.w << 16) + a1[2], alpha * __builtin_bit_cast(float, r.w & 0xffff0000u) + a1[3]);
                    *(u32x4*)(O + ro + bj * HALF) = w; } }
    }
};
struct EpiHeadMajor64 {
    static constexpr bool PERM = true, AFTER_DRAIN = false, AMAX = true;
    bf16_t* O; int nrows; unsigned* amax;
    __device__ __forceinline__ void operator()(const f32x4 (&acc)[2][2][4][2], const Unit& u, int wr, int wc, int fr, int fq) const {
        const int row0 = u.pm * BM + wr * 64 + fr, col0 = u.pn * BM + wc * 32 + 8 * fq;
#pragma unroll
        for (int ai = 0; ai < 2; ++ai)
#pragma unroll
            for (int m = 0; m < 4; ++m) { const int row = row0 + ai * HALF + m * 16;
#pragma unroll
                for (int bj = 0; bj < 2; ++bj) { const int col = col0 + bj * HALF; const f32x4 v0 = acc[ai][bj][m][0], v1 = acc[ai][bj][m][1];
                    u32x4 w; w.x = cvt_pk_bf16(v0[0], v0[1]); w.y = cvt_pk_bf16(v0[2], v0[3]); w.z = cvt_pk_bf16(v1[0], v1[1]); w.w = cvt_pk_bf16(v1[2], v1[3]);
                    *(u32x4*)(O + ((size_t)(col >> 6) * nrows + row) * 64 + (col & 63)) = w; } }
    }
};
struct EpiVtTiled {
    static constexpr bool PERM = true, AFTER_DRAIN = false, AMAX = false;
    bf16_t* O; int dvshift; int ntok;
    __device__ __forceinline__ void operator()(const f32x4 (&acc)[2][2][4][2], const Unit& u, int wr, int wc, int fr, int fq) const {
        const int row0 = u.pm * BM + wr * 64 + fr, col0 = u.pn * BM + wc * 32 + 8 * fq; const int DVm = (1 << dvshift) - 1, nt = ntok >> 6;
#pragma unroll
        for (int ai = 0; ai < 2; ++ai)
#pragma unroll
            for (int m = 0; m < 4; ++m) { const int row = row0 + ai * HALF + m * 16; const int head = row >> dvshift, dv = row & DVm;
#pragma unroll
                for (int bj = 0; bj < 2; ++bj) { const int col = col0 + bj * HALF; const f32x4 v0 = acc[ai][bj][m][0], v1 = acc[ai][bj][m][1];
                    u32x4 w; w.x = cvt_pk_bf16(v0[0], v0[1]); w.y = cvt_pk_bf16(v0[2], v0[3]); w.z = cvt_pk_bf16(v1[0], v1[1]); w.w = cvt_pk_bf16(v1[2], v1[3]);
                    *(u32x4*)(O + ((((size_t)head * nt + (col >> 6)) << dvshift) + dv) * 64 + (col & 63)) = w; } }
    }
};
struct EpiF32 {
    static constexpr bool PERM = false, AFTER_DRAIN = false, AMAX = true;
    float* O; int ldc; unsigned* amax;
    __device__ __forceinline__ void operator()(const f32x4 (&acc)[2][2][4][2], const Unit& u, int wr, int wc, int fr, int fq) const {
        const int row0 = u.pm * BM + wr * 64 + fr, col0 = u.pn * BM + wc * 32 + 4 * fq;
#pragma unroll
        for (int ai = 0; ai < 2; ++ai)
#pragma unroll
            for (int m = 0; m < 4; ++m) { float* rowp = O + (size_t)(row0 + ai * HALF + m * 16) * ldc + col0;
#pragma unroll
                for (int bj = 0; bj < 2; ++bj)
#pragma unroll
                    for (int n = 0; n < 2; ++n) *(f32x4*)(rowp + bj * HALF + n * 16) = acc[ai][bj][m][n]; }
    }
};
struct EpiRope64 {
    static constexpr bool PERM = true, AFTER_DRAIN = false, AMAX = true;
    bf16_t* O; int ldc; const cs_t* cs; int nheads; int nq_tiles; float qscale; int posmask, posmul, posadd; int hm_from; bf16_t* Ohm; int hm_rows; unsigned* amax;
    __device__ __forceinline__ void operator()(const f32x4 (&acc)[2][2][4][2], const Unit& u, int wr, int wc, int fr, int fq) const {
        const int hv = 4 * u.pn + wc; if (hv >= nheads) return;
        const bool hm = hv >= hm_from;
        const float sc = (u.pn < nq_tiles) ? qscale : 1.0f;
        const int row0 = u.pm * BM + wr * 64 + fr, y0 = 8 * fq;
#pragma unroll
        for (int ai = 0; ai < 2; ++ai)
#pragma unroll
            for (int m = 0; m < 4; ++m) { const int row = row0 + ai * HALF + m * 16; const int pos = (row & posmask) * posmul + posadd;
                const f32x4* cp = (const f32x4*)(cs + (size_t)pos * 32 + y0);
                const f32x4 c0 = cp[0], c1 = cp[1], c2 = cp[2], c3 = cp[3];
                const f32x4 a0 = acc[ai][0][m][0], a1 = acc[ai][0][m][1], b0 = acc[ai][1][m][0], b1 = acc[ai][1][m][1];
                float o1[8], o2[8];
                o1[0] = a0[0] * c0[0] - b0[0] * c0[1]; o2[0] = b0[0] * c0[0] + a0[0] * c0[1];
                o1[1] = a0[1] * c0[2] - b0[1] * c0[3]; o2[1] = b0[1] * c0[2] + a0[1] * c0[3];
                o1[2] = a0[2] * c1[0] - b0[2] * c1[1]; o2[2] = b0[2] * c1[0] + a0[2] * c1[1];
                o1[3] = a0[3] * c1[2] - b0[3] * c1[3]; o2[3] = b0[3] * c1[2] + a0[3] * c1[3];
                o1[4] = a1[0] * c2[0] - b1[0] * c2[1]; o2[4] = b1[0] * c2[0] + a1[0] * c2[1];
                o1[5] = a1[1] * c2[2] - b1[1] * c2[3]; o2[5] = b1[1] * c2[2] + a1[1] * c2[3];
                o1[6] = a1[2] * c3[0] - b1[2] * c3[1]; o2[6] = b1[2] * c3[0] + a1[2] * c3[1];
                o1[7] = a1[3] * c3[2] - b1[3] * c3[3]; o2[7] = b1[3] * c3[2] + a1[3] * c3[3];
                bf16_t* rowp = hm ? (Ohm + ((size_t)(hv - hm_from) * hm_rows + row) * 64 + y0) : (O + (size_t)row * ldc + 64 * hv + y0);
                u32x4 w; w.x = cvt_pk_bf16(o1[0] * sc, o1[1] * sc); w.y = cvt_pk_bf16(o1[2] * sc, o1[3] * sc); w.z = cvt_pk_bf16(o1[4] * sc, o1[5] * sc); w.w = cvt_pk_bf16(o1[6] * sc, o1[7] * sc);
                *(u32x4*)rowp = w;
                w.x = cvt_pk_bf16(o2[0] * sc, o2[1] * sc); w.y = cvt_pk_bf16(o2[2] * sc, o2[3] * sc); w.z = cvt_pk_bf16(o2[4] * sc, o2[5] * sc); w.w = cvt_pk_bf16(o2[6] * sc, o2[7] * sc);
                *(u32x4*)(rowp + 32) = w; }
    }
};
struct EpiRope16 {
    static constexpr bool PERM = true, AFTER_DRAIN = false, AMAX = false;
    bf16_t* O; int ldc; const cs_t* cs; float qscale;
    __device__ __forceinline__ void operator()(const f32x4 (&acc)[2][2][4][2], const Unit& u, int wr, int wc, int fr, int fq) const {
        const int row0 = u.pm * BM + wr * 64 + fr; const float sc = qscale;
        const int head = 8 * u.pn + 2 * wc + (fq >> 1), y0 = 8 * (fq & 1);
#pragma unroll
        for (int ai = 0; ai < 2; ++ai)
#pragma unroll
            for (int m = 0; m < 4; ++m) { const int row = row0 + ai * HALF + m * 16;
                const f32x4* cp = (const f32x4*)(cs + (size_t)row * 16 + y0);
                const f32x4 c0 = cp[0], c1 = cp[1], c2 = cp[2], c3 = cp[3];
                const f32x4 a0 = acc[ai][0][m][0], a1 = acc[ai][0][m][1], b0 = acc[ai][1][m][0], b1 = acc[ai][1][m][1];
                float o1[8], o2[8];
                o1[0] = a0[0] * c0[0] - b0[0] * c0[1]; o2[0] = b0[0] * c0[0] + a0[0] * c0[1];
                o1[1] = a0[1] * c0[2] - b0[1] * c0[3]; o2[1] = b0[1] * c0[2] + a0[1] * c0[3];
                o1[2] = a0[2] * c1[0] - b0[2] * c1[1]; o2[2] = b0[2] * c1[0] + a0[2] * c1[1];
                o1[3] = a0[3] * c1[2] - b0[3] * c1[3]; o2[3] = b0[3] * c1[2] + a0[3] * c1[3];
                o1[4] = a1[0] * c2[0] - b1[0] * c2[1]; o2[4] = b1[0] * c2[0] + a1[0] * c2[1];
                o1[5] = a1[1] * c2[2] - b1[1] * c2[3]; o2[5] = b1[1] * c2[2] + a1[1] * c2[3];
                o1[6] = a1[2] * c3[0] - b1[2] * c3[1]; o2[6] = b1[2] * c3[0] + a1[2] * c3[1];
                o1[7] = a1[3] * c3[2] - b1[3] * c3[3]; o2[7] = b1[3] * c3[2] + a1[3] * c3[3];
                bf16_t* rowp = O + (size_t)row * ldc + 32 * head + y0;
                u32x4 w; w.x = cvt_pk_bf16(o1[0] * sc, o1[1] * sc); w.y = cvt_pk_bf16(o1[2] * sc, o1[3] * sc); w.z = cvt_pk_bf16(o1[4] * sc, o1[5] * sc); w.w = cvt_pk_bf16(o1[6] * sc, o1[7] * sc);
                *(u32x4*)rowp = w;
                w.x = cvt_pk_bf16(o2[0] * sc, o2[1] * sc); w.y = cvt_pk_bf16(o2[2] * sc, o2[3] * sc); w.z = cvt_pk_bf16(o2[4] * sc, o2[5] * sc); w.w = cvt_pk_bf16(o2[6] * sc, o2[7] * sc);
                *(u32x4*)(rowp + 16) = w; }
    }
};
__device__ __forceinline__ float gelu_tanh(float x) {
    const float u2 = 1.5957691216057308f * (x + 0.044715f * x * x * x);
    return x * __builtin_amdgcn_rcpf(1.0f + __builtin_amdgcn_exp2f(-1.4426950408889634f * u2));
}
struct EpiGeluBf16 {
    static constexpr bool PERM = true, AFTER_DRAIN = false, AMAX = false;
    bf16_t* O; int ldc;
    __device__ __forceinline__ void operator()(const f32x4 (&acc)[2][2][4][2], const Unit& u, int wr, int wc, int fr, int fq) const {
        const int row0 = u.pm * BM + wr * 64 + fr, col0 = u.pn * BM + wc * 32 + 8 * fq;
#pragma unroll
        for (int ai = 0; ai < 2; ++ai)
#pragma unroll
            for (int m = 0; m < 4; ++m) { bf16_t* rowp = O + (size_t)(row0 + ai * HALF + m * 16) * ldc + col0;
#pragma unroll
                for (int bj = 0; bj < 2; ++bj) { const f32x4 v0 = acc[ai][bj][m][0], v1 = acc[ai][bj][m][1];
                    u32x4 w; w.x = cvt_pk_bf16(gelu_tanh(v0[0]), gelu_tanh(v0[1])); w.y = cvt_pk_bf16(gelu_tanh(v0[2]), gelu_tanh(v0[3]));
                    w.z = cvt_pk_bf16(gelu_tanh(v1[0]), gelu_tanh(v1[1])); w.w = cvt_pk_bf16(gelu_tanh(v1[2]), gelu_tanh(v1[3]));
                    *(u32x4*)(rowp + bj * HALF) = w; } }
    }
};
__device__ __forceinline__ float swiglu1(float g, float l) {
    const float hg = fminf(g, 7.0f), hl = fminf(fmaxf(l, -7.0f), 7.0f);
    return hg * __builtin_amdgcn_rcpf(1.0f + __builtin_amdgcn_exp2f(-1.702f * 1.4426950408889634f * hg)) * (hl + 1.0f);
}
struct EpiSwiglu {
    static constexpr bool PERM = true, AFTER_DRAIN = false, AMAX = false;
    bf16_t* O; const float* bgu; float ws; unsigned char* O8;
    __device__ __forceinline__ void operator()(const f32x4 (&acc)[2][2][4][2], const Unit& u, int wr, int wc, int fr, int fq) const {
        const int e = u.pn >> 3, pnl = u.pn & 7;
        const int row0 = u.pm * BM + wr * 64 + fr, f0 = pnl * 128 + wc * 32 + 8 * fq;
        const f32x4* bp = (const f32x4*)(bgu + (size_t)e * 2048 + 2 * f0);
        const f32x4 q0 = bp[0], q1 = bp[1], q2 = bp[2], q3 = bp[3];
#pragma unroll
        for (int ai = 0; ai < 2; ++ai)
#pragma unroll
            for (int m = 0; m < 4; ++m) { bf16_t* rowp = O + (size_t)(row0 + ai * HALF + m * 16) * 1024 + f0;
                const f32x4 g0 = acc[ai][0][m][0] * ws, g1 = acc[ai][0][m][1] * ws, l0 = acc[ai][1][m][0] * ws, l1 = acc[ai][1][m][1] * ws;
                u32x4 w;
                w.x = cvt_pk_bf16(swiglu1(g0[0] + q0[0], l0[0] + q0[1]), swiglu1(g0[1] + q0[2], l0[1] + q0[3]));
                w.y = cvt_pk_bf16(swiglu1(g0[2] + q1[0], l0[2] + q1[1]), swiglu1(g0[3] + q1[2], l0[3] + q1[3]));
                w.z = cvt_pk_bf16(swiglu1(g1[0] + q2[0], l1[0] + q2[1]), swiglu1(g1[1] + q2[2], l1[1] + q2[3]));
                w.w = cvt_pk_bf16(swiglu1(g1[2] + q3[0], l1[2] + q3[1]), swiglu1(g1[3] + q3[2], l1[3] + q3[3]));
                if (O8 == nullptr) *(u32x4*)rowp = w;
                else { int p0_ = __builtin_amdgcn_cvt_pk_fp8_f32(__builtin_bit_cast(float, w.x << 16), __builtin_bit_cast(float, w.x & 0xffff0000u), 0, false);
                    p0_ = __builtin_amdgcn_cvt_pk_fp8_f32(__builtin_bit_cast(float, w.y << 16), __builtin_bit_cast(float, w.y & 0xffff0000u), p0_, true);
                    int p1_ = __builtin_amdgcn_cvt_pk_fp8_f32(__builtin_bit_cast(float, w.z << 16), __builtin_bit_cast(float, w.z & 0xffff0000u), 0, false);
                    p1_ = __builtin_amdgcn_cvt_pk_fp8_f32(__builtin_bit_cast(float, w.w << 16), __builtin_bit_cast(float, w.w & 0xffff0000u), p1_, true);
                    *(u32x2*)(O8 + (size_t)(row0 + ai * HALF + m * 16) * 1024 + f0) = (u32x2){(unsigned)p0_, (unsigned)p1_}; } }
    }
};
struct EpiDown {
    static constexpr bool PERM = true, AFTER_DRAIN = false, AMAX = false;
    bf16_t* O; const float* bd; const float* rgate; unsigned char* O8; float ws;
    __device__ __forceinline__ void operator()(const f32x4 (&acc)[2][2][4][2], const Unit& u, int wr, int wc, int fr, int fq) const {
        const int e = u.pn >> 2, pnl = u.pn & 3;
        const int row0 = u.pm * BM + wr * 64 + fr, col0 = pnl * BM + wc * 32 + 8 * fq;
        f32x4 bv[2][2];
#pragma unroll
        for (int bj = 0; bj < 2; ++bj)
#pragma unroll
            for (int n = 0; n < 2; ++n) bv[bj][n] = *(const f32x4*)(bd + (size_t)e * 1024 + col0 + bj * HALF + 4 * n);
#pragma unroll
        for (int ai = 0; ai < 2; ++ai)
#pragma unroll
            for (int m = 0; m < 4; ++m) { const int row = row0 + ai * HALF + m * 16; const float gw = rgate[row]; bf16_t* rowp = O + (size_t)row * 1024 + col0;
#pragma unroll
                for (int bj = 0; bj < 2; ++bj) { const f32x4 v0 = (acc[ai][bj][m][0] * ws + bv[bj][0]) * gw, v1 = (acc[ai][bj][m][1] * ws + bv[bj][1]) * gw;
                    if (O8 == nullptr) { u32x4 w; w.x = cvt_pk_bf16(v0[0], v0[1]); w.y = cvt_pk_bf16(v0[2], v0[3]); w.z = cvt_pk_bf16(v1[0], v1[1]); w.w = cvt_pk_bf16(v1[2], v1[3]);
                    *(u32x4*)(rowp + bj * HALF) = w; }
                    else {
                        int p0_ = __builtin_amdgcn_cvt_pk_fp8_f32(v0[0] * 16.f, v0[1] * 16.f, 0, false); p0_ = __builtin_amdgcn_cvt_pk_fp8_f32(v0[2] * 16.f, v0[3] * 16.f, p0_, true);
                        int p1_ = __builtin_amdgcn_cvt_pk_fp8_f32(v1[0] * 16.f, v1[1] * 16.f, 0, false); p1_ = __builtin_amdgcn_cvt_pk_fp8_f32(v1[2] * 16.f, v1[3] * 16.f, p1_, true);
                        *(u32x2*)(O8 + (size_t)row * 1024 + col0 + bj * HALF) = (u32x2){(unsigned)p0_, (unsigned)p1_}; } } }
    }
};
struct EpiDownH {
    static constexpr bool PERM = true, AFTER_DRAIN = false, AMAX = false;
    bf16_t* O; const float* bd; const float* rgate; float ws;
    __device__ __forceinline__ void operator()(const f32x4 (&acc)[2][2][4][2], const Unit& u, int wr, int wc, int fr, int fq) const {
        const int e = u.pn >> 3, pnl = u.pn & 7;
        const int row0 = u.pm * BM + wr * 64 + fr, col0 = pnl * HALF + wc * 32 + 8 * fq;
        const f32x4 bv0 = *(const f32x4*)(bd + (size_t)e * 1024 + col0), bv1 = *(const f32x4*)(bd + (size_t)e * 1024 + col0 + 4);
#pragma unroll
        for (int ai = 0; ai < 2; ++ai)
#pragma unroll
            for (int m = 0; m < 4; ++m) { const int row = row0 + ai * HALF + m * 16; const float gw = rgate[row];
                const f32x4 v0 = (acc[ai][0][m][0] * ws + bv0) * gw, v1 = (acc[ai][0][m][1] * ws + bv1) * gw;
                u32x4 w; w.x = cvt_pk_bf16(v0[0], v0[1]); w.y = cvt_pk_bf16(v0[2], v0[3]); w.z = cvt_pk_bf16(v1[0], v1[1]); w.w = cvt_pk_bf16(v1[2], v1[3]);
                *(u32x4*)(O + (size_t)row * 1024 + col0) = w; }
    }
};
struct MoeOrder {
    int nN, G, c, ntiles; const PG8_LAS int* tile_e; int rep;
    __device__ bool next(int i, Unit& u) const {
        const int xcd = c & 7, jj = c >> 3, per = G >> 3;
        const int t0 = (ntiles * xcd) >> 3, t1 = (ntiles * (xcd + 1)) >> 3;
        int li = i * per + jj; const int tot = (t1 - t0) * nN; if (li >= tot * rep) return false; if (li >= tot) li -= tot;
        const int pm = t0 + li / nN, pnl = li - (li / nN) * nN; const int e = tile_e[pm];
        u.pm = pm; u.pn = __builtin_amdgcn_readfirstlane(e * nN + pnl); return true;
    }
    __device__ __forceinline__ void a_ready(const Unit&) const {}
    __device__ __forceinline__ void done(const Unit&) const {}
};
template <class Epi, class Sched, bool ALIGN_EPI, bool SP2, int UIDC, bool GATHER = false, bool F8 = false, bool NHALF = false, int F8N1 = 0>
__device__ __forceinline__ void gemm_phase(PG8_LAS unsigned char* lds, const Gemm g, const Sched& S, const Epi& E, const int wid_in, const int UID) {
    const int wid = wid_in, lane = (int)__builtin_amdgcn_mbcnt_hi(~0u, __builtin_amdgcn_mbcnt_lo(~0u, (unsigned)UID)) - UID, tid = wid * 64 + lane, wr = wid >> 2, wc = wid & 3, fr = lane & 15, fq = lane >> 4;
    int K_l = g.K; asm volatile("; opaque K" : "+s"(K_l));
    const int K = K_l, nt = K / BK;
    static_assert(!GATHER || SP2, "GATHER is wired into the SP2 loop only");
    unsigned voffA[2], voffB[2];
#pragma unroll
    for (int i = 0; i < 2; ++i) { int R, C; stage_rc(tid * 16 + i * 8192, R, C); const int Rb = Epi::PERM ? ((R & ~31) + perm32(R & 31)) : R;
        voffA[i] = (unsigned)(R * K + C) * 2u; voffB[i] = (unsigned)(Rb * K + C) * 2u; }
    const size_t kstep = (size_t)(BK * 2);
    const size_t hstep = (size_t)HALF * K * 2;
    const size_t tstep = 2 * hstep;
    const unsigned ldsw = (unsigned)wid * 1024u;
    const int aoff = lds_byte(wr * 64 + fr, fq * 8), boff = lds_byte(wc * 32 + fr, fq * 8);
#define PG8_SA(b, h) (((b) * 2 + (h)) * HTB)
#define PG8_SB(b, h) ((4 + (b) * 2 + (h)) * HTB)
#define PG8_STAGE(bufoff, gbase, voff) do { _Pragma("unroll") for (int _i = 0; _i < 2; ++_i) \
        __builtin_amdgcn_global_load_lds((const unsigned*)((const char*)(gbase) + (voff)[_i]), (PG8_LAS unsigned*)(lds + (bufoff) + ldsw + _i * 8192), 16, 0, 0); } while (0)
#define PG8_STAGE_A(b, h, gbase, usenext) do { if constexpr (GATHER) { const unsigned _v0 = (usenext) ? vAn[h][0] : vAc[h][0], _v1 = (usenext) ? vAn[h][1] : vAc[h][1]; \
        __builtin_amdgcn_global_load_lds((const unsigned*)((const char*)(gbase) + _v0), (PG8_LAS unsigned*)(lds + PG8_SA(b, h) + ldsw), 16, 0, 0); \
        __builtin_amdgcn_global_load_lds((const unsigned*)((const char*)(gbase) + _v1), (PG8_LAS unsigned*)(lds + PG8_SA(b, h) + ldsw + 8192), 16, 0, 0); } \
    else PG8_STAGE(PG8_SA(b, h), (gbase) + (h) * hstep, voffA); } while (0)
#define PG8_LDA(dst, b, h) do { _Pragma("unroll") for (int m = 0; m < 4; ++m) _Pragma("unroll") for (int k = 0; k < 2; ++k) dst[m][k] = *(const PG8_LAS bf16x8*)(lds + PG8_SA(b, h) + aoff + m * 2048 + k * 1024); } while (0)
#define PG8_LDB(dst, b, h) do { _Pragma("unroll") for (int n = 0; n < 2; ++n) _Pragma("unroll") for (int k = 0; k < 2; ++k) dst[n][k] = *(const PG8_LAS bf16x8*)(lds + PG8_SB(b, h) + boff + n * 2048 + k * 1024); } while (0)
#define PG8_MMA(ai, bj, At, Bt) do { if constexpr (!(NHALF && (bj) == 1)) { __builtin_amdgcn_s_setprio(1); if constexpr (F8) { _Pragma("unroll") for (int m = 0; m < 4; ++m) _Pragma("unroll") for (int n = 0; n < 2; ++n) { \
        if (NHALF || (bj) == 0 || n < F8N1) acc[ai][bj][m][n] = __builtin_amdgcn_mfma_scale_f32_16x16x128_f8f6f4(__builtin_shufflevector(__builtin_bit_cast(i32x4, Bt[n][0]), __builtin_bit_cast(i32x4, Bt[n][1]), 0, 1, 2, 3, 4, 5, 6, 7), \
            __builtin_shufflevector(__builtin_bit_cast(i32x4, At[m][0]), __builtin_bit_cast(i32x4, At[m][1]), 0, 1, 2, 3, 4, 5, 6, 7), acc[ai][bj][m][n], 0, 0, 0, 0, 0, 0); \
        else { _Pragma("unroll") for (int k = 0; k < 2; ++k) { const i64x2 a_ = __builtin_bit_cast(i64x2, At[m][k]), b_ = __builtin_bit_cast(i64x2, Bt[n][k]); \
            acc[ai][bj][m][n] = __builtin_amdgcn_mfma_f32_16x16x32_fp8_fp8(b_[0], a_[0], acc[ai][bj][m][n], 0, 0, 0); \
            acc[ai][bj][m][n] = __builtin_amdgcn_mfma_f32_16x16x32_fp8_fp8(b_[1], a_[1], acc[ai][bj][m][n], 0, 0, 0); } } } } \
    else { _Pragma("unroll") for (int m = 0; m < 4; ++m) _Pragma("unroll") for (int n = 0; n < 2; ++n) _Pragma("unroll") for (int k = 0; k < 2; ++k) \
        acc[ai][bj][m][n] = __builtin_amdgcn_mfma_f32_16x16x32_bf16(Bt[n][k], At[m][k], acc[ai][bj][m][n], 0, 0, 0); } __builtin_amdgcn_s_setprio(0); } } while (0)
#define PG8_WAIT_V(n) asm volatile("s_waitcnt vmcnt(" #n ")" ::: "memory")
#define PG8_WAIT_L(n) asm volatile("s_waitcnt lgkmcnt(" #n ")" ::: "memory")
#define PG8_BAR __builtin_amdgcn_s_barrier()
#define PG8_SCHED __builtin_amdgcn_sched_barrier(0)
    Unit cur, nxt; int ui = 0;
    if (!S.next(0, cur)) return;
    f32x4 acc[2][2][4][2];
#pragma unroll
    for (int a = 0; a < 2; ++a)
#pragma unroll
        for (int b = 0; b < 2; ++b)
#pragma unroll
            for (int m = 0; m < 4; ++m)
#pragma unroll
                for (int n = 0; n < 2; ++n) acc[a][b][m][n] = (f32x4){0.f, 0.f, 0.f, 0.f};
    bf16x8 At[4][2], B0[2][2], B1[2][2];
    const char* cA = (const char*)g.A + (GATHER ? (size_t)0 : (size_t)cur.pm * tstep); const char* cB = (const char*)g.Bt + (size_t)cur.pn * (NHALF ? hstep : tstep);
    unsigned vAc[2][2], vAn[2][2];
    auto gvoff = [&](int pm, unsigned (&v)[2][2]) {
        const int ln_ = (int)__builtin_amdgcn_mbcnt_hi(~0u, __builtin_amdgcn_mbcnt_lo(~0u, (unsigned)pm)) - pm, tid_ = wid * 64 + ln_;
#pragma unroll
        for (int hh = 0; hh < 2; ++hh)
#pragma unroll
            for (int i = 0; i < 2; ++i) { int R, C; stage_rc(tid_ * 16 + i * 8192, R, C); v[hh][i] = (unsigned)g.gidx[(pm - g.gtile0) * 256 + hh * HALF + R] * (unsigned)(K * 2) + (unsigned)(C * 2); } };
    if constexpr (GATHER) { gvoff(cur.pm, vAc); } else { vAc[0][0] = vAc[0][1] = vAc[1][0] = vAc[1][1] = 0u; }
#pragma unroll
    for (int hh = 0; hh < 2; ++hh) { vAn[hh][0] = vAc[hh][0]; vAn[hh][1] = vAc[hh][1]; }
    S.a_ready(cur);
    if constexpr (SP2) {
        PG8_STAGE(PG8_SB(0, 0), cB, voffB); PG8_STAGE(PG8_SB(0, 1), cB + hstep, voffB); PG8_STAGE_A(0, 0, cA, false); PG8_STAGE_A(0, 1, cA, false);
        if (wr == 1) PG8_BAR;
        PG8_WAIT_V(2); PG8_BAR;
        PG8_STAGE(PG8_SB(1, 0), cB + kstep, voffB); PG8_STAGE_A(1, 0, cA + kstep, false); PG8_STAGE(PG8_SB(1, 1), cB + hstep + kstep, voffB);
        PG8_WAIT_V(6); PG8_BAR;
    } else {
        PG8_STAGE(PG8_SB(0, 0), cB, voffB); PG8_STAGE(PG8_SA(0, 0), cA, voffA); PG8_STAGE(PG8_SB(0, 1), cB + hstep, voffB); PG8_STAGE(PG8_SA(0, 1), cA + hstep, voffA);
        if (wr == 1) PG8_BAR;
        PG8_WAIT_V(4); PG8_BAR;
        PG8_STAGE(PG8_SB(1, 0), cB + kstep, voffB); PG8_STAGE(PG8_SA(1, 0), cA + kstep, voffA); PG8_STAGE(PG8_SB(1, 1), cB + hstep + kstep, voffB);
        PG8_WAIT_V(6); PG8_BAR;
    }
    for (;;) {
        const bool has_next = S.next(ui + 1, nxt);
        const char* nA = (has_next && !GATHER) ? (const char*)g.A + (size_t)nxt.pm * tstep : (GATHER ? (const char*)g.A : cA); const char* nB = has_next ? (const char*)g.Bt + (size_t)nxt.pn * (NHALF ? hstep : tstep) : cB;
        if constexpr (GATHER) { if (has_next) gvoff(nxt.pm, vAn); else {
#pragma unroll
            for (int hh = 0; hh < 2; ++hh) { vAn[hh][0] = vAc[hh][0]; vAn[hh][1] = vAc[hh][1]; } } }
        for (int t = 0; t < nt; t += 2) {
            const bool last = (t == nt - 2);
            const char* a1 = cA + (size_t)(t + 1) * kstep;
            const char* a2 = last ? nA : cA + (size_t)(t + 2) * kstep; const char* b2 = last ? nB : cB + (size_t)(t + 2) * kstep;
            const char* a3 = a2 + kstep; const char* b3 = b2 + kstep;
            if (last && has_next) S.a_ready(nxt);
            if constexpr (SP2) {
            PG8_LDB(B0, 0, 0); PG8_LDB(B1, 0, 1); PG8_SCHED; PG8_LDA(At, 0, 0); PG8_STAGE_A(1, 1, a1, false);
            PG8_WAIT_V(8); PG8_WAIT_L(0); PG8_BAR; PG8_MMA(0, 0, At, B0); PG8_MMA(0, 1, At, B1); PG8_BAR; PG8_SCHED;
            PG8_LDA(At, 0, 1); PG8_STAGE(PG8_SB(0, 0), b2, voffB); PG8_STAGE(PG8_SB(0, 1), b2 + hstep, voffB); PG8_STAGE_A(0, 0, a2, last);
            PG8_WAIT_V(8); PG8_WAIT_L(0); PG8_BAR; PG8_MMA(1, 0, At, B0); PG8_MMA(1, 1, At, B1); PG8_BAR; PG8_SCHED;
            PG8_LDB(B0, 1, 0); PG8_LDB(B1, 1, 1); PG8_SCHED; PG8_LDA(At, 1, 0); PG8_STAGE_A(0, 1, a2, last);
            PG8_WAIT_V(8); PG8_WAIT_L(0); PG8_BAR; PG8_MMA(0, 0, At, B0); PG8_MMA(0, 1, At, B1); PG8_BAR; PG8_SCHED;
            PG8_LDA(At, 1, 1); PG8_STAGE(PG8_SB(1, 0), b3, voffB); PG8_STAGE(PG8_SB(1, 1), b3 + hstep, voffB); PG8_STAGE_A(1, 0, a3, last);
            PG8_WAIT_V(8); PG8_WAIT_L(0); PG8_BAR; PG8_MMA(1, 0, At, B0); PG8_MMA(1, 1, At, B1); PG8_BAR; PG8_SCHED;
            } else {
            PG8_LDB(B0, 0, 0); PG8_SCHED; PG8_LDA(At, 0, 0); PG8_STAGE(PG8_SA(1, 1), a1 + hstep, voffA);
            PG8_WAIT_L(8); PG8_BAR; PG8_WAIT_L(0); PG8_MMA(0, 0, At, B0); PG8_BAR; PG8_SCHED;
            PG8_LDB(B1, 0, 1); PG8_STAGE(PG8_SB(0, 0), b2, voffB);
            PG8_BAR; PG8_WAIT_L(0); PG8_MMA(0, 1, At, B1); PG8_BAR;
            PG8_LDA(At, 0, 1); PG8_STAGE(PG8_SA(0, 0), a2, voffA);
            PG8_BAR; PG8_WAIT_L(0); PG8_MMA(1, 0, At, B0); PG8_BAR; PG8_SCHED;
            PG8_STAGE(PG8_SB(0, 1), b2 + hstep, voffB);
            PG8_WAIT_V(6); PG8_BAR; PG8_MMA(1, 1, At, B1); PG8_BAR;
            PG8_LDB(B0, 1, 0); PG8_SCHED; PG8_LDA(At, 1, 0); PG8_STAGE(PG8_SA(0, 1), a2 + hstep, voffA);
            PG8_WAIT_L(8); PG8_BAR; PG8_WAIT_L(0); PG8_MMA(0, 0, At, B0); PG8_BAR; PG8_SCHED;
            PG8_LDB(B1, 1, 1); PG8_STAGE(PG8_SB(1, 0), b3, voffB);
            PG8_BAR; PG8_WAIT_L(0); PG8_MMA(0, 1, At, B1); PG8_BAR;
            PG8_LDA(At, 1, 1); PG8_STAGE(PG8_SA(1, 0), a3, voffA);
            PG8_BAR; PG8_WAIT_L(0); PG8_MMA(1, 0, At, B0); PG8_BAR; PG8_SCHED;
            PG8_STAGE(PG8_SB(1, 1), b3 + hstep, voffB);
            PG8_WAIT_V(6); PG8_BAR; PG8_MMA(1, 1, At, B1); PG8_BAR;
            }
        }
        if constexpr (ALIGN_EPI) { if (wr == 0) PG8_BAR; }
        if constexpr (!Epi::AFTER_DRAIN) {
            const int dep_ = __builtin_amdgcn_readfirstlane(__builtin_bit_cast(int, acc[1][1][3][1][3]));
            const int lane_e = (int)__builtin_amdgcn_mbcnt_hi(~0u, __builtin_amdgcn_mbcnt_lo(~0u, (unsigned)dep_)) - dep_;
            if constexpr (Epi::AMAX) {
                float mx_ = 0.f;
#pragma unroll
                for (int a_ = 0; a_ < 2; ++a_)
#pragma unroll
                    for (int b_ = 0; b_ < 2; ++b_)
#pragma unroll
                        for (int m_ = 0; m_ < 4; ++m_) { const f32x4 s0_ = acc[a_][b_][m_][0] * acc[a_][b_][m_][0] + acc[a_][b_][m_][1] * acc[a_][b_][m_][1];
                            float s_ = (s0_[0] + s0_[1]) + (s0_[2] + s0_[3]); s_ += __shfl_xor(s_, 16); s_ += __shfl_xor(s_, 32); mx_ = fmaxf(mx_, s_); }
#pragma unroll
                for (int o_ = 8; o_ >= 1; o_ >>= 1) mx_ = fmaxf(mx_, __shfl_xor(mx_, o_));
                if (lane_e == 0) (void)__hip_atomic_fetch_max(E.amax, __builtin_bit_cast(unsigned, mx_), __ATOMIC_RELAXED, __HIP_MEMORY_SCOPE_AGENT); }
            E(acc, cur, wr, wc, lane_e & 15, lane_e >> 4); S.done(cur); }
        if (!has_next) break;
#pragma unroll
        for (int a = 0; a < 2; ++a)
#pragma unroll
            for (int b = 0; b < 2; ++b)
#pragma unroll
                for (int m = 0; m < 4; ++m)
#pragma unroll
                    for (int n = 0; n < 2; ++n) acc[a][b][m][n] = (f32x4){0.f, 0.f, 0.f, 0.f};
        cur = nxt; cA = nA; cB = nB; ++ui;
#pragma unroll
        for (int hh = 0; hh < 2; ++hh) { vAc[hh][0] = vAn[hh][0]; vAc[hh][1] = vAn[hh][1]; }
        if constexpr (ALIGN_EPI) { if (wr == 1) PG8_BAR; }
    }
    PG8_WAIT_V(0);
    if constexpr (!ALIGN_EPI) { if (wr == 0) PG8_BAR; }
    PG8_BAR;
    if constexpr (Epi::AFTER_DRAIN) { E.fused(acc, cur, wr, wc, fr, fq, lds, wid, lane); S.done(cur); }
#undef PG8_SA
#undef PG8_SB
#undef PG8_STAGE
#undef PG8_STAGE_A
#undef PG8_LDA
#undef PG8_LDB
#undef PG8_MMA
#undef PG8_WAIT_V
#undef PG8_WAIT_L
#undef PG8_BAR
#undef PG8_SCHED
}
}
constexpr int S = 16384, D = 1024, NLAYER = 4, NE = 32;
constexpr float ALPHA_DN = 1.6817928305074292f;
constexpr float LN_EPS = 1e-5f, RMS_EPS = 1e-6f;
constexpr float LOG2E = 1.4426950408889634f;
constexpr int NWAVES = 8, NTHREADS = 512;
constexpr int MOE_MAXTILES = 288, MOE_ROWS = MOE_MAXTILES * 256;
constexpr size_t MiB = 1u << 20;
constexpr size_t WS_CTL = 0, CTL_ZERO_BYTES = 1 * MiB;
constexpr size_t WS_CS64 = 1 * MiB, WS_CS32 = 5 * MiB;
constexpr size_t WS_WDA = 8 * MiB;
constexpr size_t WS_WMLA = 24 * MiB;
constexpr size_t WS_WNSA = 30 * MiB;
constexpr size_t WS_WMOE = 64 * MiB;
constexpr size_t WS_H = 832 * MiB, WS_H1 = 896 * MiB, WS_Y = 960 * MiB;
constexpr size_t WS_XB = 1024 * MiB, WS_X1B = 1056 * MiB, WS_AO = 1088 * MiB;
constexpr size_t WS_QK = 1120 * MiB;
constexpr size_t WS_VT = 1184 * MiB;
constexpr size_t WS_OH = 1216 * MiB;
constexpr size_t WS_MISC = 1280 * MiB;
constexpr size_t WS_KH = WS_MISC + 96 * MiB;
constexpr size_t WS_AS = 1408 * MiB, WS_ACT = 1552 * MiB, WS_YS = 1696 * MiB;
constexpr size_t WS_ROUTE = 1840 * MiB;
constexpr size_t WS_END = 1844 * MiB;
constexpr size_t MLA_C = 0, MLA_CQN = 32 * MiB, MLA_CKVN = 40 * MiB, MLA_KR = 44 * MiB;
constexpr size_t NSA_P = 0, NSA_ACK = 24 * MiB, NSA_ACV = 40 * MiB, NSA_HK = 56 * MiB, NSA_HV = 58 * MiB, NSA_KC = 60 * MiB, NSA_VCT = 61 * MiB, NSA_SEL = 63 * MiB;
constexpr int CW_BAR = 4096, CW_CNT = 16384  , CW_ERR = 20480  , CW_KMAX = 20608  ;
constexpr int RING_BYTES = 131072, LDSCTL_OFF = RING_BYTES, LDS_GIDX_OFF = LDSCTL_OFF + 4096  , LDS_BYTES = 155648;
constexpr int LC_HIST = 16, LC_BASE = 48, LC_SEG = 80  , LC_LCNT = 120, LC_NT = 152, LC_TILEE = 160  , LC_POS = 512  , LC_LAM = 800;

#define GAS __attribute__((address_space(1)))
#define LAS __attribute__((address_space(3)))
typedef unsigned short bf16;
typedef unsigned v4u __attribute__((ext_vector_type(4)));
typedef unsigned v2u __attribute__((ext_vector_type(2)));
typedef float f32x4 __attribute__((ext_vector_type(4)));
typedef float f32x16 __attribute__((ext_vector_type(16)));
typedef float f32x8v __attribute__((ext_vector_type(8)));
typedef float f32x2v __attribute__((ext_vector_type(2)));
__device__ __forceinline__ float sum32pk(const f32x16& a, const f32x16& b) {
    const f32x16 s = a + b;
    const f32x8v s8 = __builtin_shufflevector(s, s, 0, 1, 2, 3, 4, 5, 6, 7) + __builtin_shufflevector(s, s, 8, 9, 10, 11, 12, 13, 14, 15);
    const f32x4 s4 = __builtin_shufflevector(s8, s8, 0, 1, 2, 3) + __builtin_shufflevector(s8, s8, 4, 5, 6, 7);
    const f32x2v s2 = __builtin_shufflevector(s4, s4, 0, 1) + __builtin_shufflevector(s4, s4, 2, 3);
    return s2.x + s2.y;
}
typedef short bf16x8 __attribute__((ext_vector_type(8)));
typedef pg8::cs_t cs_t;
__device__ __forceinline__ unsigned f2bf(float f) { unsigned u = __builtin_bit_cast(unsigned, f); return (u + 0x7fffu + ((u >> 16) & 1u)) >> 16; }
__device__ __forceinline__ unsigned pk2(float lo, float hi) { return pg8::cvt_pk_bf16(lo, hi); }
__device__ __forceinline__ float bf2f(unsigned short b) { return __builtin_bit_cast(float, (unsigned)b << 16); }
__device__ __forceinline__ float bflo(unsigned w) { return __builtin_bit_cast(float, w << 16); }
__device__ __forceinline__ float bfhi(unsigned w) { return __builtin_bit_cast(float, w & 0xffff0000u); }
__device__ __forceinline__ float wave_sum(float v) {
#pragma unroll
    for (int o = 1; o < 64; o <<= 1) v += __shfl_xor(v, o);
    return v;
}
__device__ __forceinline__ float wave_max(float v) {
#pragma unroll
    for (int o = 1; o < 64; o <<= 1) v = fmaxf(v, __shfl_xor(v, o));
    return v;
}
__device__ __forceinline__ float swap32f(float v, int hi) {
    auto rr = __builtin_amdgcn_permlane32_swap(__float_as_uint(v), __float_as_uint(v), false, false);
    return hi ? __uint_as_float(rr[0]) : __uint_as_float(rr[1]);
}

__device__ __forceinline__ float swap16f(float v, int odd) {
    auto rr = __builtin_amdgcn_permlane16_swap(__float_as_uint(v), __float_as_uint(v), false, false);
    return odd ? __uint_as_float(rr[0]) : __uint_as_float(rr[1]);
}

#define XB_TMO      128
#define XB_XCNT(j)  (256  + 64 * (j))
#define XB_XSUB(j)  (1280 + 64 * (j))
#define XB_XGEN(j)  (2304 + 64 * (j))
#define XB_TOP      3328
#define XB_TOPGEN   3392
#define XCD_BAR_WORDS 3456
#define XB_SPIN_CAP (1u << 18)
__device__ __forceinline__ unsigned xb_ld(unsigned* p)              { return __hip_atomic_load(p, __ATOMIC_RELAXED, __HIP_MEMORY_SCOPE_AGENT); }
__device__ __forceinline__ unsigned xb_add(unsigned* p, unsigned v) { return __hip_atomic_fetch_add(p, v, __ATOMIC_RELAXED, __HIP_MEMORY_SCOPE_AGENT); }
__device__ __forceinline__ unsigned xb_xcc_id() { return (unsigned)__builtin_amdgcn_s_getreg((3 << 11) | 20) & 0xFu; }
#define XB_SPIN(cond, bar) do { unsigned _sp = 0; while (cond) { __builtin_amdgcn_s_sleep(1); \
    if ((++_sp & 255u) == 0u) { if (xb_ld(&(bar)[XB_TMO])) break; if (_sp > XB_SPIN_CAP) { atomicAdd(&(bar)[XB_TMO], 1u); break; } } } } while (0)
struct XcdBarrier { unsigned* bar; unsigned x; volatile LAS unsigned* st; };
__device__ __forceinline__ XcdBarrier xcd_barrier_post(unsigned* bar, volatile LAS unsigned* st, int tid0) {
    XcdBarrier b; b.bar = bar; b.x = xb_xcc_id(); b.st = st;
    if (tid0 == 0) (void)xb_add(&bar[XB_XCNT(b.x)], 1u);
    return b;
}
__device__ __forceinline__ void xcd_barrier_complete(unsigned* bar, unsigned x, unsigned& nloc, unsigned& nx) {
    const unsigned G = gridDim.x * gridDim.y * gridDim.z;
    unsigned sum, cnt, mine, sp = 0u;
    for (;;) {
        sum = 0u; cnt = 0u; mine = 0u;
#pragma unroll
        for (unsigned j = 0; j < 16; ++j) { const unsigned c = xb_ld(&bar[XB_XCNT(j)]); sum += c; cnt += (c > 0u) ? 1u : 0u; mine = (j == x) ? c : mine; }
        if (sum == G) break;
        __builtin_amdgcn_s_sleep(1);
        if ((++sp & 255u) == 0u) { if (xb_ld(&bar[XB_TMO])) break; if (sp > XB_SPIN_CAP) { atomicAdd(&bar[XB_TMO], 1u); break; } }
    }
    nloc = mine > 0u ? mine : 1u; nx = cnt > 0u ? cnt : 1u;
}
__device__ __forceinline__ void xcd_barrier(const XcdBarrier& b, int tid0) {
    asm volatile("s_waitcnt vmcnt(0)" ::: "memory");
    __syncthreads();
    if (tid0 == 0) {
        unsigned* bar = b.bar;
        __builtin_amdgcn_s_waitcnt(0);
        unsigned nloc = b.st[0], nx = b.st[1];
        if (nloc == 0u) { xcd_barrier_complete(bar, b.x, nloc, nx); b.st[0] = nloc; b.st[1] = nx; }
        const unsigned old = xb_add(&bar[XB_XSUB(b.x)], 1u);
        const unsigned gen = old / nloc;
        if (old + 1u == (gen + 1u) * nloc) {
            __builtin_amdgcn_fence(__ATOMIC_RELEASE, "agent");
            asm volatile("s_waitcnt vmcnt(0)" ::: "memory");
            const unsigned og = xb_add(&bar[XB_TOP], 1u);
            const unsigned tg = og / nx;
            if (og + 1u == (tg + 1u) * nx) xb_add(&bar[XB_TOPGEN], 1u);
            else XB_SPIN(xb_ld(&bar[XB_TOPGEN]) == tg, bar);
            __builtin_amdgcn_fence(__ATOMIC_ACQUIRE, "agent");
            xb_add(&bar[XB_XGEN(b.x)], 1u);
            asm volatile("s_waitcnt vmcnt(0)" ::: "memory");
        } else {
            XB_SPIN(xb_ld(&bar[XB_XGEN(b.x)]) == gen, bar);
            __builtin_amdgcn_fence(__ATOMIC_ACQUIRE, "agent");
            asm volatile("s_waitcnt vmcnt(0)" ::: "memory");
        }
    }
    __syncthreads();
}

enum CvtMode { CM_IDENT = 0, CM_ROPE64 = 1, CM_MLAQ = 2, CM_MLAKV = 3, CM_NSAIN = 4, CM_SWIGLU = 5 };
struct Job { const float* src; bf16* dst; long long sbs, dbs; int ld, K, ncols, col0, mode, nbatch, item0, pad; };
constexpr int MAXJOBS = 32;
enum { I_X = 0, I_DA_WIN, I_DA_LQ1, I_DA_LK1, I_DA_LQ2, I_DA_LK2, I_DA_SUBLN, I_DA_WOUT, I_MLA_WIN, I_MLA_QN, I_MLA_KVN, I_MLA_WUQ, I_MLA_WUKV, I_MLA_WOUT,
       I_NSA_WIN, I_NSA_POSK, I_NSA_POSV, I_NSA_KW1, I_NSA_KW2, I_NSA_VW1, I_NSA_VW2, I_NSA_WOUT, I_LN1G, I_LN1B, I_LN2G, I_LN2B, I_MOE_WR, I_MOE_BR, I_MOE_WGU, I_MOE_BGU, I_MOE_WDN, I_MOE_BDN, N_IN };
struct Args { const float* in[N_IN]; float* out; unsigned char* ws; Job jobs[MAXJOBS]; int njobs, nitems, ph_lo, ph_hi; };

__device__ __forceinline__ int rope64_row(int hv, int d) { return 256 * (hv >> 2) + 128 * (d >> 5) + 32 * (hv & 3) + (d & 31); }
__device__ __forceinline__ int cvt_dst_row(int mode, int f) {
    switch (mode) {
    case CM_ROPE64: return rope64_row(f >> 6, f & 63);
    case CM_MLAQ: { const int head = f / 96, d = f - head * 96; if (d < 64) return 64 * head + d; const int r = d - 64; return 1024 + 256 * (head >> 3) + 128 * (r >> 4) + 16 * (head & 7) + (r & 15); }
    case CM_MLAKV: { const int head = f >> 7, d = f & 127; return d < 64 ? 64 * head + d : 1024 + 64 * head + (d - 64); }
    case CM_NSAIN: {
        if (f < 1024) return rope64_row(f >> 6, f & 63);
        if (f < 1280) return 1536 + (f - 1024);
        if (f < 1536) return 1792 + (f - 1280);
        if (f < 1792) return rope64_row(16 + ((f - 1536) >> 6), f & 63);
        if (f < 2048) return 2304 + (f - 1792);
        if (f < 2304) return rope64_row(20 + ((f - 2048) >> 6), f & 63);
        if (f < 2560) return 2560 + (f - 2304);
        return 2048 + (f - 2560); }
    case CM_SWIGLU: { const int j = f >> 1; return 256 * (j >> 7) + 128 * (f & 1) + (j & 127); }
    default: return f;
    }
}
__device__ __forceinline__ void cvt_item(const Job& J, int item, LAS unsigned char* scr, int lane) {
    const int nblk = (J.ncols + 63) >> 6, per_b = (J.K >> 6) * nblk;
    const int b = item / per_b, r = item - b * per_b, kb = r / nblk, nb = r - kb * nblk, k0 = 64 * kb, n0 = 64 * nb;
    const int col = n0 + lane; const bool ok = col < J.ncols;
    const float* W = J.src + (size_t)b * J.sbs + (size_t)k0 * J.ld + J.col0 + (ok ? col : 0);
    float v[64];
#pragma unroll
    for (int i = 0; i < 64; ++i) v[i] = __builtin_nontemporal_load(W + (size_t)i * J.ld);
#pragma unroll
    for (int q = 0; q < 8; ++q) { v4u o; o.x = pk2(v[8 * q], v[8 * q + 1]); o.y = pk2(v[8 * q + 2], v[8 * q + 3]); o.z = pk2(v[8 * q + 4], v[8 * q + 5]); o.w = pk2(v[8 * q + 6], v[8 * q + 7]);
        *(LAS v4u*)(scr + lane * 144 + q * 16) = o; }
    asm volatile("s_waitcnt lgkmcnt(0)" ::: "memory");
    bf16* dstb = J.dst + (size_t)b * J.dbs + k0;
#pragma unroll
    for (int s = 0; s < 8; ++s) { const int rl = 8 * s + (lane >> 3), ch = lane & 7;
        const v4u o = *(const LAS v4u*)(scr + rl * 144 + ch * 16);
        if (n0 + rl < J.ncols) __builtin_nontemporal_store(o, (v4u*)(dstb + (size_t)cvt_dst_row(J.mode, n0 + rl) * J.K + ch * 8)); }
    asm volatile("s_waitcnt lgkmcnt(0)" ::: "memory");
}
__device__ __forceinline__ void cvt_item_f8(const Job& J, int item, LAS unsigned char* scr, int lane) {
    const int nblk = (J.ncols + 63) >> 6, per_b = (J.K >> 7) * nblk;
    const int b = item / per_b, r = item - b * per_b, kb = r / nblk, nb = r - kb * nblk, n0 = 64 * nb;
    const bool perm = J.pad == 1;
    const float* W = J.src + (size_t)b * J.sbs + J.col0 + n0 + lane;
#pragma unroll
    for (int h = 0; h < 2; ++h) {
        float v[64];
#pragma unroll
        for (int q = 0; q < 4; ++q)
#pragma unroll
            for (int m = 0; m < 16; ++m) { const int row = perm ? 8 * kb + 4 * h + q + 64 * m : 128 * kb + 64 * h + 16 * q + m; v[16 * q + m] = __builtin_nontemporal_load(W + (size_t)row * J.ld); }
#pragma unroll
        for (int q = 0; q < 4; ++q) { v4u o; int w;
            w = __builtin_amdgcn_cvt_pk_fp8_f32(v[16 * q + 0] * 64.f, v[16 * q + 1] * 64.f, 0, false); w = __builtin_amdgcn_cvt_pk_fp8_f32(v[16 * q + 2] * 64.f, v[16 * q + 3] * 64.f, w, true); o.x = (unsigned)w;
            w = __builtin_amdgcn_cvt_pk_fp8_f32(v[16 * q + 4] * 64.f, v[16 * q + 5] * 64.f, 0, false); w = __builtin_amdgcn_cvt_pk_fp8_f32(v[16 * q + 6] * 64.f, v[16 * q + 7] * 64.f, w, true); o.y = (unsigned)w;
            w = __builtin_amdgcn_cvt_pk_fp8_f32(v[16 * q + 8] * 64.f, v[16 * q + 9] * 64.f, 0, false); w = __builtin_amdgcn_cvt_pk_fp8_f32(v[16 * q + 10] * 64.f, v[16 * q + 11] * 64.f, w, true); o.z = (unsigned)w;
            w = __builtin_amdgcn_cvt_pk_fp8_f32(v[16 * q + 12] * 64.f, v[16 * q + 13] * 64.f, 0, false); w = __builtin_amdgcn_cvt_pk_fp8_f32(v[16 * q + 14] * 64.f, v[16 * q + 15] * 64.f, w, true); o.w = (unsigned)w;
            *(LAS v4u*)(scr + lane * 144 + (4 * h + q) * 16) = o; }
    }
    asm volatile("s_waitcnt lgkmcnt(0)" ::: "memory");
    unsigned char* dstb = (unsigned char*)J.dst + (size_t)b * J.dbs + 128 * kb;
#pragma unroll
    for (int s = 0; s < 8; ++s) { const int rl = 8 * s + (lane >> 3), ch = lane & 7;
        const v4u o = *(const LAS v4u*)(scr + rl * 144 + ch * 16);
        __builtin_nontemporal_store(o, (v4u*)(dstb + (size_t)cvt_dst_row(J.mode, n0 + rl) * J.K + ch * 16)); }
    asm volatile("s_waitcnt lgkmcnt(0)" ::: "memory");
}
__device__ __forceinline__ unsigned lds_inc(LAS unsigned* p) { return __hip_atomic_fetch_add(p, 1u, __ATOMIC_RELAXED, __HIP_MEMORY_SCOPE_WORKGROUP); }
#define WSP(T, off) ((T*)(a.ws + (off)))
__device__ __forceinline__ void zero_rows(bf16* dst, int K, int r0, int r1, int gtid, int gthreads) {
    v4u* p = (v4u*)(dst + (size_t)r0 * K); const int n = (r1 - r0) * K / 8;
    for (int i = gtid; i < n; i += gthreads) p[i] = (v4u){0u, 0u, 0u, 0u};
}
__device__ __forceinline__ void phase_prologue(const Args& a, LAS unsigned char* lds, int tid, int lane, int wave) {
    const int gw = blockIdx.x * NWAVES + wave, NGW = gridDim.x * NWAVES;
    const int gtid = blockIdx.x * NTHREADS + tid, GT = gridDim.x * NTHREADS;
    LAS unsigned char* scr = lds + wave * 9216;
    for (int it = gw; it < a.nitems; it += NGW) {
        int j = 0;
        for (int q = 1; q < a.njobs; ++q) if (it >= a.jobs[q].item0) j = q;
        j = __builtin_amdgcn_readfirstlane(j);
        if (a.jobs[j].pad) cvt_item_f8(a.jobs[j], it - a.jobs[j].item0, scr, lane); else cvt_item(a.jobs[j], it - a.jobs[j].item0, scr, lane);
    }
    zero_rows(WSP(bf16, WS_WMLA), 1024, 416, 512, gtid, GT);
    zero_rows(WSP(bf16, WS_WNSA), 1024, 2096, 2304, gtid, GT);
    zero_rows(WSP(bf16, WS_WNSA + 8 * MiB), 256, 32, 128, gtid, GT);
    zero_rows(WSP(bf16, WS_WNSA + 8 * MiB), 256, 160, 256, gtid, GT);
    zero_rows(WSP(bf16, WS_WNSA + 8 * MiB + 131072), 256, 64, 256, gtid, GT);
    cs_t* cs64 = WSP(cs_t, WS_CS64); cs_t* cs32 = WSP(cs_t, WS_CS32);
    for (int i = gtid; i < S * 48; i += GT) {
        int pos, fi; float inv; cs_t* dst;
        if (i < S * 32) { pos = i >> 5; fi = i & 31; inv = exp2f(-(float)fi * (13.287712379549449f / 32.0f)); dst = cs64 + i; }
        else { const int k = i - S * 32; pos = k >> 4; fi = k & 15; inv = exp2f(-(float)fi * (13.287712379549449f / 16.0f)); dst = cs32 + k; }
        const float ang = (float)pos * inv;
        const double t = (double)ang * 0.15915494309189535; const double fr = t - __builtin_rint(t);
        cs_t o; o.c = __builtin_amdgcn_cosf((float)fr); o.s = __builtin_amdgcn_sinf((float)fr); *dst = o;
    }
    const f32x4* x4 = (const f32x4*)a.in[I_X]; v2u* xb = WSP(v2u, WS_XB);
    for (int i = gtid; i < S * D / 4; i += GT) { const f32x4 v = x4[i]; v2u o; o.x = pk2(v[0], v[1]); o.y = pk2(v[2], v[3]); xb[i] = o; }
}

__device__ __forceinline__ void phase_ln1_router(const Args& a, LAS unsigned char* lds, int layer, int tid, int lane, int wave) {
    const float* wr = a.in[I_MOE_WR] + (size_t)layer * 1024 * 32;
    LAS float* wl = (LAS float*)lds;
    for (int i = tid; i < 8192; i += NTHREADS) { const f32x4 v = ((const f32x4*)wr)[i]; const int k = i >> 3, ch = i & 7, R = (k & 15) * 64 + (k >> 4), pch = ch ^ ((R >> 1) & 7); *(LAS f32x4*)(wl + R * 32 + pch * 4) = v; }
    LAS unsigned* lc = (LAS unsigned*)(lds + LDSCTL_OFF);
    if (tid < 32) lc[LC_HIST + tid] = 0u;
    __syncthreads();
    const float* gn = a.in[I_LN1G] + layer * 1024; const float* bn = a.in[I_LN1B] + layer * 1024; const float* br = a.in[I_MOE_BR] + layer * 32;
    const bf16* Y = WSP(bf16, WS_Y); const bf16* XBr = WSP(bf16, WS_XB); bf16* X1B = WSP(bf16, WS_X1B);
    int* top_e = WSP(int, WS_ROUTE); float* gate = WSP(float, WS_ROUTE + 262144);
    const int sw = (lane >> 1) & 7;
    for (int i = 0; i < 8; ++i) {
        const int t = blockIdx.x * 64 + wave * 8 + i;
        float v[16]; float s = 0.f;
        { const v4u* yp = (const v4u*)(Y + (size_t)t * 1024 + 16 * lane); (void)XBr;
          const v4u y0 = yp[0], y1 = yp[1];
          const unsigned yw[8] = {y0.x, y0.y, y0.z, y0.w, y1.x, y1.y, y1.z, y1.w};
#pragma unroll
          for (int q = 0; q < 8; ++q) { v[2 * q] = bflo(yw[q]); v[2 * q + 1] = bfhi(yw[q]); s += v[2 * q] + v[2 * q + 1]; } }
        const float mean = wave_sum(s) * (1.0f / 1024.0f); float s2 = 0.f;
#pragma unroll
        for (int m = 0; m < 16; ++m) { v[m] -= mean; s2 += v[m] * v[m]; }
        const float rstd = 1.0f / sqrtf(wave_sum(s2) * (1.0f / 1024.0f) + LN_EPS);
        { const f32x4* g4 = (const f32x4*)(gn + 16 * lane); const f32x4* b4 = (const f32x4*)(bn + 16 * lane);
#pragma unroll
          for (int q = 0; q < 4; ++q) { const f32x4 gg = g4[q], bb = b4[q];
#pragma unroll
              for (int e = 0; e < 4; ++e) v[4 * q + e] = v[4 * q + e] * rstd * gg[e] + bb[e]; }
          v4u o0, o1; o0.x = pk2(v[0], v[1]); o0.y = pk2(v[2], v[3]); o0.z = pk2(v[4], v[5]); o0.w = pk2(v[6], v[7]); o1.x = pk2(v[8], v[9]); o1.y = pk2(v[10], v[11]); o1.z = pk2(v[12], v[13]); o1.w = pk2(v[14], v[15]);
          v4u* xp = (v4u*)(X1B + (size_t)t * 1024 + 16 * lane); xp[0] = o0; xp[1] = o1; }
        {
            v4u o; int w;
            w = __builtin_amdgcn_cvt_pk_fp8_f32(v[0], v[1], 0, false); w = __builtin_amdgcn_cvt_pk_fp8_f32(v[2], v[3], w, true); o.x = (unsigned)w;
            w = __builtin_amdgcn_cvt_pk_fp8_f32(v[4], v[5], 0, false); w = __builtin_amdgcn_cvt_pk_fp8_f32(v[6], v[7], w, true); o.y = (unsigned)w;
            w = __builtin_amdgcn_cvt_pk_fp8_f32(v[8], v[9], 0, false); w = __builtin_amdgcn_cvt_pk_fp8_f32(v[10], v[11], w, true); o.z = (unsigned)w;
            w = __builtin_amdgcn_cvt_pk_fp8_f32(v[12], v[13], 0, false); w = __builtin_amdgcn_cvt_pk_fp8_f32(v[14], v[15], w, true); o.w = (unsigned)w;
            *(v4u*)(WSP(unsigned char, WS_AS) + (size_t)t * 1024 + lane * 16) = o; }
        float acc[32];
#pragma unroll
        for (int e = 0; e < 32; ++e) acc[e] = 0.f;
#pragma unroll
        for (int m = 0; m < 16; ++m) { const LAS float* wrow = wl + (lane + 64 * m) * 32;
#pragma unroll
            for (int ch = 0; ch < 8; ++ch) { const f32x4 w = *(const LAS f32x4*)(wrow + ((ch ^ sw) << 2));
                acc[4 * ch + 0] += v[m] * w[0]; acc[4 * ch + 1] += v[m] * w[1]; acc[4 * ch + 2] += v[m] * w[2]; acc[4 * ch + 3] += v[m] * w[3]; } }
        float a16[16], a8[8], a4[4], a2[2];
        { const bool b = (lane & 32) != 0;
#pragma unroll
          for (int q = 0; q < 16; ++q) { const float send = b ? acc[q] : acc[q + 16], keep = b ? acc[q + 16] : acc[q]; a16[q] = keep + __shfl_xor(send, 32); } }
        { const bool b = (lane & 16) != 0;
#pragma unroll
          for (int q = 0; q < 8; ++q) { const float send = b ? a16[q] : a16[q + 8], keep = b ? a16[q + 8] : a16[q]; a8[q] = keep + __shfl_xor(send, 16); } }
        { const bool b = (lane & 8) != 0;
#pragma unroll
          for (int q = 0; q < 4; ++q) { const float send = b ? a8[q] : a8[q + 4], keep = b ? a8[q + 4] : a8[q]; a4[q] = keep + __shfl_xor(send, 8); } }
        { const bool b = (lane & 4) != 0;
#pragma unroll
          for (int q = 0; q < 2; ++q) { const float send = b ? a4[q] : a4[q + 2], keep = b ? a4[q + 2] : a4[q]; a2[q] = keep + __shfl_xor(send, 4); } }
        float lg;
        { const bool b = (lane & 2) != 0; const float send = b ? a2[0] : a2[1], keep = b ? a2[1] : a2[0]; lg = keep + __shfl_xor(send, 2); }
        lg += __shfl_xor(lg, 1);
        lg += br[lane >> 1];
        float tv[4]; int te[4];
#pragma unroll
        for (int r = 0; r < 4; ++r) {
            const float mx = wave_max(lg);
            const unsigned long long bal = __ballot(lg == mx);
            const int sl = __ffsll((long long)bal) - 1; const int e = sl >> 1;
            tv[r] = mx; te[r] = e;
            if ((lane >> 1) == e) lg = -INFINITY;
        }
        if (lane == 0) {
            const float e1 = __expf(tv[1] - tv[0]), e2 = __expf(tv[2] - tv[0]), e3 = __expf(tv[3] - tv[0]); const float inv = 1.0f / (1.0f + e1 + e2 + e3);
            *(int4*)(top_e + (size_t)t * 4) = make_int4(te[0], te[1], te[2], te[3]);
            *(float4*)(gate + (size_t)t * 4) = make_float4(inv, e1 * inv, e2 * inv, e3 * inv);
            lds_inc(lc + LC_HIST + te[0]); lds_inc(lc + LC_HIST + te[1]); lds_inc(lc + LC_HIST + te[2]); lds_inc(lc + LC_HIST + te[3]);
        }
    }
    __syncthreads();
    if (tid < 32) { unsigned* cnt = WSP(unsigned, WS_CTL) + CW_CNT + layer * 32; const unsigned h = lc[LC_HIST + tid]; lc[LC_BASE + tid] = xb_add(cnt + tid, h); }
    __syncthreads();
}

__device__ __forceinline__ void phase_place(const Args& a, LAS unsigned char* lds, int layer, int tid, int lane, int wave) {
    LAS unsigned* lc = (LAS unsigned*)(lds + LDSCTL_OFF);
    unsigned* cnt = WSP(unsigned, WS_CTL) + CW_CNT + layer * 32;
    if (tid < 64) {
        const unsigned c = (lane < 32) ? xb_ld(cnt + lane) : 0u; const unsigned nt = (c + 255u) >> 8;
        unsigned inc = nt;
#pragma unroll
        for (int o = 1; o < 32; o <<= 1) { const unsigned up = __shfl_up(inc, o); if (lane >= o) inc += up; }
        const unsigned ts = inc - nt;
        if (lane < 32) { lc[LC_SEG + lane] = ts * 256u; for (unsigned q = 0; q < nt; ++q) lc[LC_TILEE + ts + q] = (unsigned)lane; }
        if (lane == 31) lc[LC_NT] = inc;
    }
    if (tid >= 64 && tid < 96) lc[LC_LCNT + tid - 64] = 0u;
    __syncthreads();
    const int* top_e = WSP(int, WS_ROUTE); const float* gate = WSP(float, WS_ROUTE + 262144); int* tokpos = WSP(int, WS_ROUTE + 524288); float* rgate = WSP(float, WS_ROUTE + 786432);
    if (tid < 256) { const int t = blockIdx.x * 64 + (tid >> 2); const int e = top_e[(size_t)t * 4 + (tid & 3)];
        const unsigned rank = lds_inc(lc + LC_LCNT + e); const unsigned pos = lc[LC_SEG + e] + lc[LC_BASE + e] + rank;
        rgate[pos] = gate[(size_t)t * 4 + (tid & 3)]; tokpos[(size_t)t * 4 + (tid & 3)] = (int)pos; WSP(unsigned short, WS_ROUTE + 2 * MiB)[pos] = (unsigned short)t; }
    __syncthreads();
    if (blockIdx.x < 32) { const int e = blockIdx.x; const unsigned c = xb_ld(cnt + e), seg = lc[LC_SEG + e], pad = ((c + 255u) & ~255u) - c;
        unsigned short* rt = WSP(unsigned short, WS_ROUTE + 2 * MiB) + seg + c;
        for (unsigned q = tid; q < pad; q += NTHREADS) rt[q] = 0; }
    __syncthreads();
}

__device__ __forceinline__ void phase_ln2(const Args& a, int layer, float* fout, int tid, int lane, int wave) {
    const float* gn = a.in[I_LN2G] + layer * 1024; const float* bn = a.in[I_LN2B] + layer * 1024;
    const bf16* X1B = WSP(bf16, WS_X1B); const bf16* Ys = WSP(bf16, WS_YS); const int* tokpos = WSP(int, WS_ROUTE + 524288); bf16* XB = WSP(bf16, WS_XB);
    for (int i = 0; i < 8; ++i) {
        const int t = blockIdx.x * 64 + wave * 8 + i;
        const int4 pp = *(const int4*)(tokpos + (size_t)t * 4);
        f32x4 v[4]; float s = 0.f;
#pragma unroll
        for (int j = 0; j < 4; ++j) { const int k = 256 * j + 4 * lane; const v2u hw = *(const v2u*)(X1B + (size_t)t * 1024 + k);
            f32x4 h = (f32x4){bflo(hw.x), bfhi(hw.x), bflo(hw.y), bfhi(hw.y)} * ALPHA_DN;
            const unsigned char* Y8 = (const unsigned char*)Ys;
            const int w0 = *(const int*)(Y8 + (size_t)pp.x * 1024 + k), w1 = *(const int*)(Y8 + (size_t)pp.y * 1024 + k), w2 = *(const int*)(Y8 + (size_t)pp.z * 1024 + k), w3 = *(const int*)(Y8 + (size_t)pp.w * 1024 + k);
            const f32x2v a0 = __builtin_amdgcn_cvt_pk_f32_fp8(w0, false), a1 = __builtin_amdgcn_cvt_pk_f32_fp8(w1, false), a2 = __builtin_amdgcn_cvt_pk_f32_fp8(w2, false), a3 = __builtin_amdgcn_cvt_pk_f32_fp8(w3, false);
            const f32x2v c0 = __builtin_amdgcn_cvt_pk_f32_fp8(w0, true), c1 = __builtin_amdgcn_cvt_pk_f32_fp8(w1, true), c2 = __builtin_amdgcn_cvt_pk_f32_fp8(w2, true), c3 = __builtin_amdgcn_cvt_pk_f32_fp8(w3, true);
            h[0] += ((a0.x + a1.x) + (a2.x + a3.x)) * 0.0625f; h[1] += ((a0.y + a1.y) + (a2.y + a3.y)) * 0.0625f;
            h[2] += ((c0.x + c1.x) + (c2.x + c3.x)) * 0.0625f; h[3] += ((c0.y + c1.y) + (c2.y + c3.y)) * 0.0625f;
            v[j] = h; s += (h[0] + h[1]) + (h[2] + h[3]); }
        const float mean = wave_sum(s) * (1.0f / 1024.0f); float s2 = 0.f;
#pragma unroll
        for (int j = 0; j < 4; ++j) { v[j] = v[j] - mean; s2 += (v[j][0] * v[j][0] + v[j][1] * v[j][1]) + (v[j][2] * v[j][2] + v[j][3] * v[j][3]); }
        const float rstd = 1.0f / sqrtf(wave_sum(s2) * (1.0f / 1024.0f) + LN_EPS);
#pragma unroll
        for (int j = 0; j < 4; ++j) { const int k = 256 * j + 4 * lane; const f32x4 g4 = *(const f32x4*)(gn + k), b4 = *(const f32x4*)(bn + k);
            const f32x4 o = v[j] * rstd * g4 + b4;
            if (fout) *(f32x4*)(fout + (size_t)t * 1024 + k) = o;
            else { v2u w; w.x = pk2(o[0], o[1]); w.y = pk2(o[2], o[3]); *(v2u*)(XB + (size_t)t * 1024 + k) = w; } }
    }
}

__device__ __forceinline__ float da_lambda(const Args& a, int j, float lam_init, int lane) {
    const float q1 = a.in[I_DA_LQ1][j * 64 + lane], k1 = a.in[I_DA_LK1][j * 64 + lane], q2 = a.in[I_DA_LQ2][j * 64 + lane], k2 = a.in[I_DA_LK2][j * 64 + lane];
    return __expf(wave_sum(q1 * k1)) - __expf(wave_sum(q2 * k2)) + lam_init;
}
__device__ __forceinline__ void phase_mla_norm(const Args& a, int tid, int lane, int wave) {
    const float* C = WSP(float, WS_MISC + MLA_C); bf16* cqn = WSP(bf16, WS_MISC + MLA_CQN); bf16* ckvn = WSP(bf16, WS_MISC + MLA_CKVN); bf16* Kr = WSP(bf16, WS_MISC + MLA_KR);
    const cs_t* cs32 = WSP(cs_t, WS_CS32);
    const f32x4 gq = *(const f32x4*)(a.in[I_MLA_QN] + 4 * lane); const float gk0 = a.in[I_MLA_KVN][2 * lane], gk1 = a.in[I_MLA_KVN][2 * lane + 1];
    const int gw = blockIdx.x * NWAVES + wave, NGW = gridDim.x * NWAVES;
    for (int t = gw; t < S; t += NGW) {
        const float* row = C + (size_t)t * 512;
        const f32x4 q = *(const f32x4*)(row + 4 * lane);
        const float rq = 1.0f / sqrtf(wave_sum((q[0] * q[0] + q[1] * q[1]) + (q[2] * q[2] + q[3] * q[3])) * (1.0f / 256.0f) + RMS_EPS);
        v2u w; w.x = pk2(q[0] * rq * gq[0], q[1] * rq * gq[1]); w.y = pk2(q[2] * rq * gq[2], q[3] * rq * gq[3]); *(v2u*)(cqn + (size_t)t * 256 + 4 * lane) = w;
        const float k0 = row[256 + 2 * lane], k1 = row[256 + 2 * lane + 1];
        const float rk = 1.0f / sqrtf(wave_sum(k0 * k0 + k1 * k1) * (1.0f / 128.0f) + RMS_EPS);
        *(unsigned*)(ckvn + (size_t)t * 128 + 2 * lane) = pk2(k0 * rk * gk0, k1 * rk * gk1);
        if (lane < 16) { const float x1 = row[384 + lane], x2 = row[400 + lane]; const cs_t cs = cs32[(size_t)t * 16 + lane];
            Kr[(size_t)t * 32 + lane] = (bf16)f2bf(x1 * cs.c - x2 * cs.s); Kr[(size_t)t * 32 + 16 + lane] = (bf16)f2bf(x2 * cs.c + x1 * cs.s); }
    }
}

__device__ __forceinline__ void phase_nsa_cmp_gather(const Args& a, int tid) {
    const bf16* P = WSP(bf16, WS_MISC + NSA_P);
    const int gtid = blockIdx.x * NTHREADS + tid, GT = gridDim.x * NTHREADS;
    for (int id = gtid; id < 2 * 4096 * 256; id += GT) {
        const int c8 = id & 7, l = (id >> 3) & 31, n = (id >> 8) & 1023, g = (id >> 18) & 3, kv = id >> 20;
        bf16* dst = WSP(bf16, WS_MISC + (kv ? NSA_ACV : NSA_ACK)) + ((size_t)(g * 1024 + n) * 2048 + l * 64 + c8 * 8);
        v4u o = (v4u){0u, 0u, 0u, 0u};
        if (n < 1023) {
            const v4u x = *(const v4u*)(P + (size_t)(16 * n + l) * 768 + kv * 256 + g * 64 + c8 * 8);
            const float* pp = a.in[kv ? I_NSA_POSV : I_NSA_POSK] + l * 64 + c8 * 8;
            const f32x4 p0 = *(const f32x4*)pp, p1 = *(const f32x4*)(pp + 4);
            o.x = pk2(bflo(x.x) + p0[0], bfhi(x.x) + p0[1]); o.y = pk2(bflo(x.y) + p0[2], bfhi(x.y) + p0[3]);
            o.z = pk2(bflo(x.z) + p1[0], bfhi(x.z) + p1[1]); o.w = pk2(bflo(x.w) + p1[2], bfhi(x.w) + p1[3]);
        }
        *(v4u*)dst = o;
    }
}

struct BgConv {
    const Job* jb; LAS unsigned char* scr; int it, it_end, stride, lane, period, tick, sub; bool pending; float v[16];
    __device__ __forceinline__ void init(const Job* jb_, int nlayers, int first, int stride_, int lane_, int period_, LAS unsigned char* scr_) { jb = jb_; it = first; it_end = 12288 * nlayers; stride = stride_; lane = lane_; pending = false; period = period_; tick = 0; scr = scr_; sub = 0; }
    __device__ __forceinline__ int decode(const Job*& J, int& b, int& kb, int& nb) const {
        const int li = it / 12288, loc = it - li * 12288;
        if (loc < 8192) { J = jb + 2 * li; b = loc >> 8; const int r = loc & 255; kb = r >> 5; nb = r & 31; return 2; }
        const int i2 = loc - 8192; J = jb + 2 * li + 1; b = i2 >> 7; const int r = i2 & 127; kb = r >> 4; nb = r & 15; return 2; }
    __device__ __forceinline__ void issue() {
        if (it >= it_end) return;
        const Job* J; int b, kb, nb; const int f8 = decode(J, b, kb, nb);
        const float* W = J->src + (size_t)b * J->sbs + (size_t)(f8 == 1 ? 8 * kb + sub : 128 * kb + 16 * sub) * J->ld + 64 * nb + lane;
        const size_t rstep = (size_t)(f8 == 1 ? 64 : 1) * J->ld;
#pragma unroll
        for (int i = 0; i < 16; ++i) v[i] = __builtin_nontemporal_load(W + (size_t)i * rstep);
        pending = true; }
    __device__ __forceinline__ void retire() {
        if (!pending) return;
        const Job* J; int b, kb, nb; const bool f8 = decode(J, b, kb, nb) != 0;
        if (f8) { v4u o; int w;
            w = __builtin_amdgcn_cvt_pk_fp8_f32(v[0] * 64.f, v[1] * 64.f, 0, false); w = __builtin_amdgcn_cvt_pk_fp8_f32(v[2] * 64.f, v[3] * 64.f, w, true); o.x = (unsigned)w;
            w = __builtin_amdgcn_cvt_pk_fp8_f32(v[4] * 64.f, v[5] * 64.f, 0, false); w = __builtin_amdgcn_cvt_pk_fp8_f32(v[6] * 64.f, v[7] * 64.f, w, true); o.y = (unsigned)w;
            w = __builtin_amdgcn_cvt_pk_fp8_f32(v[8] * 64.f, v[9] * 64.f, 0, false); w = __builtin_amdgcn_cvt_pk_fp8_f32(v[10] * 64.f, v[11] * 64.f, w, true); o.z = (unsigned)w;
            w = __builtin_amdgcn_cvt_pk_fp8_f32(v[12] * 64.f, v[13] * 64.f, 0, false); w = __builtin_amdgcn_cvt_pk_fp8_f32(v[14] * 64.f, v[15] * 64.f, w, true); o.w = (unsigned)w;
            *(LAS v4u*)(scr + lane * 144 + sub * 16) = o;
        } else {
#pragma unroll
        for (int q = 0; q < 2; ++q) { v4u o; o.x = pk2(v[8 * q], v[8 * q + 1]); o.y = pk2(v[8 * q + 2], v[8 * q + 3]); o.z = pk2(v[8 * q + 4], v[8 * q + 5]); o.w = pk2(v[8 * q + 6], v[8 * q + 7]);
            *(LAS v4u*)(scr + lane * 144 + (2 * sub + q) * 16) = o; }
        }
        pending = false;
        if (sub < (f8 ? 7 : 3)) { ++sub; return; }
        asm volatile("s_waitcnt lgkmcnt(0)" ::: "memory");
        unsigned char* dstb = (unsigned char*)J->dst + (f8 ? (size_t)b * J->dbs + 128 * kb : ((size_t)b * J->dbs + 64 * kb) * 2);
        const size_t pitch = f8 ? (size_t)J->K : (size_t)J->K * 2;
        const int ln = (int)__builtin_amdgcn_mbcnt_hi(~0u, __builtin_amdgcn_mbcnt_lo(~0u, (unsigned)it)) - it;
#pragma unroll
        for (int s = 0; s < 8; ++s) { const int rl = 8 * s + (ln >> 3), ch = ln & 7;
            const v4u o = *(const LAS v4u*)(scr + rl * 144 + ch * 16);
            __builtin_nontemporal_store(o, (v4u*)(dstb + (size_t)cvt_dst_row(J->mode, 64 * nb + rl) * pitch + ch * 16)); }
        asm volatile("s_waitcnt lgkmcnt(0)" ::: "memory");
        sub = 0; it += stride; }
    __device__ __forceinline__ void begin() { if (++tick < period) return; tick = 0; issue(); }
    __device__ __forceinline__ void end() { if (tick == period - 1) retire(); }
    __device__ __forceinline__ void drain() { for (;;) { retire(); issue(); if (!pending) break; } }
};
struct BgNone { __device__ __forceinline__ void begin() {} __device__ __forceinline__ void end() {} };

#define MFMA32(A, B, C) __builtin_amdgcn_mfma_f32_32x32x16_bf16((A), (B), (C), 0, 0, 0)
#define MFMA16(A, B, C) __builtin_amdgcn_mfma_f32_16x16x32_bf16((A), (B), (C), 0, 0, 0)
__device__ __forceinline__ bf16x8 pack8(float a0, float a1, float a2, float a3, float a4, float a5, float a6, float a7) {
    v4u w; w.x = pk2(a0, a1); w.y = pk2(a2, a3); w.z = pk2(a4, a5); w.w = pk2(a6, a7); return __builtin_bit_cast(bf16x8, w);
}
__device__ __forceinline__ int pi32(int r) { return (r & ~12) | ((r & 4) << 1) | ((r & 8) >> 1); }
__device__ __forceinline__ float max3f(float a, float b, float c) { return __builtin_fmaxf(__builtin_fmaxf(a, b), c); }
__device__ __forceinline__ float max16(const f32x16& p) {
    const float a = max3f(p[0], p[1], p[2]), b = max3f(p[3], p[4], p[5]), c = max3f(p[6], p[7], p[8]), d = max3f(p[9], p[10], p[11]), e = max3f(p[12], p[13], p[14]);
    return max3f(max3f(a, b, c), max3f(d, e, p[15]), d);
}
struct AttnArgs {
    const bf16* Q0; const bf16* Q1; int ldq;
    const bf16* K0; int ldk0; const bf16* K1; int ldk1;
    const bf16* Vt; int ldv;
    bf16* O; int ldo;
    int window;
    const bf16* Qb; const bf16* Kb;
    float lam; const float* gain; float gscale;
    float kbound;
};
template <bool B> struct BoolC { static constexpr bool value = B; };
template <int DQK, int DV, bool PAIR = false, class BG = BgNone>
__device__ __forceinline__ void attn_unit(LAS unsigned char* lds, const AttnArgs& A, int q0, int tid_in, int lane_in, int wave, BG& bg) {
    const int lane = (int)__builtin_amdgcn_mbcnt_hi(~0u, __builtin_amdgcn_mbcnt_lo(~0u, (unsigned)q0)) - q0; const int tid = wave * 64 + lane; (void)tid_in; (void)lane_in;
    constexpr int KSB = (DQK + 8) * 2, VSB = 144, KBUF = 64 * KSB, BUFB = KBUF + DV * VSB;
    constexpr int NKS = DQK / 16, ND0 = DV / 32, KCH = DQK / 8;
    const int r32 = lane & 31, hi = lane >> 5;
    const int qw0 = q0 + 32 * wave, qrow = qw0 + r32;
    const int W = A.window;
    const int t_hi = (q0 >> 6) + 4;
    int t_lo = 0; if (W > 0) { const int lo = q0 - W + 1; t_lo = lo > 0 ? (lo >> 6) : 0; }
    constexpr int OA_OFF = 2 * BUFB, OA_ROWB = DV * 2 + 16;
    const bf16* Qp = A.Q0; const bf16* Kp = A.K0;
    bf16x8 qf[NKS];
    f32x16 o[ND0];
    float lsum = 0.f;
    constexpr int NKI = (64 * KCH + 511) / 512, NVI = DV * 8 / 512;
    v4u kA[NKI], vA[NVI];
    auto gload = [&](int t, v4u (&kreg)[NKI], v4u (&vreg)[NVI]) {
        const __amdgpu_buffer_rsrc_t rk0 = __builtin_amdgcn_make_buffer_rsrc((void*)Kp, 0, 0x7fffffff, 0x00020000);
        const __amdgpu_buffer_rsrc_t rk1 = __builtin_amdgcn_make_buffer_rsrc((void*)(KCH > 8 ? A.K1 : Kp), 0, 0x7fffffff, 0x00020000);
        const __amdgpu_buffer_rsrc_t rvt = __builtin_amdgcn_make_buffer_rsrc((void*)A.Vt, 0, 0x7fffffff, 0x00020000);
        const int k0s = t * 64 * A.ldk0 * 2, k1s = t * 64 * A.ldk1 * 2, vs = t * DV * 128;
#pragma unroll
        for (int i = 0; i < NKI; ++i) { const int c = tid + 512 * i;
            if ((64 * KCH) % 512 == 0 || c < 64 * KCH) { const int row = c / KCH, ch = c - row * KCH;
                if constexpr (KCH > 8) { kreg[i] = (ch < 8) ? __builtin_bit_cast(v4u, __builtin_amdgcn_raw_buffer_load_b128(rk0, (row * A.ldk0 + ch * 8) * 2, k0s, 0))
                                                            : __builtin_bit_cast(v4u, __builtin_amdgcn_raw_buffer_load_b128(rk1, (row * A.ldk1 + (ch - 8) * 8) * 2, k1s, 0)); }
                else kreg[i] = __builtin_bit_cast(v4u, __builtin_amdgcn_raw_buffer_load_b128(rk0, (row * A.ldk0 + ch * 8) * 2, k0s, 0)); } }
#pragma unroll
        for (int i = 0; i < NVI; ++i) { const int c = tid + 512 * i; vreg[i] = __builtin_bit_cast(v4u, __builtin_amdgcn_raw_buffer_load_b128(rvt, c * 16, vs, 0)); }
    };
    auto sstore = [&](int stage, const v4u (&kreg)[NKI], const v4u (&vreg)[NVI]) {
        LAS unsigned char* Kb = lds + stage * BUFB; LAS unsigned char* Vb = Kb + KBUF;
#pragma unroll
        for (int i = 0; i < NKI; ++i) { const int c = tid + 512 * i;
            if ((64 * KCH) % 512 == 0 || c < 64 * KCH) { const int row = c / KCH, ch = c - row * KCH; *(LAS v4u*)(Kb + row * KSB + ch * 16) = kreg[i]; } }
#pragma unroll
        for (int i = 0; i < NVI; ++i) { const int c = tid + 512 * i; const int row = c >> 3, ch = c & 7; *(LAS v4u*)(Vb + row * VSB + ch * 16) = vreg[i]; }
    };
    const int pr = pi32(r32);
    float mhat = 0.f;
    auto compute = [&](int t, int stage, auto ft) {
        constexpr bool FAST = decltype(ft)::value;
        const int kv0 = t * 64;
        const bool skip = (kv0 > qw0 + 31) || (W > 0 && kv0 + 63 <= qw0 - W);
        if (!skip) {
            const LAS unsigned char* Kb = lds + stage * BUFB; const LAS unsigned char* Vb = Kb + KBUF;
            f32x16 p0, p1;
#pragma unroll
            for (int r = 0; r < 16; ++r) { p0[r] = FAST ? 0.f : -mhat; p1[r] = FAST ? 0.f : -mhat; }
            bf16x8 kfr[2 * NKS];
#pragma unroll
            for (int ks = 0; ks < NKS; ++ks) { kfr[2 * ks] = *(const LAS bf16x8*)(Kb + pr * KSB + ks * 32 + hi * 16); kfr[2 * ks + 1] = *(const LAS bf16x8*)(Kb + (32 + pr) * KSB + ks * 32 + hi * 16); }
            asm volatile("s_waitcnt lgkmcnt(0)" ::: "memory");
            bf16x8 vfr[4 * ND0];
#pragma unroll
            for (int d = 0; d < ND0 / 2; ++d)
#pragma unroll
                for (int hf = 0; hf < 2; ++hf)
#pragma unroll
                    for (int jj = 0; jj < 2; ++jj) vfr[4 * d + 2 * hf + jj] = *(const LAS bf16x8*)(Vb + (32 * d + r32) * VSB + (32 * hf + 16 * jj + 8 * hi) * 2);
            __builtin_amdgcn_sched_barrier(0);
#pragma unroll
            for (int ks = 0; ks < NKS; ++ks) { p0 = MFMA32(kfr[2 * ks], qf[ks], p0); p1 = MFMA32(kfr[2 * ks + 1], qf[ks], p1); }
            __builtin_amdgcn_sched_barrier(0);
#pragma unroll
            for (int d = ND0 / 2; d < ND0; ++d)
#pragma unroll
                for (int hf = 0; hf < 2; ++hf)
#pragma unroll
                    for (int jj = 0; jj < 2; ++jj) vfr[4 * d + 2 * hf + jj] = *(const LAS bf16x8*)(Vb + (32 * d + r32) * VSB + (32 * hf + 16 * jj + 8 * hi) * 2);
            __builtin_amdgcn_sched_barrier(0);
            const bool need_mask = (kv0 + 63 > qw0) || (W > 0 && kv0 <= qw0 + 31 - W);
            if (need_mask) {
#pragma unroll
                for (int r = 0; r < 16; ++r) { const int kv = kv0 + 16 * (r >> 3) + 8 * hi + (r & 7);
                    const bool v0 = (kv <= qrow) && (W == 0 || kv > qrow - W), v1 = (kv + 32 <= qrow) && (W == 0 || kv + 32 > qrow - W);
                    p0[r] = v0 ? p0[r] : -INFINITY; p1[r] = v1 ? p1[r] : -INFINITY; }
            }
            if constexpr (!FAST) {
            float mx = fmaxf(max16(p0), max16(p1)); mx = fmaxf(mx, swap32f(mx, hi));
            const bool move = (mx > 8.0f) || (lsum == 0.f && mx != 0.f && mx != -INFINITY);
            if (__any(move)) {
                const float d = move ? mx : 0.f; const float alpha = __builtin_amdgcn_exp2f(-d);
                mhat += d; lsum *= alpha;
#pragma unroll
                for (int r = 0; r < 16; ++r) { p0[r] -= d; p1[r] -= d; }
#pragma unroll
                for (int d0 = 0; d0 < ND0; ++d0)
#pragma unroll
                    for (int r = 0; r < 16; ++r) o[d0][r] *= alpha;
            }
            }
#pragma unroll
            for (int r = 0; r < 16; ++r) { p0[r] = __builtin_amdgcn_exp2f(p0[r]); p1[r] = __builtin_amdgcn_exp2f(p1[r]); }
            lsum += sum32pk(p0, p1);
            bf16x8 pf[2][2];
            pf[0][0] = pack8(p0[0], p0[1], p0[2], p0[3], p0[4], p0[5], p0[6], p0[7]); pf[0][1] = pack8(p0[8], p0[9], p0[10], p0[11], p0[12], p0[13], p0[14], p0[15]);
            pf[1][0] = pack8(p1[0], p1[1], p1[2], p1[3], p1[4], p1[5], p1[6], p1[7]); pf[1][1] = pack8(p1[8], p1[9], p1[10], p1[11], p1[12], p1[13], p1[14], p1[15]);
            asm volatile("s_waitcnt lgkmcnt(0)" ::: "memory");
#pragma unroll
            for (int d = 0; d < ND0; ++d)
#pragma unroll
                for (int hf = 0; hf < 2; ++hf)
#pragma unroll
                    for (int jj = 0; jj < 2; ++jj) o[d] = MFMA32(vfr[4 * d + 2 * hf + jj], pf[hf][jj], o[d]);
        }
    };
    for (int pass = 0; pass < (PAIR ? 2 : 1); ++pass) {
        if (PAIR && pass) { Qp = A.Qb; Kp = A.Kb; }
#pragma unroll
        for (int ks = 0; ks < NKS; ++ks) { if (ks < 4) qf[ks] = *(const bf16x8*)(Qp + (size_t)qrow * A.ldq + ks * 16 + hi * 8); else qf[ks] = *(const bf16x8*)(A.Q1 + (size_t)qrow * A.ldq + (ks - 4) * 16 + hi * 8); }
#pragma unroll
        for (int d = 0; d < ND0; ++d)
#pragma unroll
            for (int r = 0; r < 16; ++r) o[d][r] = 0.f;
        lsum = 0.f; mhat = 0.f;
        gload(t_lo, kA, vA); sstore(0, kA, vA); if (t_lo + 1 < t_hi) gload(t_lo + 1, kA, vA); __syncthreads();
#pragma unroll
        for (int ks = 0; ks < NKS; ++ks) asm volatile("" :: "v"(qf[ks]));
        float q2n = 0.f;
#pragma unroll
        for (int ks = 0; ks < NKS; ++ks) { const v4u w = __builtin_bit_cast(v4u, qf[ks]);
            q2n += (bflo(w.x) * bflo(w.x) + bfhi(w.x) * bfhi(w.x)) + (bflo(w.y) * bflo(w.y) + bfhi(w.y) * bfhi(w.y))
                 + (bflo(w.z) * bflo(w.z) + bfhi(w.z) * bfhi(w.z)) + (bflo(w.w) * bflo(w.w) + bfhi(w.w) * bfhi(w.w)); }
        q2n += swap32f(q2n, hi);
        const bool fast = !__any(!(q2n * A.kbound <= 4096.0f));
        auto run = [&](auto ft) {
        for (int t = t_lo; t < t_hi; ++t) {
            const int buf = (t - t_lo) & 1;
            if (t + 1 < t_hi) sstore(buf ^ 1, kA, vA);
            if (t + 2 < t_hi) gload(t + 2, kA, vA);
            constexpr bool HOST = decltype(ft)::value;
            if constexpr (HOST) bg.begin();
            compute(t, buf, ft);
            if constexpr (HOST) bg.end();
            __syncthreads();
        } };
        if (fast) run(BoolC<true>{}); else run(BoolC<false>{});
        if (PAIR && pass == 0) {
            const float lt0 = lsum + swap32f(lsum, hi); const float inv0 = lt0 > 0.f ? 1.0f / lt0 : 0.f;
            LAS unsigned char* oa = lds + OA_OFF + (32 * wave + r32) * OA_ROWB + 8 * hi;
#pragma unroll
            for (int d = 0; d < ND0; ++d)
#pragma unroll
                for (int g4 = 0; g4 < 4; ++g4) { v2u w; w.x = pk2(o[d][4 * g4] * inv0, o[d][4 * g4 + 1] * inv0); w.y = pk2(o[d][4 * g4 + 2] * inv0, o[d][4 * g4 + 3] * inv0);
                    *(LAS v2u*)(oa + (32 * d + 8 * g4) * 2) = w; }
        }
    }
    const float lt = lsum + swap32f(lsum, hi); const float inv = lt > 0.f ? 1.0f / lt : 0.f;
    const int dep_e = __builtin_amdgcn_readfirstlane(__builtin_bit_cast(int, lt));
    const int lane_e = (int)__builtin_amdgcn_mbcnt_hi(~0u, __builtin_amdgcn_mbcnt_lo(~0u, (unsigned)dep_e)) - dep_e;
    bf16* orow = A.O + (size_t)(qw0 + (lane_e & 31)) * A.ldo - 4 * hi + 4 * (lane_e >> 5);
    if constexpr (PAIR) {
        const LAS unsigned char* oa = lds + OA_OFF + (32 * wave + r32) * OA_ROWB + 8 * hi;
        float ss = 0.f;
#pragma unroll
        for (int d = 0; d < ND0; ++d)
#pragma unroll
            for (int g4 = 0; g4 < 4; ++g4) { const v2u w = *(const LAS v2u*)(oa + (32 * d + 8 * g4) * 2);
                const float d0 = bflo(w.x) - A.lam * (o[d][4 * g4] * inv), d1 = bfhi(w.x) - A.lam * (o[d][4 * g4 + 1] * inv), d2 = bflo(w.y) - A.lam * (o[d][4 * g4 + 2] * inv), d3 = bfhi(w.y) - A.lam * (o[d][4 * g4 + 3] * inv);
                o[d][4 * g4] = d0; o[d][4 * g4 + 1] = d1; o[d][4 * g4 + 2] = d2; o[d][4 * g4 + 3] = d3; ss += (d0 * d0 + d1 * d1) + (d2 * d2 + d3 * d3); }
        ss += swap32f(ss, hi);
        const float rr = A.gscale / sqrtf(ss * (1.0f / DV) + LN_EPS);
#pragma unroll
        for (int d = 0; d < ND0; ++d)
#pragma unroll
            for (int g4 = 0; g4 < 4; ++g4) { const f32x4 gg = *(const f32x4*)(A.gain + 32 * d + 8 * g4 + 4 * hi);
                v2u w; w.x = pk2(o[d][4 * g4] * rr * gg[0], o[d][4 * g4 + 1] * rr * gg[1]); w.y = pk2(o[d][4 * g4 + 2] * rr * gg[2], o[d][4 * g4 + 3] * rr * gg[3]);
                *(v2u*)(orow + 32 * d + 8 * g4 + 4 * hi) = w; }
    } else {
#pragma unroll
    for (int d = 0; d < ND0; ++d)
#pragma unroll
        for (int g4 = 0; g4 < 4; ++g4) { v2u w; w.x = pk2(o[d][4 * g4] * inv, o[d][4 * g4 + 1] * inv); w.y = pk2(o[d][4 * g4 + 2] * inv, o[d][4 * g4 + 3] * inv);
            *(v2u*)(orow + 32 * d + 8 * g4 + 4 * hi) = w; }
    }
}

constexpr int CMP_IMP_B = 64 * 257 * 4, CMP_KB = 64 * 144;
__device__ __forceinline__ float quad_sum(float v) {
    v += __builtin_bit_cast(float, __builtin_amdgcn_update_dpp(0, __builtin_bit_cast(int, v), 0xB1, 0xF, 0xF, true));
    v += __builtin_bit_cast(float, __builtin_amdgcn_update_dpp(0, __builtin_bit_cast(int, v), 0x4E, 0xF, 0xF, true));
    return v;
}
__device__ __forceinline__ void nsa_cmp_unit(LAS unsigned char* lds, const Args& a, int T, int g, int tid_in, int lane_in, int wave, float kbound) {
    const int lane = (int)__builtin_amdgcn_mbcnt_hi(~0u, __builtin_amdgcn_mbcnt_lo(~0u, (unsigned)T)) - T; const int tid = wave * 64 + lane; (void)tid_in; (void)lane_in;
    const bf16* R = WSP(bf16, WS_QK); const bf16* Kc = WSP(bf16, WS_MISC + NSA_KC); const bf16* VcT = WSP(bf16, WS_MISC + NSA_VCT);
    bf16* Oc = WSP(bf16, WS_OH); unsigned* selm = WSP(unsigned, WS_MISC + NSA_SEL);
    const int r32 = lane & 31, hi = lane >> 5, q0 = 64 * T;
    const int ql = 8 * wave + (r32 >> 2), hd = r32 & 3, h = 4 * g + hd, qrow = q0 + ql;
    const int nlim = (qrow >= 31) ? ((qrow - 31) >> 4) : -1;
    const int qw_lo = q0 + 8 * wave, qw_hi = qw_lo + 7;
    const int nlim_lo = (qw_lo >= 31) ? ((qw_lo - 31) >> 4) : -1, nlim_hi = (qw_hi >= 31) ? ((qw_hi - 31) >> 4) : -1;
    const int NT = (((q0 + 32) >> 4) >> 6) + 1;
    LAS float* imp = (LAS float*)lds;
    LAS unsigned char* kb0 = lds + CMP_IMP_B; LAS unsigned char* vb0 = kb0 + 2 * CMP_KB;
    for (int i = tid; i < 64 * 257; i += NTHREADS) imp[i] = 0.f;
    bf16x8 qf[4];
#pragma unroll
    for (int ks = 0; ks < 4; ++ks) qf[ks] = *(const bf16x8*)(R + (size_t)qrow * 1024 + 64 * h + ks * 16 + hi * 8);
    const int pr = pi32(r32);
    const int lrow = tid >> 3, lch = tid & 7;
    const bf16* Ksrc = Kc + (size_t)(g * 1024) * 64 + tid * 8;
    const bf16* Vsrc = VcT + (size_t)lrow * 4096 + g * 1024 + lch * 8;
    const int soff = lrow * 144 + lch * 16;
    v4u kreg, vreg;
    float mhat = 0.f, lsum = 0.f;
    auto qk = [&](const LAS unsigned char* Kb, int n0, f32x16& p0, f32x16& p1, auto ft) {
        constexpr bool FAST = decltype(ft)::value;
#pragma unroll
        for (int r = 0; r < 16; ++r) { p0[r] = FAST ? 0.f : -mhat; p1[r] = FAST ? 0.f : -mhat; }
        bf16x8 kfr[8];
#pragma unroll
        for (int ks = 0; ks < 4; ++ks) { kfr[2 * ks] = *(const LAS bf16x8*)(Kb + pr * 144 + ks * 32 + hi * 16); kfr[2 * ks + 1] = *(const LAS bf16x8*)(Kb + (32 + pr) * 144 + ks * 32 + hi * 16); }
        asm volatile("s_waitcnt lgkmcnt(0)" ::: "memory");
        __builtin_amdgcn_sched_barrier(0);
#pragma unroll
        for (int ks = 0; ks < 4; ++ks) { p0 = MFMA32(kfr[2 * ks], qf[ks], p0); p1 = MFMA32(kfr[2 * ks + 1], qf[ks], p1); }
        if (n0 + 63 > nlim_lo) {
#pragma unroll
            for (int r = 0; r < 16; ++r) { const int n = n0 + 16 * (r >> 3) + 8 * hi + (r & 7); p0[r] = (n <= nlim) ? p0[r] : -INFINITY; p1[r] = (n + 32 <= nlim) ? p1[r] : -INFINITY; }
        }
    };
    kreg = *(const v4u*)Ksrc; *(LAS v4u*)(kb0 + soff) = kreg; if (1 < NT) kreg = *(const v4u*)(Ksrc + 4096); __syncthreads();
#pragma unroll
    for (int ks = 0; ks < 4; ++ks) asm volatile("" :: "v"(qf[ks]));
    float q2n = 0.f;
#pragma unroll
    for (int ks = 0; ks < 4; ++ks) { const v4u w = __builtin_bit_cast(v4u, qf[ks]);
        q2n += (bflo(w.x) * bflo(w.x) + bfhi(w.x) * bfhi(w.x)) + (bflo(w.y) * bflo(w.y) + bfhi(w.y) * bfhi(w.y))
             + (bflo(w.z) * bflo(w.z) + bfhi(w.z) * bfhi(w.z)) + (bflo(w.w) * bflo(w.w) + bfhi(w.w) * bfhi(w.w)); }
    q2n += swap32f(q2n, hi);
    const bool fast = !__any(!(q2n * kbound <= 4096.0f));
    auto pass1 = [&](auto ft) {
    constexpr bool FAST = decltype(ft)::value;
    for (int t = 0; t < NT; ++t) {
        const int buf = t & 1, n0 = 64 * t;
        if (t + 1 < NT) *(LAS v4u*)(kb0 + (buf ^ 1) * CMP_KB + soff) = kreg;
        if (t + 2 < NT) kreg = *(const v4u*)(Ksrc + (size_t)(t + 2) * 4096);
        if (n0 <= nlim_hi) {
            f32x16 p0, p1; qk(kb0 + buf * CMP_KB, n0, p0, p1, ft);
            if constexpr (!FAST) {
            float mx = fmaxf(max16(p0), max16(p1)); mx = fmaxf(mx, swap32f(mx, hi));
            const bool move = (mx > 8.0f) || (lsum == 0.f && mx != 0.f && mx != -INFINITY);
            if (__any(move)) { const float d = move ? mx : 0.f; mhat += d; lsum *= __builtin_amdgcn_exp2f(-d);
#pragma unroll
                for (int r = 0; r < 16; ++r) { p0[r] -= d; p1[r] -= d; } }
            }
#pragma unroll
            for (int r = 0; r < 16; ++r) { p0[r] = __builtin_amdgcn_exp2f(p0[r]); p1[r] = __builtin_amdgcn_exp2f(p1[r]); }
            lsum += sum32pk(p0, p1);
        }
        __syncthreads();
    } };
    if (fast) pass1(BoolC<true>{}); else pass1(BoolC<false>{});
    const float lt = lsum + swap32f(lsum, hi); const float inv = lt > 0.f ? 1.0f / lt : 0.f;
    f32x16 o[2];
#pragma unroll
    for (int d = 0; d < 2; ++d)
#pragma unroll
        for (int r = 0; r < 16; ++r) o[d][r] = 0.f;
    kreg = *(const v4u*)Ksrc; vreg = *(const v4u*)Vsrc;
    *(LAS v4u*)(kb0 + soff) = kreg; *(LAS v4u*)(vb0 + soff) = vreg;
    if (1 < NT) { kreg = *(const v4u*)(Ksrc + 4096); vreg = *(const v4u*)(Vsrc + 64); }
    __syncthreads();
    LAS float* irow = imp + ql * 257 + 4 * hd + 2 * hi;
    for (int t = 0; t < NT; ++t) {
        const int buf = t & 1, n0 = 64 * t;
        if (t + 1 < NT) { *(LAS v4u*)(kb0 + (buf ^ 1) * CMP_KB + soff) = kreg; *(LAS v4u*)(vb0 + (buf ^ 1) * CMP_KB + soff) = vreg; }
        if (t + 2 < NT) { kreg = *(const v4u*)(Ksrc + (size_t)(t + 2) * 4096); vreg = *(const v4u*)(Vsrc + 64 * (t + 2)); }
        if (n0 <= nlim_hi) {
            const LAS unsigned char* Vb = vb0 + buf * CMP_KB;
            f32x16 p0, p1; qk(kb0 + buf * CMP_KB, n0, p0, p1, BoolC<false>{});
            bf16x8 vfr[8];
#pragma unroll
            for (int d = 0; d < 2; ++d)
#pragma unroll
                for (int q = 0; q < 4; ++q) vfr[4 * d + q] = *(const LAS bf16x8*)(Vb + (32 * d + r32) * 144 + (16 * q + 8 * hi) * 2);
#pragma unroll
            for (int r = 0; r < 16; ++r) { p0[r] = __builtin_amdgcn_exp2f(p0[r]) * inv; p1[r] = __builtin_amdgcn_exp2f(p1[r]) * inv; }
            float s0[4], s1[4], s2[4];
#pragma unroll
            for (int gq = 0; gq < 4; ++gq) { const f32x16& p = (gq >> 1) ? p1 : p0; const int b8 = 8 * (gq & 1);
                s0[gq] = quad_sum(2.f * (p[b8] + p[b8 + 1] + p[b8 + 2]) + p[b8 + 3]);
                s1[gq] = quad_sum(p[b8 + 3] + 2.f * (p[b8 + 4] + p[b8 + 5] + p[b8 + 6]) + p[b8 + 7]);
                s2[gq] = quad_sum(p[b8 + 7]); }
            const float a0 = hd == 0 ? s0[0] : hd == 1 ? s0[1] : hd == 2 ? s0[2] : s0[3];
            const float a1 = hd == 0 ? s1[0] : hd == 1 ? s1[1] : hd == 2 ? s1[2] : s1[3];
            const float a2 = hd == 0 ? s2[0] : hd == 1 ? s2[1] : hd == 2 ? s2[2] : s2[3];
            LAS float* ip = irow + (n0 >> 2);
            { const float x0 = ip[0], x1 = ip[1]; ip[0] = x0 + a0; ip[1] = x1 + a1; }
            asm volatile("s_waitcnt lgkmcnt(0)" ::: "memory");
            { const float x2 = ip[2]; ip[2] = x2 + a2; }
            bf16x8 pf[4];
            pf[0] = pack8(p0[0], p0[1], p0[2], p0[3], p0[4], p0[5], p0[6], p0[7]); pf[1] = pack8(p0[8], p0[9], p0[10], p0[11], p0[12], p0[13], p0[14], p0[15]);
            pf[2] = pack8(p1[0], p1[1], p1[2], p1[3], p1[4], p1[5], p1[6], p1[7]); pf[3] = pack8(p1[8], p1[9], p1[10], p1[11], p1[12], p1[13], p1[14], p1[15]);
            asm volatile("s_waitcnt lgkmcnt(0)" ::: "memory");
#pragma unroll
            for (int d = 0; d < 2; ++d)
#pragma unroll
                for (int q = 0; q < 4; ++q) o[d] = MFMA32(vfr[4 * d + q], pf[q], o[d]);
        }
        __syncthreads();
    }
    { bf16* orow = Oc + (size_t)qrow * 1024 + 64 * h;
#pragma unroll
      for (int d = 0; d < 2; ++d)
#pragma unroll
          for (int g4 = 0; g4 < 4; ++g4) { v2u w; w.x = pk2(o[d][4 * g4], o[d][4 * g4 + 1]); w.y = pk2(o[d][4 * g4 + 2], o[d][4 * g4 + 3]); *(v2u*)(orow + 32 * d + 8 * g4 + 4 * hi) = w; } }
    for (int i = 0; i < 8; ++i) {
        const int qq = 8 * wave + i;
        unsigned kb[4]; bool selb[4], cand[4];
#pragma unroll
        for (int s = 0; s < 4; ++s) { const int j = lane + 64 * s; selb[s] = (j <= T) && (T <= 15 || j == 0 || j >= T - 1);
            cand[s] = (T > 15) && (j >= 1) && (j <= T - 2);
            kb[s] = cand[s] ? __float_as_uint(imp[qq * 257 + j]) : 0u; }
        if (T > 15) {
            unsigned prefix = 0u;
            for (int b = 30; b >= 0; --b) { const unsigned t = prefix | (1u << b);
                const int cnt = __popcll(__ballot(cand[0] && kb[0] >= t)) + __popcll(__ballot(cand[1] && kb[1] >= t)) + __popcll(__ballot(cand[2] && kb[2] >= t)) + __popcll(__ballot(cand[3] && kb[3] >= t));
                if (cnt >= 13) prefix = t; }
            const int ngt = __popcll(__ballot(cand[0] && kb[0] > prefix)) + __popcll(__ballot(cand[1] && kb[1] > prefix)) + __popcll(__ballot(cand[2] && kb[2] > prefix)) + __popcll(__ballot(cand[3] && kb[3] > prefix));
            const int need = 13 - ngt; int running = 0;
#pragma unroll
            for (int s = 0; s < 4; ++s) { const bool eq = cand[s] && kb[s] == prefix; const unsigned long long mk = __ballot(eq);
                const int rank = running + (int)__builtin_amdgcn_mbcnt_hi((unsigned)(mk >> 32), __builtin_amdgcn_mbcnt_lo((unsigned)mk, 0u));
                if (cand[s] && (kb[s] > prefix || (eq && rank < need))) selb[s] = true;
                running += __popcll(mk); }
        }
        const unsigned long long m0 = __ballot(selb[0]), m1 = __ballot(selb[1]), m2 = __ballot(selb[2]), m3 = __ballot(selb[3]);
        if (lane == 0) { unsigned* dst = selm + ((size_t)(q0 + qq) * 4 + g) * 8;
            *(v4u*)dst = (v4u){(unsigned)m0, (unsigned)(m0 >> 32), (unsigned)m1, (unsigned)(m1 >> 32)};
            *(v4u*)(dst + 4) = (v4u){(unsigned)m2, (unsigned)(m2 >> 32), (unsigned)m3, (unsigned)(m3 >> 32)}; }
    }
    __syncthreads();
}

__device__ __forceinline__ void nsa_sel_unit(LAS unsigned char* lds, const Args& a, int T, int g, int tid_in, int lane_in, int wave, float kbound) {
    const int lane = (int)__builtin_amdgcn_mbcnt_hi(~0u, __builtin_amdgcn_mbcnt_lo(~0u, (unsigned)T)) - T; const int tid = wave * 64 + lane; (void)tid_in; (void)lane_in;
    const bf16* R = WSP(bf16, WS_QK); const bf16* VT = WSP(bf16, WS_VT); const bf16* P = WSP(bf16, WS_MISC + NSA_P);
    const bf16* Oc = WSP(bf16, WS_OH); const bf16* Ow = WSP(bf16, WS_OH + 32 * MiB); bf16* Ao = WSP(bf16, WS_AO);
    const unsigned* selm = WSP(unsigned, WS_MISC + NSA_SEL);
    constexpr int KSB = 144, VSB = 144, KBUF = 64 * KSB, BUFB = 2 * KBUF;
    const int r32 = lane & 31, hi = lane >> 5, q0 = 64 * T;
    const int ql = 8 * wave + (r32 >> 2), hd = r32 & 3, h = 4 * g + hd, qrow = q0 + ql;
    bf16x8 qf[4];
#pragma unroll
    for (int ks = 0; ks < 4; ++ks) qf[ks] = *(const bf16x8*)(R + (size_t)qrow * 1024 + 64 * h + ks * 16 + hi * 8);
    const unsigned* selp = selm + ((size_t)qrow * 4 + g) * 8; unsigned selw = 0u;
    const v4u sm0 = *(const v4u*)selp, sm1 = *(const v4u*)(selp + 4);
    f32x16 o[2];
#pragma unroll
    for (int d = 0; d < 2; ++d)
#pragma unroll
        for (int r = 0; r < 16; ++r) o[d][r] = 0.f;
    float lsum = 0.f, mhat = 0.f;
    const int lrow = tid >> 3, lch = tid & 7, soff = lrow * 144 + lch * 16;
    const bf16* Ksrc = WSP(bf16, WS_KH) + (size_t)g * S * 64 + tid * 8; const bf16* Vsrc = VT + (size_t)g * S * 64 + tid * 8;
    v4u kA, vA, kB, vB, kC, vC;
    const int NP = T / 3 + 1;
    kA = *(const v4u*)Ksrc; vA = *(const v4u*)Vsrc;
    *(LAS v4u*)(lds + soff) = kA; *(LAS v4u*)(lds + KBUF + soff) = vA;
    if (1 <= T) { kB = *(const v4u*)(Ksrc + 4096); vB = *(const v4u*)(Vsrc + 4096); *(LAS v4u*)(lds + BUFB + soff) = kB; *(LAS v4u*)(lds + BUFB + KBUF + soff) = vB; }
    if (2 <= T) { kC = *(const v4u*)(Ksrc + 2 * 4096); vC = *(const v4u*)(Vsrc + 2 * 4096); *(LAS v4u*)(lds + 2 * BUFB + soff) = kC; *(LAS v4u*)(lds + 2 * BUFB + KBUF + soff) = vC; }
    if (3 <= T) { kA = *(const v4u*)(Ksrc + 3 * 4096); vA = *(const v4u*)(Vsrc + 3 * 4096); }
    if (4 <= T) { kB = *(const v4u*)(Ksrc + 4 * 4096); vB = *(const v4u*)(Vsrc + 4 * 4096); }
    if (5 <= T) { kC = *(const v4u*)(Ksrc + 5 * 4096); vC = *(const v4u*)(Vsrc + 5 * 4096); }
    __syncthreads();
#pragma unroll
    for (int ks = 0; ks < 4; ++ks) asm volatile("" :: "v"(qf[ks]));
    LAS unsigned* smk = (LAS unsigned*)(lds + 6 * BUFB) + tid * 8;
    *(LAS v4u*)smk = sm0; *(LAS v4u*)(smk + 4) = sm1;
    const int pr = pi32(r32);
    auto compute = [&](int j, int boff, auto ft) {
        constexpr bool FAST = decltype(ft)::value;
        if ((j & 31) == 0) selw = smk[j >> 5];
        const bool mine = (selw >> (j & 31)) & 1u;
        if (__any(mine)) {
            const LAS unsigned char* Kb = lds + boff; const LAS unsigned char* Vb = Kb + KBUF;
            f32x16 p0, p1;
            { const float init = mine ? (FAST ? 0.f : -mhat) : -INFINITY;
#pragma unroll
              for (int r = 0; r < 16; ++r) { p0[r] = init; p1[r] = init; } }
            bf16x8 kfr[8];
#pragma unroll
            for (int ks = 0; ks < 4; ++ks) { kfr[2 * ks] = *(const LAS bf16x8*)(Kb + pr * KSB + ks * 32 + hi * 16); kfr[2 * ks + 1] = *(const LAS bf16x8*)(Kb + (32 + pr) * KSB + ks * 32 + hi * 16); }
            asm volatile("s_waitcnt lgkmcnt(0)" ::: "memory");
            bf16x8 vfr[8];
#pragma unroll
            for (int d = 0; d < 2; ++d)
#pragma unroll
                for (int hf = 0; hf < 2; ++hf)
#pragma unroll
                    for (int jj = 0; jj < 2; ++jj) vfr[4 * d + 2 * hf + jj] = *(const LAS bf16x8*)(Vb + (32 * d + r32) * VSB + (32 * hf + 16 * jj + 8 * hi) * 2);
            __builtin_amdgcn_sched_barrier(0);
#pragma unroll
            for (int ks = 0; ks < 4; ++ks) { p0 = MFMA32(kfr[2 * ks], qf[ks], p0); p1 = MFMA32(kfr[2 * ks + 1], qf[ks], p1); }
            if (j == T) {
#pragma unroll
                for (int r = 0; r < 16; ++r) { const int kvl = 16 * (r >> 3) + 8 * hi + (r & 7);
                    p0[r] = (kvl <= ql) ? p0[r] : -INFINITY; p1[r] = (kvl + 32 <= ql) ? p1[r] : -INFINITY; }
            }
            if constexpr (!FAST) {
            float mx = fmaxf(max16(p0), max16(p1)); mx = fmaxf(mx, swap32f(mx, hi));
            const bool move = (mx > 8.0f) || (lsum == 0.f && mx != 0.f && mx != -INFINITY);
            if (__any(move)) {
                const float d = move ? mx : 0.f; const float alpha = __builtin_amdgcn_exp2f(-d);
                mhat += d; lsum *= alpha;
#pragma unroll
                for (int r = 0; r < 16; ++r) { p0[r] -= d; p1[r] -= d; }
#pragma unroll
                for (int d0 = 0; d0 < 2; ++d0)
#pragma unroll
                    for (int r = 0; r < 16; ++r) o[d0][r] *= alpha;
            }
            }
#pragma unroll
            for (int r = 0; r < 16; ++r) { p0[r] = __builtin_amdgcn_exp2f(p0[r]); p1[r] = __builtin_amdgcn_exp2f(p1[r]); }
            lsum += sum32pk(p0, p1);
            bf16x8 pf[2][2];
            pf[0][0] = pack8(p0[0], p0[1], p0[2], p0[3], p0[4], p0[5], p0[6], p0[7]); pf[0][1] = pack8(p0[8], p0[9], p0[10], p0[11], p0[12], p0[13], p0[14], p0[15]);
            pf[1][0] = pack8(p1[0], p1[1], p1[2], p1[3], p1[4], p1[5], p1[6], p1[7]); pf[1][1] = pack8(p1[8], p1[9], p1[10], p1[11], p1[12], p1[13], p1[14], p1[15]);
            asm volatile("s_waitcnt lgkmcnt(0)" ::: "memory");
#pragma unroll
            for (int d = 0; d < 2; ++d)
#pragma unroll
                for (int hf = 0; hf < 2; ++hf)
#pragma unroll
                    for (int jj = 0; jj < 2; ++jj) o[d] = MFMA32(vfr[4 * d + 2 * hf + jj], pf[hf][jj], o[d]);
        }
    };
    float q2n = 0.f;
#pragma unroll
    for (int ks = 0; ks < 4; ++ks) { const v4u w = __builtin_bit_cast(v4u, qf[ks]);
        q2n += (bflo(w.x) * bflo(w.x) + bfhi(w.x) * bfhi(w.x)) + (bflo(w.y) * bflo(w.y) + bfhi(w.y) * bfhi(w.y))
             + (bflo(w.z) * bflo(w.z) + bfhi(w.z) * bfhi(w.z)) + (bflo(w.w) * bflo(w.w) + bfhi(w.w) * bfhi(w.w)); }
    q2n += swap32f(q2n, hi);
    const bool fast = !__any(!(q2n * kbound <= 4096.0f));
    auto run = [&](auto ft) {
    for (int jp = 0; jp < NP; ++jp) {
        const int so = (jp & 1) * (3 * BUFB), sn = 3 * BUFB - so;
        const int j0 = 3 * jp;
        if (j0 + 3 <= T) { *(LAS v4u*)(lds + sn + soff) = kA; *(LAS v4u*)(lds + sn + KBUF + soff) = vA; }
        if (j0 + 4 <= T) { *(LAS v4u*)(lds + sn + BUFB + soff) = kB; *(LAS v4u*)(lds + sn + BUFB + KBUF + soff) = vB; }
        if (j0 + 5 <= T) { *(LAS v4u*)(lds + sn + 2 * BUFB + soff) = kC; *(LAS v4u*)(lds + sn + 2 * BUFB + KBUF + soff) = vC; }
        if (j0 + 6 <= T) { kA = *(const v4u*)(Ksrc + (size_t)(j0 + 6) * 4096); vA = *(const v4u*)(Vsrc + (size_t)(j0 + 6) * 4096); }
        if (j0 + 7 <= T) { kB = *(const v4u*)(Ksrc + (size_t)(j0 + 7) * 4096); vB = *(const v4u*)(Vsrc + (size_t)(j0 + 7) * 4096); }
        if (j0 + 8 <= T) { kC = *(const v4u*)(Ksrc + (size_t)(j0 + 8) * 4096); vC = *(const v4u*)(Vsrc + (size_t)(j0 + 8) * 4096); }
        compute(j0, so, ft);
        if (j0 + 1 <= T) compute(j0 + 1, so + BUFB, ft);
        if (j0 + 2 <= T) compute(j0 + 2, so + 2 * BUFB, ft);
        __syncthreads();
    } };
    if (fast) run(BoolC<true>{}); else run(BoolC<false>{});
    { const float lt = lsum + swap32f(lsum, hi); const float inv = lt > 0.f ? 1.0f / lt : 0.f;
      const size_t rb = (size_t)qrow * 1024 + 64 * h;
      const bf16* gp = P + (size_t)qrow * 768 + 512 + 3 * h;
      const float g0 = 1.0f / (1.0f + __expf(-bf2f(gp[0]))), g1 = inv / (1.0f + __expf(-bf2f(gp[1]))), g2 = 1.0f / (1.0f + __expf(-bf2f(gp[2])));
#pragma unroll
      for (int d = 0; d < 2; ++d)
#pragma unroll
          for (int g4 = 0; g4 < 4; ++g4) { const int dv = 32 * d + 8 * g4 + 4 * hi;
              const v2u wc = *(const v2u*)(Oc + rb + dv), ww = *(const v2u*)(Ow + rb + dv);
              v2u w; w.x = pk2(g0 * bflo(wc.x) + g1 * o[d][4 * g4] + g2 * bflo(ww.x), g0 * bfhi(wc.x) + g1 * o[d][4 * g4 + 1] + g2 * bfhi(ww.x));
              w.y = pk2(g0 * bflo(wc.y) + g1 * o[d][4 * g4 + 2] + g2 * bflo(ww.y), g0 * bfhi(wc.y) + g1 * o[d][4 * g4 + 3] + g2 * bfhi(ww.y));
              *(v2u*)(Ao + rb + dv) = w; } }
}
#ifndef REP
#define REP 0
#endif
#define REPN(bit) (((REP >> (bit)) & 1) ? 2 : 1)
struct Ctx { LAS unsigned char* lds; LAS unsigned* lc; int wave, G, cb; XcdBarrier bar; int ph; };
#define RUN (c.ph >= a.ph_lo && c.ph < a.ph_hi)
#define LANE_ID(K) ((int)__builtin_amdgcn_mbcnt_hi(~0u, __builtin_amdgcn_mbcnt_lo(~0u, (unsigned)(K))) - (K))
#define IDS_(K) const int wave = c.wave; const int lane = LANE_ID(K); const int tid = wave * 64 + lane; (void)lane; (void)tid
#define IDS_T const int tid = threadIdx.x, lane = tid & 63, wave = c.wave; (void)lane; (void)tid
#define IDS_M IDS_(c.ph + 1)
#ifndef MSEL
#define MSEL 31
#endif
#if (MSEL >> 0) & 1
#define IDS0 IDS_M
#else
#define IDS0 IDS_T
#endif
#if (MSEL >> 1) & 1
#define IDS1 IDS_M
#else
#define IDS1 IDS_T
#endif
#if (MSEL >> 2) & 1
#define IDS2 IDS_M
#else
#define IDS2 IDS_T
#endif
#if (MSEL >> 3) & 1
#define IDS3 IDS_M
#else
#define IDS3 IDS_T
#endif
#if (MSEL >> 4) & 1
#define IDS4 IDS_M
#else
#define IDS4 IDS_T
#endif

#define SEAM() do { if (RUN && c.ph + 1 < a.ph_hi) xcd_barrier(c.bar, c.wave * 64 + LANE_ID(c.ph + 77)); ++c.ph; } while (0)
#define CTX_LOCALS LAS unsigned char* lds = c.lds; LAS unsigned* lc = c.lc; const int G = c.G, cb = c.cb; (void)lc; (void)lds; (void)G; (void)cb; \
    const float QS64 = 0.125f * LOG2E, QS96 = 0.10206207261596575f * LOG2E; (void)QS64; (void)QS96; \
    const cs_t* cs64 = WSP(cs_t, WS_CS64); const cs_t* cs32 = WSP(cs_t, WS_CS32); (void)cs64; (void)cs32; \
    bf16* XB = WSP(bf16, WS_XB); bf16* AO = WSP(bf16, WS_AO); bf16* QK = WSP(bf16, WS_QK); bf16* VT = WSP(bf16, WS_VT); bf16* OH = WSP(bf16, WS_OH); bf16* KH = WSP(bf16, WS_KH); (void)KH; bf16* Y16 = WSP(bf16, WS_Y); \
    (void)XB; (void)AO; (void)QK; (void)VT; (void)OH; (void)Y16; unsigned* AMX = WSP(unsigned, WS_CTL) + CW_KMAX; (void)AMX;

template <int LAYER> __device__ __forceinline__ void da_layer(const Args& a, Ctx& c) {
    CTX_LOCALS
    constexpr int j = LAYER / 3; const float lam_init = 0.8f - 0.6f * __expf(-0.3f * (float)LAYER);
    bf16* Wb = WSP(bf16, WS_WDA + (size_t)j * 8 * MiB);
    if (RUN) { IDS0;
        { pg8::Gemm g{XB, Wb, S, 2048, 1024}; pg8::StaticOrder So; So.init(S, 2048, G, cb);
          pg8::EpiRope64 E{QK, 1024, cs64, 32, 4, QS64, 0x7fffffff, 1, 0, 16, KH, S, AMX + (j ? 4 : 0)};
          pg8::gemm_phase<pg8::EpiRope64, pg8::StaticOrder, true, true, 1001>(lds, g, So, E, wave, c.ph + 1000); }
        { pg8::Gemm g{Wb + 2048 * 1024, XB, 1024, S, 1024}; pg8::StaticOrder So; So.init(1024, S, G, cb);
          pg8::EpiVtTiled E{VT, 7, S};
          pg8::gemm_phase<pg8::EpiVtTiled, pg8::StaticOrder, true, true, 1002>(lds, g, So, E, wave, c.ph + 1000); }
    }
    SEAM();
    if (RUN) { IDS0;
        const float lam = da_lambda(a, j, lam_init, lane);
        const float kbound = 2.04f * __builtin_bit_cast(float, xb_ld(AMX + (j ? 4 : 0)));
        const int hp = cb & 7, aa = cb >> 3;
        for (int i_ = 0; i_ < 2 * REPN(1); ++i_) { const int i = i_ & 1; const int qt = (i == 0) ? 63 - aa : aa;
            AttnArgs A; A.Q0 = QK + 64 * (2 * hp); A.Q1 = nullptr; A.ldq = 1024; A.K0 = KH + (size_t)(2 * hp) * S * 64; A.ldk0 = 64; A.K1 = nullptr; A.ldk1 = 0;
            A.Qb = QK + 64 * (2 * hp + 1); A.Kb = KH + (size_t)(2 * hp + 1) * S * 64; A.lam = lam; A.gain = a.in[I_DA_SUBLN] + j * 128; A.gscale = 1.0f - lam_init;
            A.Vt = VT + (size_t)(128 * hp) * S; A.ldv = S; A.O = AO + 128 * hp; A.ldo = 1024; A.window = 0; A.kbound = kbound;
            { BgNone nb_; attn_unit<64, 128, true>(lds, A, qt * 256, tid, lane, wave, nb_); } }
    }
    SEAM();
    if (RUN) { IDS0; pg8::Gemm g{AO, Wb + 3072 * 1024, S, 1024, 1024}; pg8::StaticOrder So; So.init(S, 1024, G, cb); pg8::EpiResAdd E{Y16, XB, ALPHA_DN};
        pg8::gemm_phase<pg8::EpiResAdd, pg8::StaticOrder, true, true, 1003>(lds, g, So, E, wave, c.ph + 1000); }
    SEAM();
}
__device__ __forceinline__ void mla_layer(const Args& a, Ctx& c) {
    CTX_LOCALS
    bf16* Wb = WSP(bf16, WS_WMLA);
    float* C = WSP(float, WS_MISC + MLA_C); bf16* cqn = WSP(bf16, WS_MISC + MLA_CQN); bf16* ckvn = WSP(bf16, WS_MISC + MLA_CKVN); bf16* Kr = WSP(bf16, WS_MISC + MLA_KR);
    if (RUN) { IDS1; pg8::Gemm g{XB, Wb, S, 512, 1024}; pg8::StaticOrder So; So.init(S, 512, G, cb); pg8::EpiF32 E{C, 512, AMX + 1};
        pg8::gemm_phase<pg8::EpiF32, pg8::StaticOrder, true, true, 1004>(lds, g, So, E, wave, c.ph + 1000); }
    SEAM();
    if (RUN) { IDS1; phase_mla_norm(a, tid, lane, wave); }
    SEAM();
    if (RUN) { IDS1;
        { pg8::Gemm g{cqn, Wb + 1 * MiB / 2, S, 1024, 256}; pg8::StaticOrder So; So.init(S, 1024, G, cb);
          pg8::EpiBf16P E{QK, 1536, QS96};
          pg8::gemm_phase<pg8::EpiBf16P, pg8::StaticOrder, true, true, 1901>(lds, g, So, E, wave, c.ph + 1000); }
        { pg8::Gemm g{cqn, Wb + 1 * MiB / 2 + 1024 * 256, S, 512, 256}; pg8::StaticOrder So; So.init(S, 512, G, (cb + 128) & 255);
          pg8::EpiRope16 E{QK + 1024, 1536, cs32, QS96};
          pg8::gemm_phase<pg8::EpiRope16, pg8::StaticOrder, true, true, 1902>(lds, g, So, E, wave, c.ph + 1000); }
        { pg8::Gemm g{ckvn, Wb + 2 * MiB / 2, S, 1024, 128}; pg8::StaticOrder So; So.init(S, 1024, G, cb);
          pg8::EpiHeadMajor64 E{KH, S, AMX + 1};
          pg8::gemm_phase<pg8::EpiHeadMajor64, pg8::StaticOrder, true, true, 1006>(lds, g, So, E, wave, c.ph + 1000); }
        { pg8::Gemm g{Wb + 2 * MiB / 2 + 1024 * 128, ckvn, 1024, S, 128}; pg8::StaticOrder So; So.init(1024, S, G, (cb + 128) & 255);
          pg8::EpiVtTiled E{VT, 6, S};
          pg8::gemm_phase<pg8::EpiVtTiled, pg8::StaticOrder, true, true, 1007>(lds, g, So, E, wave, c.ph + 1000); }
    }
    SEAM();
    if (RUN) { IDS1;
        const int hh = cb & 15, aa = cb >> 4;
        const float kbound = 3.06f * __builtin_bit_cast(float, xb_ld(AMX + 1));
        BgConv bg; bg.init(&a.jobs[18], 3, cb * NWAVES + wave, G * NWAVES, lane, 3, lds + 49152 + wave * 9216);
        for (int i_ = 0; i_ < 4 * REPN(2); ++i_) { const int i = i_ & 3; const int qt = (i == 0) ? 63 - aa : (i == 1) ? aa : (i == 2) ? 47 - aa : 16 + aa;
            AttnArgs A; A.Q0 = QK + 64 * hh; A.Q1 = QK + 1024 + 32 * hh; A.ldq = 1536; A.K0 = KH + (size_t)hh * S * 64; A.ldk0 = 64; A.K1 = Kr; A.ldk1 = 32;
            A.Vt = VT + (size_t)(64 * hh) * S; A.ldv = S; A.O = AO + 64 * hh; A.ldo = 1024; A.window = 0; A.Qb = nullptr; A.Kb = nullptr; A.lam = 0.f; A.gain = nullptr; A.gscale = 0.f; A.kbound = kbound;
            attn_unit<96, 64, false, BgConv>(lds, A, qt * 256, tid, lane, wave, bg); }
        bg.drain();
    }
    SEAM();
    if (RUN) { IDS1; pg8::Gemm g{AO, Wb + 3 * MiB / 2, S, 1024, 1024}; pg8::StaticOrder So; So.init(S, 1024, G, cb); pg8::EpiResAdd E{Y16, XB, ALPHA_DN};
        pg8::gemm_phase<pg8::EpiResAdd, pg8::StaticOrder, true, true, 1008>(lds, g, So, E, wave, c.ph + 1000); }
    SEAM();
}
__device__ __forceinline__ void nsa_layer(const Args& a, Ctx& c) {
    CTX_LOCALS
    bf16* Wb = WSP(bf16, WS_WNSA);
    bf16* P = WSP(bf16, WS_MISC + NSA_P); bf16* ACK = WSP(bf16, WS_MISC + NSA_ACK); bf16* ACV = WSP(bf16, WS_MISC + NSA_ACV);
    bf16* HK = WSP(bf16, WS_MISC + NSA_HK); bf16* HV = WSP(bf16, WS_MISC + NSA_HV); bf16* KC = WSP(bf16, WS_MISC + NSA_KC); bf16* VCT = WSP(bf16, WS_MISC + NSA_VCT);
    if (RUN) { IDS2;
        { pg8::Gemm g{XB, Wb, S, 1536, 1024}; pg8::StaticOrder So; So.init(S, 1536, G, cb);
          pg8::EpiRope64 E{QK, 1024, cs64, 24, 4, QS64, 0x7fffffff, 1, 0, 16, KH, S, AMX + 2};
          pg8::gemm_phase<pg8::EpiRope64, pg8::StaticOrder, true, true, 1009>(lds, g, So, E, wave, c.ph + 1000); }
        { pg8::Gemm g{XB, Wb + 1536 * 1024, S, 768, 1024}; pg8::StaticOrder So; So.init(S, 768, G, (cb + 128) & 255);
          pg8::EpiBf16P E{P, 768, 1.0f};
          pg8::gemm_phase<pg8::EpiBf16P, pg8::StaticOrder, true, true, 1010>(lds, g, So, E, wave, c.ph + 1000); }
        { pg8::Gemm g{Wb + 2304 * 1024, XB, 512, S, 1024}; pg8::StaticOrder So; So.init(512, S, G, (cb + 192) & 255);
          pg8::EpiVtTiled E{VT, 6, S};
          pg8::gemm_phase<pg8::EpiVtTiled, pg8::StaticOrder, true, true, 1011>(lds, g, So, E, wave, c.ph + 1000); }
    }
    SEAM();
    if (RUN) { IDS2; phase_nsa_cmp_gather(a, tid); }
    SEAM();
    if (RUN) { IDS2;
        { pg8::Gemm g{ACK, Wb + 6 * MiB / 2, 4096, 256, 2048}; pg8::StaticOrder So; So.init(4096, 256, G, cb); pg8::EpiGeluBf16 E{HK, 256};
          pg8::gemm_phase<pg8::EpiGeluBf16, pg8::StaticOrder, true, true, 1012>(lds, g, So, E, wave, c.ph + 1000); }
        { pg8::Gemm g{ACV, Wb + 7 * MiB / 2, 4096, 256, 2048}; pg8::StaticOrder So; So.init(4096, 256, G, (cb + 240) & 255); pg8::EpiGeluBf16 E{HV, 256};
          pg8::gemm_phase<pg8::EpiGeluBf16, pg8::StaticOrder, true, true, 1013>(lds, g, So, E, wave, c.ph + 1000); }
        if (cb >= 32) {
        for (int idx = cb - 32; idx < 1024 * REPN(6); idx += 224) { const int qt = (idx & 1023) >> 4, hh = idx & 15;
            AttnArgs A; A.Q0 = QK + 64 * hh; A.Q1 = nullptr; A.ldq = 1024; A.K0 = KH + (size_t)(4 + (hh >> 2)) * S * 64; A.ldk0 = 64; A.K1 = nullptr; A.ldk1 = 0;
            A.Vt = VT + (size_t)(256 + 64 * (hh >> 2)) * S; A.ldv = S; A.O = OH + (size_t)S * 1024 + 64 * hh; A.ldo = 1024; A.window = 512; A.Qb = nullptr; A.Kb = nullptr; A.lam = 0.f; A.gain = nullptr; A.gscale = 0.f; A.kbound = 2.04f * __builtin_bit_cast(float, xb_ld(AMX + 2));
            { BgNone nb_; attn_unit<64, 64>(lds, A, qt * 256, tid, lane, wave, nb_); } }
        }
    }
    SEAM();
    if (RUN) { IDS2;
        { pg8::Gemm g{HK, Wb + 8 * MiB / 2, 4096, 256, 256}; pg8::StaticOrder So; So.init(4096, 256, G, cb);
          pg8::EpiRope64 E{KC, 64, cs64, 1, 0, 1.0f, 1023, 16, 31, 1 << 30, nullptr, 0, AMX + 3};
          pg8::gemm_phase<pg8::EpiRope64, pg8::StaticOrder, true, true, 1014>(lds, g, So, E, wave, c.ph + 1000); }
        { pg8::Gemm g{Wb + 8 * MiB / 2 + 65536, HV, 256, 4096, 256}; pg8::StaticOrder So; So.init(256, 4096, G, (cb + 240) & 255);
          pg8::EpiBf16P E{VCT, 4096, 1.0f};
          pg8::gemm_phase<pg8::EpiBf16P, pg8::StaticOrder, true, true, 1015>(lds, g, So, E, wave, c.ph + 1000); }
    }
    SEAM();
    if (RUN) { IDS2;
        const float kb_sel = 2.04f * __builtin_bit_cast(float, xb_ld(AMX + 2)), kb_cmp = 2.04f * __builtin_bit_cast(float, xb_ld(AMX + 3)); (void)kb_cmp;
        for (int i_ = 0; i_ < 4 * REPN(3); ++i_) { const int i = i_ & 3; const int idx = i * 256 + cb, gg = idx & 3, aa = cb >> 2;
            const int T = (i == 0) ? 255 - aa : (i == 1) ? aa : (i == 2) ? 191 - aa : 64 + aa;
            nsa_cmp_unit(lds, a, T, gg, tid, lane, wave, kb_cmp);
            asm volatile("s_waitcnt vmcnt(0)" ::: "memory"); __syncthreads();
            nsa_sel_unit(lds, a, T, gg, tid, lane, wave, kb_sel);
            __syncthreads(); }
    }
    SEAM();
    if (RUN) { IDS2; pg8::Gemm g{AO, Wb + 9 * MiB / 2, S, 1024, 1024}; pg8::StaticOrder So; So.init(S, 1024, G, cb); pg8::EpiResAdd E{Y16, XB, ALPHA_DN};
        pg8::gemm_phase<pg8::EpiResAdd, pg8::StaticOrder, true, true, 1016>(lds, g, So, E, wave, c.ph + 1000); }
    SEAM();
}
template <int LAYER> __device__ __forceinline__ void moe_layer(const Args& a, Ctx& c) {
    CTX_LOCALS
    bf16* Wm = WSP(bf16, WS_WMOE + (size_t)LAYER * 192 * MiB);
    bf16* Act = WSP(bf16, WS_ACT); bf16* Ys = WSP(bf16, WS_YS);
    if (RUN) { IDS3; phase_ln1_router(a, lds, LAYER, tid, lane, wave); }
    SEAM();
    if (RUN) { IDS3; phase_place(a, lds, LAYER, tid, lane, wave); }
    SEAM();
    if (RUN) { IDS3;
        const int ntl = (int)lc[LC_NT], xcd = cb & 7, t0 = (ntl * xcd) >> 3, t1 = (ntl * (xcd + 1)) >> 3;
        { const v4u* src = (const v4u*)(WSP(unsigned short, WS_ROUTE + 2 * MiB) + (size_t)t0 * 256); LAS v4u* dst = (LAS v4u*)(lds + LDS_GIDX_OFF);
          for (int q = tid; q < (t1 - t0) * 32; q += NTHREADS) dst[q] = src[q]; }
        __syncthreads();
        pg8::MoeOrder So{8, G, cb, ntl, (const LAS int*)(lc + LC_TILEE), REPN(5)};
        {
        pg8::Gemm g{WSP(bf16, WS_AS), Wm, MOE_ROWS, 32 * 2048, 512, (const LAS unsigned short*)(lds + LDS_GIDX_OFF), t0};
        pg8::EpiSwiglu E{Act, a.in[I_MOE_BGU] + (size_t)LAYER * 32 * 2048, 1.0f / 64.0f, (unsigned char*)Act};
        pg8::gemm_phase<pg8::EpiSwiglu, pg8::MoeOrder, true, true, 1702, true, true, false, 1>(lds, g, So, E, wave, c.ph + 1000); } }
    SEAM();
    if (RUN) { IDS3; pg8::MoeOrder So{4, G, cb, (int)lc[LC_NT], (const LAS int*)(lc + LC_TILEE), REPN(5)};
        {
        pg8::Gemm g{Act, Wm + 64 * MiB, MOE_ROWS, 32 * 1024, 512};
        pg8::EpiDown E{Ys, a.in[I_MOE_BDN] + (size_t)LAYER * 32 * 1024, WSP(float, WS_ROUTE + 786432), (unsigned char*)Ys, 1.0f / 64.0f};
        pg8::gemm_phase<pg8::EpiDown, pg8::MoeOrder, true, true, 1019, false, true, false, 1>(lds, g, So, E, wave, c.ph + 1000); } }
    SEAM();
    if (RUN) { IDS3; phase_ln2(a, LAYER, LAYER == NLAYER - 1 ? a.out : nullptr, tid, lane, wave); }
    SEAM();
}

__global__ void __launch_bounds__(NTHREADS, 2) fwd_kernel(Args a) {
    extern __shared__ __attribute__((aligned(16))) unsigned char lds_raw[];
    Ctx c;
    c.lds = (LAS unsigned char*)lds_raw;
    { const int tid0 = threadIdx.x;
      c.wave = __builtin_amdgcn_readfirstlane(tid0 >> 6);
      c.G = gridDim.x; c.cb = blockIdx.x;
      c.lc = (LAS unsigned*)(c.lds + LDSCTL_OFF);
      for (int u = tid0; u < (LDS_BYTES - LDSCTL_OFF) / 4; u += NTHREADS) c.lc[u] = 0u;
      __syncthreads();
      c.bar = xcd_barrier_post(WSP(unsigned, WS_CTL) + CW_BAR, (volatile LAS unsigned*)c.lc, tid0); }
    c.ph = 0;
    if (RUN) { IDS4; for (int rep = 0; rep < REPN(0); ++rep) phase_prologue(a, c.lds, tid, lane, wave); }
    SEAM();
    da_layer<0>(a, c);  moe_layer<0>(a, c);
    mla_layer(a, c);    moe_layer<1>(a, c);
    nsa_layer(a, c);    moe_layer<2>(a, c);
    da_layer<3>(a, c);  moe_layer<3>(a, c);
}

static int add_job(Args& a, const float* src, bf16* dst, long long sbs, long long dbs, int ld, int K, int ncols, int col0, int mode, int nbatch, int f8 = 0) {
    Job& J = a.jobs[a.njobs]; J.src = src; J.dst = dst; J.sbs = sbs; J.dbs = dbs; J.ld = ld; J.K = K; J.ncols = ncols; J.col0 = col0; J.mode = mode; J.nbatch = nbatch; J.item0 = a.nitems; J.pad = f8;
    a.nitems += nbatch * (K / (f8 ? 128 : 64)) * ((ncols + 63) / 64); return a.njobs++;
}
extern "C" void kernel_launch(void* const* d_in, const int* in_sizes, int n_in, void* d_out, int out_size, void* d_ws, size_t ws_size, hipStream_t stream) {
    static int grid = 0;
    if (grid == 0) {
        if (n_in != N_IN || out_size != S * D || ws_size < WS_END) { fprintf(stderr, "kernel_launch: unexpected shapes: n_in %d out %d ws %zu (need %zu)\n", n_in, out_size, ws_size, (size_t)WS_END); grid = -1; return; }
        int dev = 0, cus = 0, per_cu = 0;
        hipGetDevice(&dev); hipDeviceGetAttribute(&cus, hipDeviceAttributeMultiprocessorCount, dev);
        if (hipFuncSetAttribute((const void*)fwd_kernel, hipFuncAttributeMaxDynamicSharedMemorySize, LDS_BYTES) != hipSuccess) { fprintf(stderr, "kernel_launch: hipFuncSetAttribute failed\n"); grid = -1; return; }
        hipOccupancyMaxActiveBlocksPerMultiprocessor(&per_cu, (const void*)fwd_kernel, NTHREADS, LDS_BYTES);
        (void)hipGetLastError();
        if (per_cu < 1 || cus < 256) { fprintf(stderr, "kernel_launch: occupancy %d, CUs %d: this kernel needs 256 resident workgroups\n", per_cu, cus); grid = -1; return; }
        grid = 256;
    }
    if (grid < 0) return;
    hipMemsetAsync((char*)d_ws + WS_CTL, 0, CTL_ZERO_BYTES, stream);
    Args a; memset(&a, 0, sizeof(a));
    for (int i = 0; i < N_IN; ++i) a.in[i] = (const float*)d_in[i];
    a.out = (float*)d_out; a.ws = (unsigned char*)d_ws;
    unsigned char* ws = (unsigned char*)d_ws;
    const long long KK = 1024;
    for (int j = 0; j < 2; ++j) {
        bf16* Wb = (bf16*)(ws + WS_WDA + (size_t)j * 8 * MiB);
        add_job(a, a.in[I_DA_WIN] + (size_t)j * 1024 * 3072, Wb, 0, 0, 3072, 1024, 2048, 0, CM_ROPE64, 1);
        add_job(a, a.in[I_DA_WIN] + (size_t)j * 1024 * 3072, Wb + 2048 * 1024, 0, 0, 3072, 1024, 1024, 2048, CM_IDENT, 1);
        add_job(a, a.in[I_DA_WOUT] + (size_t)j * 1024 * 1024, Wb + 3072 * 1024, 0, 0, 1024, 1024, 1024, 0, CM_IDENT, 1);
    }
    { bf16* Wb = (bf16*)(ws + WS_WMLA);
      add_job(a, a.in[I_MLA_WIN], Wb, 0, 0, 416, 1024, 416, 0, CM_IDENT, 1);
      add_job(a, a.in[I_MLA_WUQ], Wb + 1 * MiB / 2, 0, 0, 1536, 256, 1536, 0, CM_MLAQ, 1);
      add_job(a, a.in[I_MLA_WUKV], Wb + 2 * MiB / 2, 0, 0, 2048, 128, 2048, 0, CM_MLAKV, 1);
      add_job(a, a.in[I_MLA_WOUT], Wb + 3 * MiB / 2, 0, 0, 1024, 1024, 1024, 0, CM_IDENT, 1); }
    { bf16* Wb = (bf16*)(ws + WS_WNSA);
      add_job(a, a.in[I_NSA_WIN], Wb, 0, 0, 2608, 1024, 2608, 0, CM_NSAIN, 1);
      add_job(a, a.in[I_NSA_KW1], Wb + 6 * MiB / 2, 0, 0, 256, 2048, 256, 0, CM_IDENT, 1);
      add_job(a, a.in[I_NSA_VW1], Wb + 7 * MiB / 2, 0, 0, 256, 2048, 256, 0, CM_IDENT, 1);
      add_job(a, a.in[I_NSA_KW2], Wb + 8 * MiB / 2, 0, 0, 64, 256, 64, 0, CM_ROPE64, 1);
      add_job(a, a.in[I_NSA_VW2], Wb + 8 * MiB / 2 + 65536, 0, 0, 64, 256, 64, 0, CM_IDENT, 1);
      add_job(a, a.in[I_NSA_WOUT], Wb + 9 * MiB / 2, 0, 0, 1024, 1024, 1024, 0, CM_IDENT, 1); }
    for (int L = 0; L < NLAYER; ++L) {
        bf16* Wm = (bf16*)(ws + WS_WMOE + (size_t)L * 192 * MiB);
        add_job(a, a.in[I_MOE_WGU] + (size_t)L * 32 * KK * 2048, Wm, KK * 2048, 2048 * KK, 2048, 1024, 2048, 0, CM_SWIGLU, 32, 2);
        add_job(a, a.in[I_MOE_WDN] + (size_t)L * 32 * KK * 1024, Wm + 64 * MiB, KK * 1024, 1024 * KK, 1024, 1024, 1024, 0, CM_IDENT, 32, 2);
    }
    a.nitems = a.jobs[18].item0;
    a.ph_lo = 0; a.ph_hi = 1 << 20;
    hipLaunchKernelGGL(fwd_kernel, dim3(grid), dim3(NTHREADS), LDS_BYTES, stream, a);
    const hipError_t le = hipPeekAtLastError();
    if (le != hipSuccess) fprintf(stderr, "kernel_launch: launch failed: %s\n", hipGetErrorName(le));
}
```

```cpp
#ifndef REP
#define REP 0
#endif
#include <hip/hip_runtime.h>
#include <cstdio>
#include <cstdint>
#include <cstring>
namespace pg8 {
#define PG8_LAS __attribute__((address_space(3)))
typedef unsigned short bf16_t;
typedef short bf16x8 __attribute__((ext_vector_type(8)));
typedef float f32x4 __attribute__((ext_vector_type(4)));
typedef int i32x4 __attribute__((ext_vector_type(4)));
typedef long i64x2 __attribute__((ext_vector_type(2)));
typedef unsigned u32x4 __attribute__((ext_vector_type(4)));
constexpr int BM = 256, BK = 64, HALF = 128, HTB = HALF * BK * 2  , STAGE_BYTES = 8 * HTB, NXCD = 8, WGM = 8;

__host__ __device__ __forceinline__ int lds_byte(int r, int c) { const int st = (r >> 4) * 2 + (c >> 5), rr = r & 15, cc = c & 31, ob = rr * 64 + cc * 2; return st * 1024 + (ob ^ (((ob >> 9) & 1) << 5)); }
__host__ __device__ __forceinline__ void stage_rc(int b, int& R, int& C) { const int st = b / 1024, sb = b % 1024, swz = sb ^ (((sb >> 9) & 1) << 5); R = (st >> 1) * 16 + swz / 64; C = (st & 1) * 32 + (swz % 64) / 2; }
__host__ __device__ __forceinline__ int perm32(int rho) { const int n = rho >> 4, i = rho & 15; return 8 * (i >> 2) + 4 * n + (i & 3); }

struct Unit { int pm, pn, half; };
struct Gemm { const bf16_t* A; const bf16_t* Bt; int M, N, K; const PG8_LAS unsigned short* gidx; int gtile0; };

struct StaticOrder {
    int nM, nN, nwg, G, c;
    __host__ __device__ void init(int M, int N, int G_, int c_) { nM = M / BM; nN = N / BM; nwg = nM * nN; G = G_; c = c_; }
    __host__ __device__ bool next(int i, Unit& u) const {
        long L = (long)i * G + c;
#if defined(REP) && ((REP >> 8) & 1)
        if (L >= 2 * nwg) return false; if (L >= nwg) L -= nwg;
#else
        if (L >= nwg) return false;
#endif
        int wgid = (int)L; { const int q = nwg / NXCD, r = nwg % NXCD, xcd = wgid % NXCD, off = wgid / NXCD; wgid = (xcd < r ? xcd * (q + 1) : r * (q + 1) + (xcd - r) * q) + off; }
        const int nig = WGM * nN, gid = wgid / nig, fm = gid * WGM, gsz = (nM - fm) < WGM ? (nM - fm) : WGM;
        u.pm = fm + ((wgid % nig) % gsz); u.pn = (wgid % nig) / gsz; u.half = 0; return true;
    }
    __device__ __forceinline__ void a_ready(const Unit&) const {}
    __device__ __forceinline__ void done(const Unit&) const {}
};

__device__ __forceinline__ unsigned cvt_pk_bf16(float lo, float hi) { unsigned r; asm volatile("v_cvt_pk_bf16_f32 %0, %1, %2" : "=v"(r) : "v"(lo), "v"(hi)); return r; }
typedef float f32x2 __attribute__((ext_vector_type(2)));
typedef unsigned u32x2 __attribute__((ext_vector_type(2)));
struct __attribute__((aligned(8))) cs_t { float c, s; };
struct EpiBf16P {
    static constexpr bool PERM = true, AFTER_DRAIN = false, AMAX = false;
    bf16_t* O; int ldc; float scale;
    __device__ __forceinline__ void operator()(const f32x4 (&acc)[2][2][4][2], const Unit& u, int wr, int wc, int fr, int fq) const {
        const int row0 = u.pm * BM + wr * 64 + fr, col0 = u.pn * BM + wc * 32 + 8 * fq;
#pragma unroll
        for (int ai = 0; ai < 2; ++ai)
#pragma unroll
            for (int m = 0; m < 4; ++m) { bf16_t* rowp = O + (size_t)(row0 + ai * HALF + m * 16) * ldc + col0;
#pragma unroll
                for (int bj = 0; bj < 2; ++bj) { const f32x4 v0 = acc[ai][bj][m][0] * scale, v1 = acc[ai][bj][m][1] * scale;
                    u32x4 w; w.x = cvt_pk_bf16(v0[0], v0[1]); w.y = cvt_pk_bf16(v0[2], v0[3]); w.z = cvt_pk_bf16(v1[0], v1[1]); w.w = cvt_pk_bf16(v1[2], v1[3]);
                    *(u32x4*)(rowp + bj * HALF) = w; } }
    }
};
struct EpiHeadMajor64 {
    static constexpr bool PERM = true, AFTER_DRAIN = false, AMAX = true;
    bf16_t* O; int nrows; unsigned* amax;
    __device__ __forceinline__ void operator()(const f32x4 (&acc)[2][2][4][2], const Unit& u, int wr, int wc, int fr, int fq) const {
        const int row0 = u.pm * BM + wr * 64 + fr, col0 = u.pn * BM + wc * 32 + 8 * fq;
#pragma unroll
        for (int ai = 0; ai < 2; ++ai)
#pragma unroll
            for (int m = 0; m < 4; ++m) { const int row = row0 + ai * HALF + m * 16;
#pragma unroll
                for (int bj = 0; bj < 2; ++bj) { const int col = col0 + bj * HALF; const f32x4 v0 = acc[ai][bj][m][0], v1 = acc[ai][bj][m][1];
                    u32x4 w; w.x = cvt_pk_bf16(v0[0], v0[1]); w.y = cvt_pk_bf16(v0[2], v0[3]); w.z = cvt_pk_bf16(v1[0], v1[1]); w.w = cvt_pk_bf16(v1[2], v1[3]);
                    *(u32x4*)(O + ((size_t)(col >> 6) * nrows + row) * 64 + (col & 63)) = w; } }
    }
};
struct EpiVtTiled {
    static constexpr bool PERM = true, AFTER_DRAIN = false, AMAX = false;
    bf16_t* O; int dvshift; int ntok;
    __device__ __forceinline__ void operator()(const f32x4 (&acc)[2][2][4][2], const Unit& u, int wr, int wc, int fr, int fq) const {
        const int row0 = u.pm * BM + wr * 64 + fr, col0 = u.pn * BM + wc * 32 + 8 * fq; const int DVm = (1 << dvshift) - 1, nt = ntok >> 6;
#pragma unroll
        for (int ai = 0; ai < 2; ++ai)
#pragma unroll
            for (int m = 0; m < 4; ++m) { const int row = row0 + ai * HALF + m * 16; const int head = row >> dvshift, dv = row & DVm;
#pragma unroll
                for (int bj = 0; bj < 2; ++bj) { const int col = col0 + bj * HALF; const f32x4 v0 = acc[ai][bj][m][0], v1 = acc[ai][bj][m][1];
                    u32x4 w; w.x = cvt_pk_bf16(v0[0], v0[1]); w.y = cvt_pk_bf16(v0[2], v0[3]); w.z = cvt_pk_bf16(v1[0], v1[1]); w.w = cvt_pk_bf16(v1[2], v1[3]);
                    *(u32x4*)(O + ((((size_t)head * nt + (col >> 6)) << dvshift) + dv) * 64 + (col & 63)) = w; } }
    }
};
struct EpiF32 {
    static constexpr bool PERM = false, AFTER_DRAIN = false, AMAX = true;
    float* O; int ldc; unsigned* amax;
    __device__ __forceinline__ void operator()(const f32x4 (&acc)[2][2][4][2], const Unit& u, int wr, int wc, int fr, int fq) const {
        const int row0 = u.pm * BM + wr * 64 + fr, col0 = u.pn * BM + wc * 32 + 4 * fq;
#pragma unroll
        for (int ai = 0; ai < 2; ++ai)
#pragma unroll
            for (int m = 0; m < 4; ++m) { float* rowp = O + (size_t)(row0 + ai * HALF + m * 16) * ldc + col0;
#pragma unroll
                for (int bj = 0; bj < 2; ++bj)
#pragma unroll
                    for (int n = 0; n < 2; ++n) *(f32x4*)(rowp + bj * HALF + n * 16) = acc[ai][bj][m][n]; }
    }
};
struct EpiRope64 {
    static constexpr bool PERM = true, AFTER_DRAIN = false, AMAX = true;
    bf16_t* O; int ldc; const cs_t* cs; int nheads; int nq_tiles; float qscale; int posmask, posmul, posadd; int hm_from; bf16_t* Ohm; int hm_rows; unsigned* amax;
    __device__ __forceinline__ void operator()(const f32x4 (&acc)[2][2][4][2], const Unit& u, int wr, int wc, int fr, int fq) const {
        const int hv = 4 * u.pn + wc; if (hv >= nheads) return;
        const bool hm = hv >= hm_from;
        const float sc = (u.pn < nq_tiles) ? qscale : 1.0f;
        const int row0 = u.pm * BM + wr * 64 + fr, y0 = 8 * fq;
#pragma unroll
        for (int ai = 0; ai < 2; ++ai)
#pragma unroll
            for (int m = 0; m < 4; ++m) { const int row = row0 + ai * HALF + m * 16; const int pos = (row & posmask) * posmul + posadd;
                const f32x4* cp = (const f32x4*)(cs + (size_t)pos * 32 + y0);
                const f32x4 c0 = cp[0], c1 = cp[1], c2 = cp[2], c3 = cp[3];
                const f32x4 a0 = acc[ai][0][m][0], a1 = acc[ai][0][m][1], b0 = acc[ai][1][m][0], b1 = acc[ai][1][m][1];
                float o1[8], o2[8];
                o1[0] = a0[0] * c0[0] - b0[0] * c0[1]; o2[0] = b0[0] * c0[0] + a0[0] * c0[1];
                o1[1] = a0[1] * c0[2] - b0[1] * c0[3]; o2[1] = b0[1] * c0[2] + a0[1] * c0[3];
                o1[2] = a0[2] * c1[0] - b0[2] * c1[1]; o2[2] = b0[2] * c1[0] + a0[2] * c1[1];
                o1[3] = a0[3] * c1[2] - b0[3] * c1[3]; o2[3] = b0[3] * c1[2] + a0[3] * c1[3];
                o1[4] = a1[0] * c2[0] - b1[0] * c2[1]; o2[4] = b1[0] * c2[0] + a1[0] * c2[1];
                o1[5] = a1[1] * c2[2] - b1[1] * c2[3]; o2[5] = b1[1] * c2[2] + a1[1] * c2[3];
                o1[6] = a1[2] * c3[0] - b1[2] * c3[1]; o2[6] = b1[2] * c3[0] + a1[2] * c3[1];
                o1[7] = a1[3] * c3[2] - b1[3] * c3[3]; o2[7] = b1[3] * c3[2] + a1[3] * c3[3];
                bf16_t* rowp = hm ? (Ohm + ((size_t)(hv - hm_from) * hm_rows + row) * 64 + y0) : (O + (size_t)row * ldc + 64 * hv + y0);
                u32x4 w; w.x = cvt_pk_bf16(o1[0] * sc, o1[1] * sc); w.y = cvt_pk_bf16(o1[2] * sc, o1[3] * sc); w.z = cvt_pk_bf16(o1[4] * sc, o1[5] * sc); w.w = cvt_pk_bf16(o1[6] * sc, o1[7] * sc);
                *(u32x4*)rowp = w;
                w.x = cvt_pk_bf16(o2[0] * sc, o2[1] * sc); w.y = cvt_pk_bf16(o2[2] * sc, o2[3] * sc); w.z = cvt_pk_bf16(o2[4] * sc, o2[5] * sc); w.w = cvt_pk_bf16(o2[6] * sc, o2[7] * sc);
                *(u32x4*)(rowp + 32) = w; }
    }
};
struct EpiRope16 {
    static constexpr bool PERM = true, AFTER_DRAIN = false, AMAX = false;
    bf16_t* O; int ldc; const cs_t* cs; float qscale;
    __device__ __forceinline__ void operator()(const f32x4 (&acc)[2][2][4][2], const Unit& u, int wr, int wc, int fr, int fq) const {
        const int row0 = u.pm * BM + wr * 64 + fr; const float sc = qscale;
        const int head = 8 * u.pn + 2 * wc + (fq >> 1), y0 = 8 * (fq & 1);
#pragma unroll
        for (int ai = 0; ai < 2; ++ai)
#pragma unroll
            for (int m = 0; m < 4; ++m) { const int row = row0 + ai * HALF + m * 16;
                const f32x4* cp = (const f32x4*)(cs + (size_t)row * 16 + y0);
                const f32x4 c0 = cp[0], c1 = cp[1], c2 = cp[2], c3 = cp[3];
                const f32x4 a0 = acc[ai][0][m][0], a1 = acc[ai][0][m][1], b0 = acc[ai][1][m][0], b1 = acc[ai][1][m][1];
                float o1[8], o2[8];
                o1[0] = a0[0] * c0[0] - b0[0] * c0[1]; o2[0] = b0[0] * c0[0] + a0[0] * c0[1];
                o1[1] = a0[1] * c0[2] - b0[1] * c0[3]; o2[1] = b0[1] * c0[2] + a0[1] * c0[3];
                o1[2] = a0[2] * c1[0] - b0[2] * c1[1]; o2[2] = b0[2] * c1[0] + a0[2] * c1[1];
                o1[3] = a0[3] * c1[2] - b0[3] * c1[3]; o2[3] = b0[3] * c1[2] + a0[3] * c1[3];
                o1[4] = a1[0] * c2[0] - b1[0] * c2[1]; o2[4] = b1[0] * c2[0] + a1[0] * c2[1];
                o1[5] = a1[1] * c2[2] - b1[1] * c2[3]; o2[5] = b1[1] * c2[2] + a1[1] * c2[3];
                o1[6] = a1[2] * c3[0] - b1[2] * c3[1]; o2[6] = b1[2] * c3[0] + a1[2] * c3[1];
                o1[7] = a1[3] * c3[2] - b1[3] * c3[3]; o2[7] = b1[3] * c3[2] + a1[3] * c3[3];
                bf16_t* rowp = O + (size_t)row * ldc + 32 * head + y0;
                u32x4 w; w.x = cvt_pk_bf16(o1[0] * sc, o1[1] * sc); w.y = cvt_pk_bf16(o1[2] * sc, o1[3] * sc); w.z = cvt_pk_bf16(o1[4] * sc, o1[5] * sc); w.w = cvt_pk_bf16(o1[6] * sc, o1[7] * sc);
                *(u32x4*)rowp = w;
                w.x = cvt_pk_bf16(o2[0] * sc, o2[1] * sc); w.y = cvt_pk_bf16(o2[2] * sc, o2[3] * sc); w.z = cvt_pk_bf16(o2[4] * sc, o2[5] * sc); w.w = cvt_pk_bf16(o2[6] * sc, o2[7] * sc);
                *(u32x4*)(rowp + 16) = w; }
    }
};
__device__ __forceinline__ float gelu_tanh(float x) {
    const float u2 = 1.5957691216057308f * (x + 0.044715f * x * x * x);
    return x * __builtin_amdgcn_rcpf(1.0f + __builtin_amdgcn_exp2f(-1.4426950408889634f * u2));
}
struct EpiGeluBf16 {
    static constexpr bool PERM = true, AFTER_DRAIN = false, AMAX = false;
    bf16_t* O; int ldc;
    __device__ __forceinline__ void operator()(const f32x4 (&acc)[2][2][4][2], const Unit& u, int wr, int wc, int fr, int fq) const {
        const int row0 = u.pm * BM + wr * 64 + fr, col0 = u.pn * BM + wc * 32 + 8 * fq;
#pragma unroll
        for (int ai = 0; ai < 2; ++ai)
#pragma unroll
            for (int m = 0; m < 4; ++m) { bf16_t* rowp = O + (size_t)(row0 + ai * HALF + m * 16) * ldc + col0;
#pragma unroll
                for (int bj = 0; bj < 2; ++bj) { const f32x4 v0 = acc[ai][bj][m][0], v1 = acc[ai][bj][m][1];
                    u32x4 w; w.x = cvt_pk_bf16(gelu_tanh(v0[0]), gelu_tanh(v0[1])); w.y = cvt_pk_bf16(gelu_tanh(v0[2]), gelu_tanh(v0[3]));
                    w.z = cvt_pk_bf16(gelu_tanh(v1[0]), gelu_tanh(v1[1])); w.w = cvt_pk_bf16(gelu_tanh(v1[2]), gelu_tanh(v1[3]));
                    *(u32x4*)(rowp + bj * HALF) = w; } }
    }
};
__device__ __forceinline__ float swiglu1(float g, float l) {
    const float hg = fminf(g, 7.0f), hl = fminf(fmaxf(l, -7.0f), 7.0f);
    return hg * __builtin_amdgcn_rcpf(1.0f + __builtin_amdgcn_exp2f(-1.702f * 1.4426950408889634f * hg)) * (hl + 1.0f);
}
struct EpiSwiglu {
    static constexpr bool PERM = true, AFTER_DRAIN = false, AMAX = false;
    bf16_t* O; const float* bgu; float ws; unsigned char* O8;
    __device__ __forceinline__ void operator()(const f32x4 (&acc)[2][2][4][2], const Unit& u, int wr, int wc, int fr, int fq) const {
        const int e = u.pn >> 3, pnl = u.pn & 7;
        const int row0 = u.pm * BM + wr * 64 + fr, f0 = pnl * 128 + wc * 32 + 8 * fq;
        const f32x4* bp = (const f32x4*)(bgu + (size_t)e * 2048 + 2 * f0);
        const f32x4 q0 = bp[0], q1 = bp[1], q2 = bp[2], q3 = bp[3];
#pragma unroll
        for (int ai = 0; ai < 2; ++ai)
#pragma unroll
            for (int m = 0; m < 4; ++m) { bf16_t* rowp = O + (size_t)(row0 + ai * HALF + m * 16) * 1024 + f0;
                const f32x4 g0 = acc[ai][0][m][0] * ws, g1 = acc[ai][0][m][1] * ws, l0 = acc[ai][1][m][0] * ws, l1 = acc[ai][1][m][1] * ws;
                u32x4 w;
                w.x = cvt_pk_bf16(swiglu1(g0[0] + q0[0], l0[0] + q0[1]), swiglu1(g0[1] + q0[2], l0[1] + q0[3]));
                w.y = cvt_pk_bf16(swiglu1(g0[2] + q1[0], l0[2] + q1[1]), swiglu1(g0[3] + q1[2], l0[3] + q1[3]));
                w.z = cvt_pk_bf16(swiglu1(g1[0] + q2[0], l1[0] + q2[1]), swiglu1(g1[1] + q2[2], l1[1] + q2[3]));
                w.w = cvt_pk_bf16(swiglu1(g1[2] + q3[0], l1[2] + q3[1]), swiglu1(g1[3] + q3[2], l1[3] + q3[3]));
                if (O8 == nullptr) *(u32x4*)rowp = w;
                else { int p0_ = __builtin_amdgcn_cvt_pk_fp8_f32(__builtin_bit_cast(float, w.x << 16), __builtin_bit_cast(float, w.x & 0xffff0000u), 0, false);
                    p0_ = __builtin_amdgcn_cvt_pk_fp8_f32(__builtin_bit_cast(float, w.y << 16), __builtin_bit_cast(float, w.y & 0xffff0000u), p0_, true);
                    int p1_ = __builtin_amdgcn_cvt_pk_fp8_f32(__builtin_bit_cast(float, w.z << 16), __builtin_bit_cast(float, w.z & 0xffff0000u), 0, false);
                    p1_ = __builtin_amdgcn_cvt_pk_fp8_f32(__builtin_bit_cast(float, w.w << 16), __builtin_bit_cast(float, w.w & 0xffff0000u), p1_, true);
                    *(u32x2*)(O8 + (size_t)(row0 + ai * HALF + m * 16) * 1024 + f0) = (u32x2){(unsigned)p0_, (unsigned)p1_}; } }
    }
};
struct EpiDown {
    static constexpr bool PERM = true, AFTER_DRAIN = false, AMAX = false;
    bf16_t* O; const float* bd; const float* rgate; unsigned char* O8; float ws;
    __device__ __forceinline__ void operator()(const f32x4 (&acc)[2][2][4][2], const Unit& u, int wr, int wc, int fr, int fq) const {
        const int e = u.pn >> 2, pnl = u.pn & 3;
        const int row0 = u.pm * BM + wr * 64 + fr, col0 = pnl * BM + wc * 32 + 8 * fq;
        f32x4 bv[2][2];
#pragma unroll
        for (int bj = 0; bj < 2; ++bj)
#pragma unroll
            for (int n = 0; n < 2; ++n) bv[bj][n] = *(const f32x4*)(bd + (size_t)e * 1024 + col0 + bj * HALF + 4 * n);
#pragma unroll
        for (int ai = 0; ai < 2; ++ai)
#pragma unroll
            for (int m = 0; m < 4; ++m) { const int row = row0 + ai * HALF + m * 16; const float gw = rgate[row]; bf16_t* rowp = O + (size_t)row * 1024 + col0;
#pragma unroll
                for (int bj = 0; bj < 2; ++bj) { const f32x4 v0 = (acc[ai][bj][m][0] * ws + bv[bj][0]) * gw, v1 = (acc[ai][bj][m][1] * ws + bv[bj][1]) * gw;
                    if (O8 == nullptr) { u32x4 w; w.x = cvt_pk_bf16(v0[0], v0[1]); w.y = cvt_pk_bf16(v0[2], v0[3]); w.z = cvt_pk_bf16(v1[0], v1[1]); w.w = cvt_pk_bf16(v1[2], v1[3]);
                    *(u32x4*)(rowp + bj * HALF) = w; }
                    else {
                        int p0_ = __builtin_amdgcn_cvt_pk_fp8_f32(v0[0] * 16.f, v0[1] * 16.f, 0, false); p0_ = __builtin_amdgcn_cvt_pk_fp8_f32(v0[2] * 16.f, v0[3] * 16.f, p0_, true);
                        int p1_ = __builtin_amdgcn_cvt_pk_fp8_f32(v1[0] * 16.f, v1[1] * 16.f, 0, false); p1_ = __builtin_amdgcn_cvt_pk_fp8_f32(v1[2] * 16.f, v1[3] * 16.f, p1_, true);
                        *(u32x2*)(O8 + (size_t)row * 1024 + col0 + bj * HALF) = (u32x2){(unsigned)p0_, (unsigned)p1_}; } } }
    }
};
struct EpiDownH {
    static constexpr bool PERM = true, AFTER_DRAIN = false, AMAX = false;
    bf16_t* O; const float* bd; const float* rgate; float ws;
    __device__ __forceinline__ void operator()(const f32x4 (&acc)[2][2][4][2], const Unit& u, int wr, int wc, int fr, int fq) const {
        const int e = u.pn >> 3, pnl = u.pn & 7;
        const int row0 = u.pm * BM + wr * 64 + fr, col0 = pnl * HALF + wc * 32 + 8 * fq;
        const f32x4 bv0 = *(const f32x4*)(bd + (size_t)e * 1024 + col0), bv1 = *(const f32x4*)(bd + (size_t)e * 1024 + col0 + 4);
#pragma unroll
        for (int ai = 0; ai < 2; ++ai)
#pragma unroll
            for (int m = 0; m < 4; ++m) { const int row = row0 + ai * HALF + m * 16; const float gw = rgate[row];
                const f32x4 v0 = (acc[ai][0][m][0] * ws + bv0) * gw, v1 = (acc[ai][0][m][1] * ws + bv1) * gw;
                u32x4 w; w.x = cvt_pk_bf16(v0[0], v0[1]); w.y = cvt_pk_bf16(v0[2], v0[3]); w.z = cvt_pk_bf16(v1[0], v1[1]); w.w = cvt_pk_bf16(v1[2], v1[3]);
                *(u32x4*)(O + (size_t)row * 1024 + col0) = w; }
    }
};
struct MoeOrder {
    int nN, G, c, ntiles; const PG8_LAS int* tile_e; int rep;
    __device__ bool next(int i, Unit& u) const {
        const int xcd = c & 7, jj = c >> 3, per = G >> 3;
        const int t0 = (ntiles * xcd) >> 3, t1 = (ntiles * (xcd + 1)) >> 3;
        int li = i * per + jj; const int tot = (t1 - t0) * nN; if (li >= tot * rep) return false; if (li >= tot) li -= tot;
        const int pm = t0 + li / nN, pnl = li - (li / nN) * nN; const int te = tile_e[pm], e = te & 255;
        u.pm = pm; u.pn = __builtin_amdgcn_readfirstlane(e * nN + pnl); u.half = __builtin_amdgcn_readfirstlane(te >> 8); return true;
    }
    __device__ __forceinline__ void a_ready(const Unit&) const {}
    __device__ __forceinline__ void done(const Unit&) const {}
};
template <class Epi, class Sched, bool ALIGN_EPI, bool SP2, int UIDC, bool GATHER = false, bool F8 = false, bool NHALF = false, int F8N1 = 0>
__device__ __forceinline__ void gemm_phase(PG8_LAS unsigned char* lds, const Gemm g, const Sched& S, const Epi& E, const int wid_in, const int UID) {
    const int wid = wid_in, lane = (int)__builtin_amdgcn_mbcnt_hi(~0u, __builtin_amdgcn_mbcnt_lo(~0u, (unsigned)UID)) - UID, tid = wid * 64 + lane, wr = wid >> 2, wc = wid & 3, fr = lane & 15, fq = lane >> 4;
    int K_l = g.K; asm volatile("; opaque K" : "+s"(K_l));
    const int K = K_l, nt = K / BK;
    static_assert(!GATHER || SP2, "GATHER is wired into the SP2 loop only");
    unsigned voffA[2], voffB[2];
#pragma unroll
    for (int i = 0; i < 2; ++i) { int R, C; stage_rc(tid * 16 + i * 8192, R, C); const int Rb = Epi::PERM ? ((R & ~31) + perm32(R & 31)) : R;
        voffA[i] = (unsigned)(R * K + C) * 2u; voffB[i] = (unsigned)(Rb * K + C) * 2u; }
    const size_t kstep = (size_t)(BK * 2);
    const size_t hstep = (size_t)HALF * K * 2;
    const size_t tstep = 2 * hstep;
    const unsigned ldsw = (unsigned)wid * 1024u;
    const int aoff = lds_byte(wr * 64 + fr, fq * 8), boff = lds_byte(wc * 32 + fr, fq * 8);
#define PG8_SA(b, h) (((b) * 2 + (h)) * HTB)
#define PG8_SB(b, h) ((4 + (b) * 2 + (h)) * HTB)
#define PG8_STAGE(bufoff, gbase, voff) do { _Pragma("unroll") for (int _i = 0; _i < 2; ++_i) \
        __builtin_amdgcn_global_load_lds((const unsigned*)((const char*)(gbase) + (voff)[_i]), (PG8_LAS unsigned*)(lds + (bufoff) + ldsw + _i * 8192), 16, 0, 0); } while (0)
#define PG8_STAGE_A(b, h, gbase, usenext) do { if constexpr (GATHER) { const unsigned _v0 = (usenext) ? vAn[h][0] : vAc[h][0], _v1 = (usenext) ? vAn[h][1] : vAc[h][1]; \
        __builtin_amdgcn_global_load_lds((const unsigned*)((const char*)(gbase) + _v0), (PG8_LAS unsigned*)(lds + PG8_SA(b, h) + ldsw), 16, 0, 0); \
        __builtin_amdgcn_global_load_lds((const unsigned*)((const char*)(gbase) + _v1), (PG8_LAS unsigned*)(lds + PG8_SA(b, h) + ldsw + 8192), 16, 0, 0); } \
    else PG8_STAGE(PG8_SA(b, h), (gbase) + (h) * hstep, voffA); } while (0)
#define PG8_LDA(dst, b, h) do { _Pragma("unroll") for (int m = 0; m < 4; ++m) _Pragma("unroll") for (int k = 0; k < 2; ++k) dst[m][k] = *(const PG8_LAS bf16x8*)(lds + PG8_SA(b, h) + aoff + m * 2048 + k * 1024); } while (0)
#define PG8_LDB(dst, b, h) do { _Pragma("unroll") for (int n = 0; n < 2; ++n) _Pragma("unroll") for (int k = 0; k < 2; ++k) dst[n][k] = *(const PG8_LAS bf16x8*)(lds + PG8_SB(b, h) + boff + n * 2048 + k * 1024); } while (0)
#define PG8_MMA(ai, bj, At, Bt) do { if constexpr (!(NHALF && (bj) == 1)) if ((ai) == 0 || !hf_) { __builtin_amdgcn_s_setprio(1); if constexpr (F8) { _Pragma("unroll") for (int m = 0; m < 4; ++m) _Pragma("unroll") for (int n = 0; n < 2; ++n) { \
        if (NHALF || (bj) == 0 || n < F8N1) acc[ai][bj][m][n] = __builtin_amdgcn_mfma_scale_f32_16x16x128_f8f6f4(__builtin_shufflevector(__builtin_bit_cast(i32x4, Bt[n][0]), __builtin_bit_cast(i32x4, Bt[n][1]), 0, 1, 2, 3, 4, 5, 6, 7), \
            __builtin_shufflevector(__builtin_bit_cast(i32x4, At[m][0]), __builtin_bit_cast(i32x4, At[m][1]), 0, 1, 2, 3, 4, 5, 6, 7), acc[ai][bj][m][n], 0, 0, 0, 0, 0, 0); \
        else { _Pragma("unroll") for (int k = 0; k < 2; ++k) { const i64x2 a_ = __builtin_bit_cast(i64x2, At[m][k]), b_ = __builtin_bit_cast(i64x2, Bt[n][k]); \
            acc[ai][bj][m][n] = __builtin_amdgcn_mfma_f32_16x16x32_fp8_fp8(b_[0], a_[0], acc[ai][bj][m][n], 0, 0, 0); \
            acc[ai][bj][m][n] = __builtin_amdgcn_mfma_f32_16x16x32_fp8_fp8(b_[1], a_[1], acc[ai][bj][m][n], 0, 0, 0); } } } } \
    else { _Pragma("unroll") for (int m = 0; m < 4; ++m) _Pragma("unroll") for (int n = 0; n < 2; ++n) _Pragma("unroll") for (int k = 0; k < 2; ++k) \
        acc[ai][bj][m][n] = __builtin_amdgcn_mfma_f32_16x16x32_bf16(Bt[n][k], At[m][k], acc[ai][bj][m][n], 0, 0, 0); } __builtin_amdgcn_s_setprio(0); } } while (0)
#define PG8_WAIT_V(n) asm volatile("s_waitcnt vmcnt(" #n ")" ::: "memory")
#define PG8_WAIT_L(n) asm volatile("s_waitcnt lgkmcnt(" #n ")" ::: "memory")
#define PG8_BAR __builtin_amdgcn_s_barrier()
#define PG8_SCHED __builtin_amdgcn_sched_barrier(0)
    Unit cur, nxt; int ui = 0;
    if (!S.next(0, cur)) return;
    f32x4 acc[2][2][4][2];
#pragma unroll
    for (int a = 0; a < 2; ++a)
#pragma unroll
        for (int b = 0; b < 2; ++b)
#pragma unroll
            for (int m = 0; m < 4; ++m)
#pragma unroll
                for (int n = 0; n < 2; ++n) acc[a][b][m][n] = (f32x4){0.f, 0.f, 0.f, 0.f};
    bf16x8 At[4][2], B0[2][2], B1[2][2];
    const char* cA = (const char*)g.A + (GATHER ? (size_t)0 : (size_t)cur.pm * tstep); const char* cB = (const char*)g.Bt + (size_t)cur.pn * (NHALF ? hstep : tstep);
    unsigned vAc[2][2], vAn[2][2];
    auto gvoff = [&](int pm, unsigned (&v)[2][2]) {
        const int ln_ = (int)__builtin_amdgcn_mbcnt_hi(~0u, __builtin_amdgcn_mbcnt_lo(~0u, (unsigned)pm)) - pm, tid_ = wid * 64 + ln_;
#pragma unroll
        for (int hh = 0; hh < 2; ++hh)
#pragma unroll
            for (int i = 0; i < 2; ++i) { int R, C; stage_rc(tid_ * 16 + i * 8192, R, C); v[hh][i] = (unsigned)g.gidx[(pm - g.gtile0) * 256 + hh * HALF + R] * (unsigned)(K * 2) + (unsigned)(C * 2); } };
    if constexpr (GATHER) { gvoff(cur.pm, vAc); } else { vAc[0][0] = vAc[0][1] = vAc[1][0] = vAc[1][1] = 0u; }
#pragma unroll
    for (int hh = 0; hh < 2; ++hh) { vAn[hh][0] = vAc[hh][0]; vAn[hh][1] = vAc[hh][1]; }
    S.a_ready(cur);
    if constexpr (SP2) {
        PG8_STAGE(PG8_SB(0, 0), cB, voffB); PG8_STAGE(PG8_SB(0, 1), cB + hstep, voffB); PG8_STAGE_A(0, 0, cA, false); PG8_STAGE_A(0, 1, cA, false);
        if (wr == 1) PG8_BAR;
        PG8_WAIT_V(2); PG8_BAR;
        PG8_STAGE(PG8_SB(1, 0), cB + kstep, voffB); PG8_STAGE_A(1, 0, cA + kstep, false); PG8_STAGE(PG8_SB(1, 1), cB + hstep + kstep, voffB);
        PG8_WAIT_V(6); PG8_BAR;
    } else {
        PG8_STAGE(PG8_SB(0, 0), cB, voffB); PG8_STAGE(PG8_SA(0, 0), cA, voffA); PG8_STAGE(PG8_SB(0, 1), cB + hstep, voffB); PG8_STAGE(PG8_SA(0, 1), cA + hstep, voffA);
        if (wr == 1) PG8_BAR;
        PG8_WAIT_V(4); PG8_BAR;
        PG8_STAGE(PG8_SB(1, 0), cB + kstep, voffB); PG8_STAGE(PG8_SA(1, 0), cA + kstep, voffA); PG8_STAGE(PG8_SB(1, 1), cB + hstep + kstep, voffB);
        PG8_WAIT_V(6); PG8_BAR;
    }
    for (;;) {
        const bool has_next = S.next(ui + 1, nxt);
        const bool hf_ = cur.half != 0;
        const char* nA = (has_next && !GATHER) ? (const char*)g.A + (size_t)nxt.pm * tstep : (GATHER ? (const char*)g.A : cA); const char* nB = has_next ? (const char*)g.Bt + (size_t)nxt.pn * (NHALF ? hstep : tstep) : cB;
        if constexpr (GATHER) { if (has_next) gvoff(nxt.pm, vAn); else {
#pragma unroll
            for (int hh = 0; hh < 2; ++hh) { vAn[hh][0] = vAc[hh][0]; vAn[hh][1] = vAc[hh][1]; } } }
        for (int t = 0; t < nt; t += 2) {
            const bool last = (t == nt - 2);
            const char* a1 = cA + (size_t)(t + 1) * kstep;
            const char* a2 = last ? nA : cA + (size_t)(t + 2) * kstep; const char* b2 = last ? nB : cB + (size_t)(t + 2) * kstep;
            const char* a3 = a2 + kstep; const char* b3 = b2 + kstep;
            if (last && has_next) S.a_ready(nxt);
            if constexpr (SP2) {
            PG8_LDB(B0, 0, 0); PG8_LDB(B1, 0, 1); PG8_SCHED; PG8_LDA(At, 0, 0); PG8_STAGE_A(1, 1, a1, false);
            PG8_WAIT_V(8); PG8_WAIT_L(0); PG8_BAR; PG8_MMA(0, 0, At, B0); PG8_MMA(0, 1, At, B1); PG8_BAR; PG8_SCHED;
            PG8_LDA(At, 0, 1); PG8_STAGE(PG8_SB(0, 0), b2, voffB); PG8_STAGE(PG8_SB(0, 1), b2 + hstep, voffB); PG8_STAGE_A(0, 0, a2, last);
            PG8_WAIT_V(8); PG8_WAIT_L(0); PG8_BAR; PG8_MMA(1, 0, At, B0); PG8_MMA(1, 1, At, B1); PG8_BAR; PG8_SCHED;
            PG8_LDB(B0, 1, 0); PG8_LDB(B1, 1, 1); PG8_SCHED; PG8_LDA(At, 1, 0); PG8_STAGE_A(0, 1, a2, last);
            PG8_WAIT_V(8); PG8_WAIT_L(0); PG8_BAR; PG8_MMA(0, 0, At, B0); PG8_MMA(0, 1, At, B1); PG8_BAR; PG8_SCHED;
            PG8_LDA(At, 1, 1); PG8_STAGE(PG8_SB(1, 0), b3, voffB); PG8_STAGE(PG8_SB(1, 1), b3 + hstep, voffB); PG8_STAGE_A(1, 0, a3, last);
            PG8_WAIT_V(8); PG8_WAIT_L(0); PG8_BAR; PG8_MMA(1, 0, At, B0); PG8_MMA(1, 1, At, B1); PG8_BAR; PG8_SCHED;
            } else {
            PG8_LDB(B0, 0, 0); PG8_SCHED; PG8_LDA(At, 0, 0); PG8_STAGE(PG8_SA(1, 1), a1 + hstep, voffA);
            PG8_WAIT_L(8); PG8_BAR; PG8_WAIT_L(0); PG8_MMA(0, 0, At, B0); PG8_BAR; PG8_SCHED;
            PG8_LDB(B1, 0, 1); PG8_STAGE(PG8_SB(0, 0), b2, voffB);
            PG8_BAR; PG8_WAIT_L(0); PG8_MMA(0, 1, At, B1); PG8_BAR;
            PG8_LDA(At, 0, 1); PG8_STAGE(PG8_SA(0, 0), a2, voffA);
            PG8_BAR; PG8_WAIT_L(0); PG8_MMA(1, 0, At, B0); PG8_BAR; PG8_SCHED;
            PG8_STAGE(PG8_SB(0, 1), b2 + hstep, voffB);
            PG8_WAIT_V(6); PG8_BAR; PG8_MMA(1, 1, At, B1); PG8_BAR;
            PG8_LDB(B0, 1, 0); PG8_SCHED; PG8_LDA(At, 1, 0); PG8_STAGE(PG8_SA(0, 1), a2 + hstep, voffA);
            PG8_WAIT_L(8); PG8_BAR; PG8_WAIT_L(0); PG8_MMA(0, 0, At, B0); PG8_BAR; PG8_SCHED;
            PG8_LDB(B1, 1, 1); PG8_STAGE(PG8_SB(1, 0), b3, voffB);
            PG8_BAR; PG8_WAIT_L(0); PG8_MMA(0, 1, At, B1); PG8_BAR;
            PG8_LDA(At, 1, 1); PG8_STAGE(PG8_SA(1, 0), a3, voffA);
            PG8_BAR; PG8_WAIT_L(0); PG8_MMA(1, 0, At, B0); PG8_BAR; PG8_SCHED;
            PG8_STAGE(PG8_SB(1, 1), b3 + hstep, voffB);
            PG8_WAIT_V(6); PG8_BAR; PG8_MMA(1, 1, At, B1); PG8_BAR;
            }
        }
        if constexpr (ALIGN_EPI) { if (wr == 0) PG8_BAR; }
        if constexpr (!Epi::AFTER_DRAIN) {
            const int dep_ = __builtin_amdgcn_readfirstlane(__builtin_bit_cast(int, acc[1][1][3][1][3]));
            const int lane_e = (int)__builtin_amdgcn_mbcnt_hi(~0u, __builtin_amdgcn_mbcnt_lo(~0u, (unsigned)dep_)) - dep_;
            if constexpr (Epi::AMAX) {
                float mx_ = 0.f;
#pragma unroll
                for (int a_ = 0; a_ < 2; ++a_)
#pragma unroll
                    for (int b_ = 0; b_ < 2; ++b_)
#pragma unroll
                        for (int m_ = 0; m_ < 4; ++m_) { const f32x4 s0_ = acc[a_][b_][m_][0] * acc[a_][b_][m_][0] + acc[a_][b_][m_][1] * acc[a_][b_][m_][1];
                            float s_ = (s0_[0] + s0_[1]) + (s0_[2] + s0_[3]); s_ += __shfl_xor(s_, 16); s_ += __shfl_xor(s_, 32); mx_ = fmaxf(mx_, s_); }
#pragma unroll
                for (int o_ = 8; o_ >= 1; o_ >>= 1) mx_ = fmaxf(mx_, __shfl_xor(mx_, o_));
                if (lane_e == 0) (void)__hip_atomic_fetch_max(E.amax, __builtin_bit_cast(unsigned, mx_), __ATOMIC_RELAXED, __HIP_MEMORY_SCOPE_AGENT); }
            E(acc, cur, wr, wc, lane_e & 15, lane_e >> 4); S.done(cur); }
        if (!has_next) break;
#pragma unroll
        for (int a = 0; a < 2; ++a)
#pragma unroll
            for (int b = 0; b < 2; ++b)
#pragma unroll
                for (int m = 0; m < 4; ++m)
#pragma unroll
                    for (int n = 0; n < 2; ++n) acc[a][b][m][n] = (f32x4){0.f, 0.f, 0.f, 0.f};
        cur = nxt; cA = nA; cB = nB; ++ui;
#pragma unroll
        for (int hh = 0; hh < 2; ++hh) { vAc[hh][0] = vAn[hh][0]; vAc[hh][1] = vAn[hh][1]; }
        if constexpr (ALIGN_EPI) { if (wr == 1) PG8_BAR; }
    }
    PG8_WAIT_V(0);
    if constexpr (!ALIGN_EPI) { if (wr == 0) PG8_BAR; }
    PG8_BAR;
    if constexpr (Epi::AFTER_DRAIN) { E.fused(acc, cur, wr, wc, fr, fq, lds, wid, lane); S.done(cur); }
#undef PG8_SA
#undef PG8_SB
#undef PG8_STAGE
#undef PG8_STAGE_A
#undef PG8_LDA
#undef PG8_LDB
#undef PG8_MMA
#undef PG8_WAIT_V
#undef PG8_WAIT_L
#undef PG8_BAR
#undef PG8_SCHED
}
}
constexpr int S = 16384, D = 1024, NLAYER = 4, NE = 32;
constexpr float ALPHA_DN = 1.6817928305074292f;
constexpr float LN_EPS = 1e-5f, RMS_EPS = 1e-6f;
constexpr float LOG2E = 1.4426950408889634f;
constexpr int NWAVES = 8, NTHREADS = 512;
constexpr int MOE_MAXTILES = 288, MOE_ROWS = MOE_MAXTILES * 256;
constexpr size_t MiB = 1u << 20;
constexpr size_t WS_CTL = 0, CTL_ZERO_BYTES = 1 * MiB;
constexpr size_t WS_CS64 = 1 * MiB, WS_CS32 = 5 * MiB;
constexpr size_t WS_WDA = 8 * MiB;
constexpr size_t WS_WMLA = 24 * MiB;
constexpr size_t WS_WNSA = 30 * MiB;
constexpr size_t WS_WMOE = 64 * MiB;
constexpr size_t WS_H = 832 * MiB, WS_H1 = 896 * MiB, WS_Y = 960 * MiB;
constexpr size_t WS_XB = 1024 * MiB, WS_X1B = 1056 * MiB, WS_AO = 1088 * MiB;
constexpr size_t WS_QK = 1120 * MiB;
constexpr size_t WS_VT = 1184 * MiB;
constexpr size_t WS_OH = 1216 * MiB;
constexpr size_t WS_MISC = 1280 * MiB;
constexpr size_t WS_KH = WS_MISC + 96 * MiB;
constexpr size_t WS_AS = 1408 * MiB, WS_ACT = 1552 * MiB, WS_YS = 1696 * MiB;
constexpr size_t WS_ROUTE = 1840 * MiB;
constexpr size_t WS_END = 1844 * MiB;
constexpr size_t MLA_C = 0, MLA_CQN = 32 * MiB, MLA_CKVN = 40 * MiB, MLA_KR = 44 * MiB;
constexpr size_t NSA_P = 0, NSA_ACK = 24 * MiB, NSA_ACV = 40 * MiB, NSA_HK = 56 * MiB, NSA_HV = 58 * MiB, NSA_KC = 60 * MiB, NSA_VCT = 61 * MiB, NSA_SEL = 63 * MiB;
constexpr int CW_BAR = 4096, CW_CNT = 16384  , CW_ERR = 20480  , CW_KMAX = 20608  ;
constexpr int RING_BYTES = 131072, LDSCTL_OFF = RING_BYTES, LDS_GIDX_OFF = LDSCTL_OFF + 4096  , LDS_BYTES = 155648;
constexpr int LC_HIST = 16, LC_BASE = 48, LC_SEG = 80  , LC_LCNT = 120, LC_NT = 152, LC_TILEE = 160  , LC_POS = 512  , LC_LAM = 800;

#define GAS __attribute__((address_space(1)))
#define LAS __attribute__((address_space(3)))
typedef unsigned short bf16;
typedef unsigned v4u __attribute__((ext_vector_type(4)));
typedef unsigned v2u __attribute__((ext_vector_type(2)));
typedef float f32x4 __attribute__((ext_vector_type(4)));
typedef float f32x16 __attribute__((ext_vector_type(16)));
typedef float f32x8v __attribute__((ext_vector_type(8)));
typedef float f32x2v __attribute__((ext_vector_type(2)));
__device__ __forceinline__ float sum32pk(const f32x16& a, const f32x16& b) {
    const f32x16 s = a + b;
    const f32x8v s8 = __builtin_shufflevector(s, s, 0, 1, 2, 3, 4, 5, 6, 7) + __builtin_shufflevector(s, s, 8, 9, 10, 11, 12, 13, 14, 15);
    const f32x4 s4 = __builtin_shufflevector(s8, s8, 0, 1, 2, 3) + __builtin_shufflevector(s8, s8, 4, 5, 6, 7);
    const f32x2v s2 = __builtin_shufflevector(s4, s4, 0, 1) + __builtin_shufflevector(s4, s4, 2, 3);
    return s2.x + s2.y;
}
typedef short bf16x8 __attribute__((ext_vector_type(8)));
typedef pg8::cs_t cs_t;
__device__ __forceinline__ unsigned f2bf(float f) { unsigned u = __builtin_bit_cast(unsigned, f); return (u + 0x7fffu + ((u >> 16) & 1u)) >> 16; }
__device__ __forceinline__ unsigned pk2(float lo, float hi) { return pg8::cvt_pk_bf16(lo, hi); }
__device__ __forceinline__ float bf2f(unsigned short b) { return __builtin_bit_cast(float, (unsigned)b << 16); }
__device__ __forceinline__ float bflo(unsigned w) { return __builtin_bit_cast(float, w << 16); }
__device__ __forceinline__ float bfhi(unsigned w) { return __builtin_bit_cast(float, w & 0xffff0000u); }
__device__ __forceinline__ float wave_sum(float v) {
#pragma unroll
    for (int o = 1; o < 64; o <<= 1) v += __shfl_xor(v, o);
    return v;
}
__device__ __forceinline__ float wave_max(float v) {
#pragma unroll
    for (int o = 1; o < 64; o <<= 1) v = fmaxf(v, __shfl_xor(v, o));
    return v;
}
__device__ __forceinline__ float swap32f(float v, int hi) {
    auto rr = __builtin_amdgcn_permlane32_swap(__float_as_uint(v), __float_as_uint(v), false, false);
    return hi ? __uint_as_float(rr[0]) : __uint_as_float(rr[1]);
}

__device__ __forceinline__ float swap16f(float v, int odd) {
    auto rr = __builtin_amdgcn_permlane16_swap(__float_as_uint(v), __float_as_uint(v), false, false);
    return odd ? __uint_as_float(rr[0]) : __uint_as_float(rr[1]);
}

#define XB_TMO      128
#define XB_XCNT(j)  (256  + 64 * (j))
#define XB_XSUB(j)  (1280 + 64 * (j))
#define XB_XGEN(j)  (2304 + 64 * (j))
#define XB_TOP      3328
#define XB_TOPGEN   3392
#define XCD_BAR_WORDS 3456
#define XB_SPIN_CAP (1u << 18)
__device__ __forceinline__ unsigned xb_ld(unsigned* p)              { return __hip_atomic_load(p, __ATOMIC_RELAXED, __HIP_MEMORY_SCOPE_AGENT); }
__device__ __forceinline__ unsigned xb_add(unsigned* p, unsigned v) { return __hip_atomic_fetch_add(p, v, __ATOMIC_RELAXED, __HIP_MEMORY_SCOPE_AGENT); }
__device__ __forceinline__ unsigned xb_xcc_id() { return (unsigned)__builtin_amdgcn_s_getreg((3 << 11) | 20) & 0xFu; }
#define XB_SPIN(cond, bar) do { unsigned _sp = 0; while (cond) { __builtin_amdgcn_s_sleep(1); \
    if ((++_sp & 255u) == 0u) { if (xb_ld(&(bar)[XB_TMO])) break; if (_sp > XB_SPIN_CAP) { atomicAdd(&(bar)[XB_TMO], 1u); break; } } } } while (0)
struct XcdBarrier { unsigned* bar; unsigned x; volatile LAS unsigned* st; };
__device__ __forceinline__ XcdBarrier xcd_barrier_post(unsigned* bar, volatile LAS unsigned* st, int tid0) {
    XcdBarrier b; b.bar = bar; b.x = xb_xcc_id(); b.st = st;
    if (tid0 == 0) (void)xb_add(&bar[XB_XCNT(b.x)], 1u);
    return b;
}
__device__ __forceinline__ void xcd_barrier_complete(unsigned* bar, unsigned x, unsigned& nloc, unsigned& nx) {
    const unsigned G = gridDim.x * gridDim.y * gridDim.z;
    unsigned sum, cnt, mine, sp = 0u;
    for (;;) {
        sum = 0u; cnt = 0u; mine = 0u;
#pragma unroll
        for (unsigned j = 0; j < 16; ++j) { const unsigned c = xb_ld(&bar[XB_XCNT(j)]); sum += c; cnt += (c > 0u) ? 1u : 0u; mine = (j == x) ? c : mine; }
        if (sum == G) break;
        __builtin_amdgcn_s_sleep(1);
        if ((++sp & 255u) == 0u) { if (xb_ld(&bar[XB_TMO])) break; if (sp > XB_SPIN_CAP) { atomicAdd(&bar[XB_TMO], 1u); break; } }
    }
    nloc = mine > 0u ? mine : 1u; nx = cnt > 0u ? cnt : 1u;
}
__device__ __forceinline__ void xcd_barrier(const XcdBarrier& b, int tid0) {
    asm volatile("s_waitcnt vmcnt(0)" ::: "memory");
    __syncthreads();
    if (tid0 == 0) {
        unsigned* bar = b.bar;
        __builtin_amdgcn_s_waitcnt(0);
        unsigned nloc = b.st[0], nx = b.st[1];
        if (nloc == 0u) { xcd_barrier_complete(bar, b.x, nloc, nx); b.st[0] = nloc; b.st[1] = nx; }
        const unsigned old = xb_add(&bar[XB_XSUB(b.x)], 1u);
        const unsigned gen = old / nloc;
        if (old + 1u == (gen + 1u) * nloc) {
            __builtin_amdgcn_fence(__ATOMIC_RELEASE, "agent");
            asm volatile("s_waitcnt vmcnt(0)" ::: "memory");
            const unsigned og = xb_add(&bar[XB_TOP], 1u);
            const unsigned tg = og / nx;
            if (og + 1u == (tg + 1u) * nx) xb_add(&bar[XB_TOPGEN], 1u);
            else XB_SPIN(xb_ld(&bar[XB_TOPGEN]) == tg, bar);
            __builtin_amdgcn_fence(__ATOMIC_ACQUIRE, "agent");
            xb_add(&bar[XB_XGEN(b.x)], 1u);
            asm volatile("s_waitcnt vmcnt(0)" ::: "memory");
        } else {
            XB_SPIN(xb_ld(&bar[XB_XGEN(b.x)]) == gen, bar);
            __builtin_amdgcn_fence(__ATOMIC_ACQUIRE, "agent");
            asm volatile("s_waitcnt vmcnt(0)" ::: "memory");
        }
    }
    __syncthreads();
}

enum CvtMode { CM_IDENT = 0, CM_ROPE64 = 1, CM_MLAQ = 2, CM_MLAKV = 3, CM_NSAIN = 4, CM_SWIGLU = 5 };
struct Job { const float* src; bf16* dst; long long sbs, dbs; int ld, K, ncols, col0, mode, nbatch, item0, pad; };
constexpr int MAXJOBS = 32;
enum { I_X = 0, I_DA_WIN, I_DA_LQ1, I_DA_LK1, I_DA_LQ2, I_DA_LK2, I_DA_SUBLN, I_DA_WOUT, I_MLA_WIN, I_MLA_QN, I_MLA_KVN, I_MLA_WUQ, I_MLA_WUKV, I_MLA_WOUT,
       I_NSA_WIN, I_NSA_POSK, I_NSA_POSV, I_NSA_KW1, I_NSA_KW2, I_NSA_VW1, I_NSA_VW2, I_NSA_WOUT, I_LN1G, I_LN1B, I_LN2G, I_LN2B, I_MOE_WR, I_MOE_BR, I_MOE_WGU, I_MOE_BGU, I_MOE_WDN, I_MOE_BDN, N_IN };
struct Args { const float* in[N_IN]; float* out; unsigned char* ws; Job jobs[MAXJOBS]; int njobs, nitems, ph_lo, ph_hi; };

__device__ __forceinline__ int rope64_row(int hv, int d) { return 256 * (hv >> 2) + 128 * (d >> 5) + 32 * (hv & 3) + (d & 31); }
__device__ __forceinline__ int cvt_dst_row(int mode, int f) {
    switch (mode) {
    case CM_ROPE64: return rope64_row(f >> 6, f & 63);
    case CM_MLAQ: { const int head = f / 96, d = f - head * 96; if (d < 64) return 64 * head + d; const int r = d - 64; return 1024 + 256 * (head >> 3) + 128 * (r >> 4) + 16 * (head & 7) + (r & 15); }
    case CM_MLAKV: { const int head = f >> 7, d = f & 127; return d < 64 ? 64 * head + d : 1024 + 64 * head + (d - 64); }
    case CM_NSAIN: {
        if (f < 1024) return rope64_row(f >> 6, f & 63);
        if (f < 1280) return 1536 + (f - 1024);
        if (f < 1536) return 1792 + (f - 1280);
        if (f < 1792) return rope64_row(16 + ((f - 1536) >> 6), f & 63);
        if (f < 2048) return 2304 + (f - 1792);
        if (f < 2304) return rope64_row(20 + ((f - 2048) >> 6), f & 63);
        if (f < 2560) return 2560 + (f - 2304);
        return 2048 + (f - 2560); }
    case CM_SWIGLU: { const int j = f >> 1; return 256 * (j >> 7) + 128 * (f & 1) + (j & 127); }
    default: return f;
    }
}
__device__ __forceinline__ void cvt_item(const Job& J, int item, LAS unsigned char* scr, int lane) {
    const int nblk = (J.ncols + 63) >> 6, per_b = (J.K >> 6) * nblk;
    const int b = item / per_b, r = item - b * per_b, kb = r / nblk, nb = r - kb * nblk, k0 = 64 * kb, n0 = 64 * nb;
    const int col = n0 + lane; const bool ok = col < J.ncols;
    const float* W = J.src + (size_t)b * J.sbs + (size_t)k0 * J.ld + J.col0 + (ok ? col : 0);
    float v[64];
#pragma unroll
    for (int i = 0; i < 64; ++i) v[i] = __builtin_nontemporal_load(W + (size_t)i * J.ld);
#pragma unroll
    for (int q = 0; q < 8; ++q) { v4u o; o.x = pk2(v[8 * q], v[8 * q + 1]); o.y = pk2(v[8 * q + 2], v[8 * q + 3]); o.z = pk2(v[8 * q + 4], v[8 * q + 5]); o.w = pk2(v[8 * q + 6], v[8 * q + 7]);
        *(LAS v4u*)(scr + lane * 144 + q * 16) = o; }
    asm volatile("s_waitcnt lgkmcnt(0)" ::: "memory");
    bf16* dstb = J.dst + (size_t)b * J.dbs + k0;
#pragma unroll
    for (int s = 0; s < 8; ++s) { const int rl = 8 * s + (lane >> 3), ch = lane & 7;
        const v4u o = *(const LAS v4u*)(scr + rl * 144 + ch * 16);
        if (n0 + rl < J.ncols) __builtin_nontemporal_store(o, (v4u*)(dstb + (size_t)cvt_dst_row(J.mode, n0 + rl) * J.K + ch * 8)); }
    asm volatile("s_waitcnt lgkmcnt(0)" ::: "memory");
}
__device__ __forceinline__ void cvt_item_f8(const Job& J, int item, LAS unsigned char* scr, int lane) {
    const int nblk = (J.ncols + 63) >> 6, per_b = (J.K >> 7) * nblk;
    const int b = item / per_b, r = item - b * per_b, kb = r / nblk, nb = r - kb * nblk, n0 = 64 * nb;
    const bool perm = J.pad == 1;
    const float* W = J.src + (size_t)b * J.sbs + J.col0 + n0 + lane;
#pragma unroll
    for (int h = 0; h < 2; ++h) {
        float v[64];
#pragma unroll
        for (int q = 0; q < 4; ++q)
#pragma unroll
            for (int m = 0; m < 16; ++m) { const int row = perm ? 8 * kb + 4 * h + q + 64 * m : 128 * kb + 64 * h + 16 * q + m; v[16 * q + m] = __builtin_nontemporal_load(W + (size_t)row * J.ld); }
#pragma unroll
        for (int q = 0; q < 4; ++q) { v4u o; int w;
            w = __builtin_amdgcn_cvt_pk_fp8_f32(v[16 * q + 0] * 64.f, v[16 * q + 1] * 64.f, 0, false); w = __builtin_amdgcn_cvt_pk_fp8_f32(v[16 * q + 2] * 64.f, v[16 * q + 3] * 64.f, w, true); o.x = (unsigned)w;
            w = __builtin_amdgcn_cvt_pk_fp8_f32(v[16 * q + 4] * 64.f, v[16 * q + 5] * 64.f, 0, false); w = __builtin_amdgcn_cvt_pk_fp8_f32(v[16 * q + 6] * 64.f, v[16 * q + 7] * 64.f, w, true); o.y = (unsigned)w;
            w = __builtin_amdgcn_cvt_pk_fp8_f32(v[16 * q + 8] * 64.f, v[16 * q + 9] * 64.f, 0, false); w = __builtin_amdgcn_cvt_pk_fp8_f32(v[16 * q + 10] * 64.f, v[16 * q + 11] * 64.f, w, true); o.z = (unsigned)w;
            w = __builtin_amdgcn_cvt_pk_fp8_f32(v[16 * q + 12] * 64.f, v[16 * q + 13] * 64.f, 0, false); w = __builtin_amdgcn_cvt_pk_fp8_f32(v[16 * q + 14] * 64.f, v[16 * q + 15] * 64.f, w, true); o.w = (unsigned)w;
            *(LAS v4u*)(scr + lane * 144 + (4 * h + q) * 16) = o; }
    }
    asm volatile("s_waitcnt lgkmcnt(0)" ::: "memory");
    unsigned char* dstb = (unsigned char*)J.dst + (size_t)b * J.dbs + 128 * kb;
#pragma unroll
    for (int s = 0; s < 8; ++s) { const int rl = 8 * s + (lane >> 3), ch = lane & 7;
        const v4u o = *(const LAS v4u*)(scr + rl * 144 + ch * 16);
        __builtin_nontemporal_store(o, (v4u*)(dstb + (size_t)cvt_dst_row(J.mode, n0 + rl) * J.K + ch * 16)); }
    asm volatile("s_waitcnt lgkmcnt(0)" ::: "memory");
}
__device__ __forceinline__ unsigned lds_inc(LAS unsigned* p) { return __hip_atomic_fetch_add(p, 1u, __ATOMIC_RELAXED, __HIP_MEMORY_SCOPE_WORKGROUP); }
#define WSP(T, off) ((T*)(a.ws + (off)))
__device__ __forceinline__ void zero_rows(bf16* dst, int K, int r0, int r1, int gtid, int gthreads) {
    v4u* p = (v4u*)(dst + (size_t)r0 * K); const int n = (r1 - r0) * K / 8;
    for (int i = gtid; i < n; i += gthreads) p[i] = (v4u){0u, 0u, 0u, 0u};
}
__device__ __forceinline__ void phase_prologue(const Args& a, LAS unsigned char* lds, int tid, int lane, int wave) {
    const int gw = blockIdx.x * NWAVES + wave, NGW = gridDim.x * NWAVES;
    const int gtid = blockIdx.x * NTHREADS + tid, GT = gridDim.x * NTHREADS;
    LAS unsigned char* scr = lds + wave * 9216;
    for (int it = gw; it < a.nitems; it += NGW) {
        int j = 0;
        for (int q = 1; q < a.njobs; ++q) if (it >= a.jobs[q].item0) j = q;
        j = __builtin_amdgcn_readfirstlane(j);
        if (a.jobs[j].pad) cvt_item_f8(a.jobs[j], it - a.jobs[j].item0, scr, lane); else cvt_item(a.jobs[j], it - a.jobs[j].item0, scr, lane);
    }
    zero_rows(WSP(bf16, WS_WMLA), 1024, 416, 512, gtid, GT);
    zero_rows(WSP(bf16, WS_WNSA), 1024, 2096, 2304, gtid, GT);
    zero_rows(WSP(bf16, WS_WNSA + 8 * MiB), 256, 32, 128, gtid, GT);
    zero_rows(WSP(bf16, WS_WNSA + 8 * MiB), 256, 160, 256, gtid, GT);
    zero_rows(WSP(bf16, WS_WNSA + 8 * MiB + 131072), 256, 64, 256, gtid, GT);
    cs_t* cs64 = WSP(cs_t, WS_CS64); cs_t* cs32 = WSP(cs_t, WS_CS32);
    for (int i = gtid; i < S * 48; i += GT) {
        int pos, fi; float inv; cs_t* dst;
        if (i < S * 32) { pos = i >> 5; fi = i & 31; inv = exp2f(-(float)fi * (13.287712379549449f / 32.0f)); dst = cs64 + i; }
        else { const int k = i - S * 32; pos = k >> 4; fi = k & 15; inv = exp2f(-(float)fi * (13.287712379549449f / 16.0f)); dst = cs32 + k; }
        const float ang = (float)pos * inv;
        const double t = (double)ang * 0.15915494309189535; const double fr = t - __builtin_rint(t);
        cs_t o; o.c = __builtin_amdgcn_cosf((float)fr); o.s = __builtin_amdgcn_sinf((float)fr); *dst = o;
    }
    const f32x4* x4 = (const f32x4*)a.in[I_X]; v2u* xb = WSP(v2u, WS_XB);
    for (int i = gtid; i < S * D / 4; i += GT) { const f32x4 v = x4[i]; v2u o; o.x = pk2(v[0], v[1]); o.y = pk2(v[2], v[3]); xb[i] = o; }
}

__device__ __forceinline__ void phase_ln1_router(const Args& a, LAS unsigned char* lds, int layer, int tid, int lane, int wave) {
    const float* wr = a.in[I_MOE_WR] + (size_t)layer * 1024 * 32;
    LAS float* wl = (LAS float*)lds;
    for (int i = tid; i < 8192; i += NTHREADS) { const f32x4 v = ((const f32x4*)wr)[i]; const int k = i >> 3, ch = i & 7, R = (k & 15) * 64 + (k >> 4), pch = ch ^ ((R >> 1) & 7); *(LAS f32x4*)(wl + R * 32 + pch * 4) = v; }
    LAS unsigned* lc = (LAS unsigned*)(lds + LDSCTL_OFF);
    if (tid < 32) lc[LC_HIST + tid] = 0u;
    __syncthreads();
    const float* gn = a.in[I_LN1G] + layer * 1024; const float* bn = a.in[I_LN1B] + layer * 1024; const float* br = a.in[I_MOE_BR] + layer * 32;
    const bf16* Y = WSP(bf16, WS_Y); const bf16* XBr = WSP(bf16, WS_XB); bf16* X1B = WSP(bf16, WS_X1B);
    int* top_e = WSP(int, WS_ROUTE); float* gate = WSP(float, WS_ROUTE + 262144);
    const int sw = (lane >> 1) & 7;
    for (int i = 0; i < 8; ++i) {
        const int t = blockIdx.x * 64 + wave * 8 + i;
        float v[16]; float s = 0.f;
        { const v4u* hp = (const v4u*)(XBr + (size_t)t * 1024 + 16 * lane); const v4u* yp = (const v4u*)(Y + (size_t)t * 1024 + 16 * lane);
          const v4u h0 = hp[0], h1 = hp[1], y0 = yp[0], y1 = yp[1];
          const unsigned hw[8] = {h0.x, h0.y, h0.z, h0.w, h1.x, h1.y, h1.z, h1.w}, yw[8] = {y0.x, y0.y, y0.z, y0.w, y1.x, y1.y, y1.z, y1.w};
#pragma unroll
          for (int q = 0; q < 8; ++q) { v[2 * q] = ALPHA_DN * bflo(hw[q]) + bflo(yw[q]); v[2 * q + 1] = ALPHA_DN * bfhi(hw[q]) + bfhi(yw[q]); s += v[2 * q] + v[2 * q + 1]; } }
        const float mean = wave_sum(s) * (1.0f / 1024.0f); float s2 = 0.f;
#pragma unroll
        for (int m = 0; m < 16; ++m) { v[m] -= mean; s2 += v[m] * v[m]; }
        const float rstd = 1.0f / sqrtf(wave_sum(s2) * (1.0f / 1024.0f) + LN_EPS);
        { const f32x4* g4 = (const f32x4*)(gn + 16 * lane); const f32x4* b4 = (const f32x4*)(bn + 16 * lane);
#pragma unroll
          for (int q = 0; q < 4; ++q) { const f32x4 gg = g4[q], bb = b4[q];
#pragma unroll
              for (int e = 0; e < 4; ++e) v[4 * q + e] = v[4 * q + e] * rstd * gg[e] + bb[e]; }
          v4u o0, o1; o0.x = pk2(v[0], v[1]); o0.y = pk2(v[2], v[3]); o0.z = pk2(v[4], v[5]); o0.w = pk2(v[6], v[7]); o1.x = pk2(v[8], v[9]); o1.y = pk2(v[10], v[11]); o1.z = pk2(v[12], v[13]); o1.w = pk2(v[14], v[15]);
          v4u* xp = (v4u*)(X1B + (size_t)t * 1024 + 16 * lane); xp[0] = o0; xp[1] = o1; }
        {
            v4u o; int w;
            w = __builtin_amdgcn_cvt_pk_fp8_f32(v[0], v[1], 0, false); w = __builtin_amdgcn_cvt_pk_fp8_f32(v[2], v[3], w, true); o.x = (unsigned)w;
            w = __builtin_amdgcn_cvt_pk_fp8_f32(v[4], v[5], 0, false); w = __builtin_amdgcn_cvt_pk_fp8_f32(v[6], v[7], w, true); o.y = (unsigned)w;
            w = __builtin_amdgcn_cvt_pk_fp8_f32(v[8], v[9], 0, false); w = __builtin_amdgcn_cvt_pk_fp8_f32(v[10], v[11], w, true); o.z = (unsigned)w;
            w = __builtin_amdgcn_cvt_pk_fp8_f32(v[12], v[13], 0, false); w = __builtin_amdgcn_cvt_pk_fp8_f32(v[14], v[15], w, true); o.w = (unsigned)w;
            *(v4u*)(WSP(unsigned char, WS_AS) + (size_t)t * 1024 + lane * 16) = o; }
        float acc[32];
#pragma unroll
        for (int e = 0; e < 32; ++e) acc[e] = 0.f;
#pragma unroll
        for (int m = 0; m < 16; ++m) { const LAS float* wrow = wl + (lane + 64 * m) * 32;
#pragma unroll
            for (int ch = 0; ch < 8; ++ch) { const f32x4 w = *(const LAS f32x4*)(wrow + ((ch ^ sw) << 2));
                acc[4 * ch + 0] += v[m] * w[0]; acc[4 * ch + 1] += v[m] * w[1]; acc[4 * ch + 2] += v[m] * w[2]; acc[4 * ch + 3] += v[m] * w[3]; } }
        float a16[16], a8[8], a4[4], a2[2];
        { const bool b = (lane & 32) != 0;
#pragma unroll
          for (int q = 0; q < 16; ++q) { const float send = b ? acc[q] : acc[q + 16], keep = b ? acc[q + 16] : acc[q]; a16[q] = keep + __shfl_xor(send, 32); } }
        { const bool b = (lane & 16) != 0;
#pragma unroll
          for (int q = 0; q < 8; ++q) { const float send = b ? a16[q] : a16[q + 8], keep = b ? a16[q + 8] : a16[q]; a8[q] = keep + __shfl_xor(send, 16); } }
        { const bool b = (lane & 8) != 0;
#pragma unroll
          for (int q = 0; q < 4; ++q) { const float send = b ? a8[q] : a8[q + 4], keep = b ? a8[q + 4] : a8[q]; a4[q] = keep + __shfl_xor(send, 8); } }
        { const bool b = (lane & 4) != 0;
#pragma unroll
          for (int q = 0; q < 2; ++q) { const float send = b ? a4[q] : a4[q + 2], keep = b ? a4[q + 2] : a4[q]; a2[q] = keep + __shfl_xor(send, 4); } }
        float lg;
        { const bool b = (lane & 2) != 0; const float send = b ? a2[0] : a2[1], keep = b ? a2[1] : a2[0]; lg = keep + __shfl_xor(send, 2); }
        lg += __shfl_xor(lg, 1);
        lg += br[lane >> 1];
        float tv[4]; int te[4];
#pragma unroll
        for (int r = 0; r < 4; ++r) {
            const float mx = wave_max(lg);
            const unsigned long long bal = __ballot(lg == mx);
            const int sl = __ffsll((long long)bal) - 1; const int e = sl >> 1;
            tv[r] = mx; te[r] = e;
            if ((lane >> 1) == e) lg = -INFINITY;
        }
        if (lane == 0) {
            const float e1 = __expf(tv[1] - tv[0]), e2 = __expf(tv[2] - tv[0]), e3 = __expf(tv[3] - tv[0]); const float inv = 1.0f / (1.0f + e1 + e2 + e3);
            *(int4*)(top_e + (size_t)t * 4) = make_int4(te[0], te[1], te[2], te[3]);
            *(float4*)(gate + (size_t)t * 4) = make_float4(inv, e1 * inv, e2 * inv, e3 * inv);
            lds_inc(lc + LC_HIST + te[0]); lds_inc(lc + LC_HIST + te[1]); lds_inc(lc + LC_HIST + te[2]); lds_inc(lc + LC_HIST + te[3]);
        }
    }
    __syncthreads();
    if (tid < 32) { unsigned* cnt = WSP(unsigned, WS_CTL) + CW_CNT + layer * 32; const unsigned h = lc[LC_HIST + tid]; lc[LC_BASE + tid] = xb_add(cnt + tid, h); }
    __syncthreads();
}

__device__ __forceinline__ void phase_place(const Args& a, LAS unsigned char* lds, int layer, int tid, int lane, int wave) {
    LAS unsigned* lc = (LAS unsigned*)(lds + LDSCTL_OFF);
    unsigned* cnt = WSP(unsigned, WS_CTL) + CW_CNT + layer * 32;
    if (tid < 64) {
        const unsigned c = (lane < 32) ? xb_ld(cnt + lane) : 0u; const unsigned nt = (c + 255u) >> 8;
        unsigned inc = nt;
#pragma unroll
        for (int o = 1; o < 32; o <<= 1) { const unsigned up = __shfl_up(inc, o); if (lane >= o) inc += up; }
        const unsigned ts = inc - nt;
        if (lane < 32) { lc[LC_SEG + lane] = ts * 256u; for (unsigned q = 0; q < nt; ++q) lc[LC_TILEE + ts + q] = (unsigned)lane | ((c - 256u * q <= 128u) ? 256u : 0u); }
        if (lane == 31) lc[LC_NT] = inc;
    }
    if (tid >= 64 && tid < 96) lc[LC_LCNT + tid - 64] = 0u;
    __syncthreads();
    const int* top_e = WSP(int, WS_ROUTE); const float* gate = WSP(float, WS_ROUTE + 262144); int* tokpos = WSP(int, WS_ROUTE + 524288); float* rgate = WSP(float, WS_ROUTE + 786432);
    if (tid < 256) { const int t = blockIdx.x * 64 + (tid >> 2); const int e = top_e[(size_t)t * 4 + (tid & 3)];
        const unsigned rank = lds_inc(lc + LC_LCNT + e); const unsigned pos = lc[LC_SEG + e] + lc[LC_BASE + e] + rank;
        rgate[pos] = gate[(size_t)t * 4 + (tid & 3)]; tokpos[(size_t)t * 4 + (tid & 3)] = (int)pos; WSP(unsigned short, WS_ROUTE + 2 * MiB)[pos] = (unsigned short)t; }
    __syncthreads();
    if (blockIdx.x < 32) { const int e = blockIdx.x; const unsigned c = xb_ld(cnt + e), seg = lc[LC_SEG + e], pad = ((c + 255u) & ~255u) - c;
        unsigned short* rt = WSP(unsigned short, WS_ROUTE + 2 * MiB) + seg + c;
        for (unsigned q = tid; q < pad; q += NTHREADS) rt[q] = 0; }
    __syncthreads();
}

__device__ __forceinline__ void phase_ln2(const Args& a, int layer, float* fout, int tid, int lane, int wave) {
    const float* gn = a.in[I_LN2G] + layer * 1024; const float* bn = a.in[I_LN2B] + layer * 1024;
    const bf16* X1B = WSP(bf16, WS_X1B); const bf16* Ys = WSP(bf16, WS_YS); const int* tokpos = WSP(int, WS_ROUTE + 524288); bf16* XB = WSP(bf16, WS_XB);
    for (int i = 0; i < 8; ++i) {
        const int t = blockIdx.x * 64 + wave * 8 + i;
        const int4 pp = *(const int4*)(tokpos + (size_t)t * 4);
        f32x4 v[4]; float s = 0.f;
#pragma unroll
        for (int j = 0; j < 4; ++j) { const int k = 256 * j + 4 * lane; const v2u hw = *(const v2u*)(X1B + (size_t)t * 1024 + k);
            f32x4 h = (f32x4){bflo(hw.x), bfhi(hw.x), bflo(hw.y), bfhi(hw.y)} * ALPHA_DN;
            const unsigned char* Y8 = (const unsigned char*)Ys;
            const int w0 = *(const int*)(Y8 + (size_t)pp.x * 1024 + k), w1 = *(const int*)(Y8 + (size_t)pp.y * 1024 + k), w2 = *(const int*)(Y8 + (size_t)pp.z * 1024 + k), w3 = *(const int*)(Y8 + (size_t)pp.w * 1024 + k);
            const f32x2v a0 = __builtin_amdgcn_cvt_pk_f32_fp8(w0, false), a1 = __builtin_amdgcn_cvt_pk_f32_fp8(w1, false), a2 = __builtin_amdgcn_cvt_pk_f32_fp8(w2, false), a3 = __builtin_amdgcn_cvt_pk_f32_fp8(w3, false);
            const f32x2v c0 = __builtin_amdgcn_cvt_pk_f32_fp8(w0, true), c1 = __builtin_amdgcn_cvt_pk_f32_fp8(w1, true), c2 = __builtin_amdgcn_cvt_pk_f32_fp8(w2, true), c3 = __builtin_amdgcn_cvt_pk_f32_fp8(w3, true);
            h[0] += ((a0.x + a1.x) + (a2.x + a3.x)) * 0.0625f; h[1] += ((a0.y + a1.y) + (a2.y + a3.y)) * 0.0625f;
            h[2] += ((c0.x + c1.x) + (c2.x + c3.x)) * 0.0625f; h[3] += ((c0.y + c1.y) + (c2.y + c3.y)) * 0.0625f;
            v[j] = h; s += (h[0] + h[1]) + (h[2] + h[3]); }
        const float mean = wave_sum(s) * (1.0f / 1024.0f); float s2 = 0.f;
#pragma unroll
        for (int j = 0; j < 4; ++j) { v[j] = v[j] - mean; s2 += (v[j][0] * v[j][0] + v[j][1] * v[j][1]) + (v[j][2] * v[j][2] + v[j][3] * v[j][3]); }
        const float rstd = 1.0f / sqrtf(wave_sum(s2) * (1.0f / 1024.0f) + LN_EPS);
#pragma unroll
        for (int j = 0; j < 4; ++j) { const int k = 256 * j + 4 * lane; const f32x4 g4 = *(const f32x4*)(gn + k), b4 = *(const f32x4*)(bn + k);
            const f32x4 o = v[j] * rstd * g4 + b4;
            if (fout) *(f32x4*)(fout + (size_t)t * 1024 + k) = o;
            else { v2u w; w.x = pk2(o[0], o[1]); w.y = pk2(o[2], o[3]); *(v2u*)(XB + (size_t)t * 1024 + k) = w; } }
    }
}

__device__ __forceinline__ float da_lambda(const Args& a, int j, float lam_init, int lane) {
    const float q1 = a.in[I_DA_LQ1][j * 64 + lane], k1 = a.in[I_DA_LK1][j * 64 + lane], q2 = a.in[I_DA_LQ2][j * 64 + lane], k2 = a.in[I_DA_LK2][j * 64 + lane];
    return __expf(wave_sum(q1 * k1)) - __expf(wave_sum(q2 * k2)) + lam_init;
}
__device__ __forceinline__ void phase_mla_norm(const Args& a, int tid, int lane, int wave) {
    const float* C = WSP(float, WS_MISC + MLA_C); bf16* cqn = WSP(bf16, WS_MISC + MLA_CQN); bf16* ckvn = WSP(bf16, WS_MISC + MLA_CKVN); bf16* Kr = WSP(bf16, WS_MISC + MLA_KR);
    const cs_t* cs32 = WSP(cs_t, WS_CS32);
    const f32x4 gq = *(const f32x4*)(a.in[I_MLA_QN] + 4 * lane); const float gk0 = a.in[I_MLA_KVN][2 * lane], gk1 = a.in[I_MLA_KVN][2 * lane + 1];
    const int gw = blockIdx.x * NWAVES + wave, NGW = gridDim.x * NWAVES;
    for (int t = gw; t < S; t += NGW) {
        const float* row = C + (size_t)t * 512;
        const f32x4 q = *(const f32x4*)(row + 4 * lane);
        const float rq = 1.0f / sqrtf(wave_sum((q[0] * q[0] + q[1] * q[1]) + (q[2] * q[2] + q[3] * q[3])) * (1.0f / 256.0f) + RMS_EPS);
        v2u w; w.x = pk2(q[0] * rq * gq[0], q[1] * rq * gq[1]); w.y = pk2(q[2] * rq * gq[2], q[3] * rq * gq[3]); *(v2u*)(cqn + (size_t)t * 256 + 4 * lane) = w;
        const float k0 = row[256 + 2 * lane], k1 = row[256 + 2 * lane + 1];
        const float rk = 1.0f / sqrtf(wave_sum(k0 * k0 + k1 * k1) * (1.0f / 128.0f) + RMS_EPS);
        *(unsigned*)(ckvn + (size_t)t * 128 + 2 * lane) = pk2(k0 * rk * gk0, k1 * rk * gk1);
        if (lane < 16) { const float x1 = row[384 + lane], x2 = row[400 + lane]; const cs_t cs = cs32[(size_t)t * 16 + lane];
            Kr[(size_t)t * 32 + lane] = (bf16)f2bf(x1 * cs.c - x2 * cs.s); Kr[(size_t)t * 32 + 16 + lane] = (bf16)f2bf(x2 * cs.c + x1 * cs.s); }
    }
}

__device__ __forceinline__ void phase_nsa_cmp_gather(const Args& a, int tid) {
    const bf16* P = WSP(bf16, WS_MISC + NSA_P);
    const int gtid = blockIdx.x * NTHREADS + tid, GT = gridDim.x * NTHREADS;
    for (int id = gtid; id < 2 * 4096 * 256; id += GT) {
        const int c8 = id & 7, l = (id >> 3) & 31, n = (id >> 8) & 1023, g = (id >> 18) & 3, kv = id >> 20;
        bf16* dst = WSP(bf16, WS_MISC + (kv ? NSA_ACV : NSA_ACK)) + ((size_t)(g * 1024 + n) * 2048 + l * 64 + c8 * 8);
        v4u o = (v4u){0u, 0u, 0u, 0u};
        if (n < 1023) {
            const v4u x = *(const v4u*)(P + (size_t)(16 * n + l) * 768 + kv * 256 + g * 64 + c8 * 8);
            const float* pp = a.in[kv ? I_NSA_POSV : I_NSA_POSK] + l * 64 + c8 * 8;
            const f32x4 p0 = *(const f32x4*)pp, p1 = *(const f32x4*)(pp + 4);
            o.x = pk2(bflo(x.x) + p0[0], bfhi(x.x) + p0[1]); o.y = pk2(bflo(x.y) + p0[2], bfhi(x.y) + p0[3]);
            o.z = pk2(bflo(x.z) + p1[0], bfhi(x.z) + p1[1]); o.w = pk2(bflo(x.w) + p1[2], bfhi(x.w) + p1[3]);
        }
        *(v4u*)dst = o;
    }
}

struct BgConv {
    const Job* jb; LAS unsigned char* scr; int it, it_end, stride, lane, period, tick, sub; bool pending; float v[16];
    __device__ __forceinline__ void init(const Job* jb_, int nlayers, int first, int stride_, int lane_, int period_, LAS unsigned char* scr_) { jb = jb_; it = first; it_end = 12288 * nlayers; stride = stride_; lane = lane_; pending = false; period = period_; tick = 0; scr = scr_; sub = 0; }
    __device__ __forceinline__ int decode(const Job*& J, int& b, int& kb, int& nb) const {
        const int li = it / 12288, loc = it - li * 12288;
        if (loc < 8192) { J = jb + 2 * li; b = loc >> 8; const int r = loc & 255; kb = r >> 5; nb = r & 31; return 2; }
        const int i2 = loc - 8192; J = jb + 2 * li + 1; b = i2 >> 7; const int r = i2 & 127; kb = r >> 4; nb = r & 15; return 2; }
    __device__ __forceinline__ void issue() {
        if (it >= it_end) return;
        const Job* J; int b, kb, nb; const int f8 = decode(J, b, kb, nb);
        const float* W = J->src + (size_t)b * J->sbs + (size_t)(f8 == 1 ? 8 * kb + sub : 128 * kb + 16 * sub) * J->ld + 64 * nb + lane;
        const size_t rstep = (size_t)(f8 == 1 ? 64 : 1) * J->ld;
#pragma unroll
        for (int i = 0; i < 16; ++i) v[i] = __builtin_nontemporal_load(W + (size_t)i * rstep);
        pending = true; }
    __device__ __forceinline__ void retire() {
        if (!pending) return;
        const Job* J; int b, kb, nb; const bool f8 = decode(J, b, kb, nb) != 0;
        if (f8) { v4u o; int w;
            w = __builtin_amdgcn_cvt_pk_fp8_f32(v[0] * 64.f, v[1] * 64.f, 0, false); w = __builtin_amdgcn_cvt_pk_fp8_f32(v[2] * 64.f, v[3] * 64.f, w, true); o.x = (unsigned)w;
            w = __builtin_amdgcn_cvt_pk_fp8_f32(v[4] * 64.f, v[5] * 64.f, 0, false); w = __builtin_amdgcn_cvt_pk_fp8_f32(v[6] * 64.f, v[7] * 64.f, w, true); o.y = (unsigned)w;
            w = __builtin_amdgcn_cvt_pk_fp8_f32(v[8] * 64.f, v[9] * 64.f, 0, false); w = __builtin_amdgcn_cvt_pk_fp8_f32(v[10] * 64.f, v[11] * 64.f, w, true); o.z = (unsigned)w;
            w = __builtin_amdgcn_cvt_pk_fp8_f32(v[12] * 64.f, v[13] * 64.f, 0, false); w = __builtin_amdgcn_cvt_pk_fp8_f32(v[14] * 64.f, v[15] * 64.f, w, true); o.w = (unsigned)w;
            *(LAS v4u*)(scr + lane * 144 + sub * 16) = o;
        } else {
#pragma unroll
        for (int q = 0; q < 2; ++q) { v4u o; o.x = pk2(v[8 * q], v[8 * q + 1]); o.y = pk2(v[8 * q + 2], v[8 * q + 3]); o.z = pk2(v[8 * q + 4], v[8 * q + 5]); o.w = pk2(v[8 * q + 6], v[8 * q + 7]);
            *(LAS v4u*)(scr + lane * 144 + (2 * sub + q) * 16) = o; }
        }
        pending = false;
        if (sub < (f8 ? 7 : 3)) { ++sub; return; }
        asm volatile("s_waitcnt lgkmcnt(0)" ::: "memory");
        unsigned char* dstb = (unsigned char*)J->dst + (f8 ? (size_t)b * J->dbs + 128 * kb : ((size_t)b * J->dbs + 64 * kb) * 2);
        const size_t pitch = f8 ? (size_t)J->K : (size_t)J->K * 2;
        const int ln = (int)__builtin_amdgcn_mbcnt_hi(~0u, __builtin_amdgcn_mbcnt_lo(~0u, (unsigned)it)) - it;
#pragma unroll
        for (int s = 0; s < 8; ++s) { const int rl = 8 * s + (ln >> 3), ch = ln & 7;
            const v4u o = *(const LAS v4u*)(scr + rl * 144 + ch * 16);
            __builtin_nontemporal_store(o, (v4u*)(dstb + (size_t)cvt_dst_row(J->mode, 64 * nb + rl) * pitch + ch * 16)); }
        asm volatile("s_waitcnt lgkmcnt(0)" ::: "memory");
        sub = 0; it += stride; }
    __device__ __forceinline__ void begin() { if (++tick < period) return; tick = 0; issue(); }
    __device__ __forceinline__ void end() { if (tick == period - 1) retire(); }
    __device__ __forceinline__ void drain() { for (;;) { retire(); issue(); if (!pending) break; } }
};
struct BgNone { __device__ __forceinline__ void begin() {} __device__ __forceinline__ void end() {} };

#define MFMA32(A, B, C) __builtin_amdgcn_mfma_f32_32x32x16_bf16((A), (B), (C), 0, 0, 0)
#define MFMA16(A, B, C) __builtin_amdgcn_mfma_f32_16x16x32_bf16((A), (B), (C), 0, 0, 0)
__device__ __forceinline__ bf16x8 pack8(float a0, float a1, float a2, float a3, float a4, float a5, float a6, float a7) {
    v4u w; w.x = pk2(a0, a1); w.y = pk2(a2, a3); w.z = pk2(a4, a5); w.w = pk2(a6, a7); return __builtin_bit_cast(bf16x8, w);
}
__device__ __forceinline__ int pi32(int r) { return (r & ~12) | ((r & 4) << 1) | ((r & 8) >> 1); }
__device__ __forceinline__ float max3f(float a, float b, float c) { return __builtin_fmaxf(__builtin_fmaxf(a, b), c); }
__device__ __forceinline__ float max16(const f32x16& p) {
    const float a = max3f(p[0], p[1], p[2]), b = max3f(p[3], p[4], p[5]), c = max3f(p[6], p[7], p[8]), d = max3f(p[9], p[10], p[11]), e = max3f(p[12], p[13], p[14]);
    return max3f(max3f(a, b, c), max3f(d, e, p[15]), d);
}
struct AttnArgs {
    const bf16* Q0; const bf16* Q1; int ldq;
    const bf16* K0; int ldk0; const bf16* K1; int ldk1;
    const bf16* Vt; int ldv;
    bf16* O; int ldo;
    int window;
    const bf16* Qb; const bf16* Kb;
    float lam; const float* gain; float gscale;
    float kbound;
};
template <bool B> struct BoolC { static constexpr bool value = B; };
template <int DQK, int DV, bool PAIR = false, class BG = BgNone>
__device__ __forceinline__ void attn_unit(LAS unsigned char* lds, const AttnArgs& A, int q0, int tid_in, int lane_in, int wave, BG& bg) {
    const int lane = (int)__builtin_amdgcn_mbcnt_hi(~0u, __builtin_amdgcn_mbcnt_lo(~0u, (unsigned)q0)) - q0; const int tid = wave * 64 + lane; (void)tid_in; (void)lane_in;
    constexpr int KSB = (DQK + 8) * 2, VSB = 144, KBUF = 64 * KSB, BUFB = KBUF + DV * VSB;
    constexpr int NKS = DQK / 16, ND0 = DV / 32, KCH = DQK / 8;
    const int r32 = lane & 31, hi = lane >> 5;
    const int qw0 = q0 + 32 * wave, qrow = qw0 + r32;
    const int W = A.window;
    const int t_hi = (q0 >> 6) + 4;
    int t_lo = 0; if (W > 0) { const int lo = q0 - W + 1; t_lo = lo > 0 ? (lo >> 6) : 0; }
    constexpr int OA_OFF = 2 * BUFB, OA_ROWB = DV * 2 + 16;
    const bf16* Qp = A.Q0; const bf16* Kp = A.K0;
    bf16x8 qf[NKS];
    f32x16 o[ND0];
    float lsum = 0.f;
    constexpr int NKI = (64 * KCH + 511) / 512, NVI = DV * 8 / 512;
    v4u kA[NKI], vA[NVI];
    auto gload = [&](int t, v4u (&kreg)[NKI], v4u (&vreg)[NVI]) {
        const __amdgpu_buffer_rsrc_t rk0 = __builtin_amdgcn_make_buffer_rsrc((void*)Kp, 0, 0x7fffffff, 0x00020000);
        const __amdgpu_buffer_rsrc_t rk1 = __builtin_amdgcn_make_buffer_rsrc((void*)(KCH > 8 ? A.K1 : Kp), 0, 0x7fffffff, 0x00020000);
        const __amdgpu_buffer_rsrc_t rvt = __builtin_amdgcn_make_buffer_rsrc((void*)A.Vt, 0, 0x7fffffff, 0x00020000);
        const int k0s = t * 64 * A.ldk0 * 2, k1s = t * 64 * A.ldk1 * 2, vs = t * DV * 128;
#pragma unroll
        for (int i = 0; i < NKI; ++i) { const int c = tid + 512 * i;
            if ((64 * KCH) % 512 == 0 || c < 64 * KCH) { const int row = c / KCH, ch = c - row * KCH;
                if constexpr (KCH > 8) { kreg[i] = (ch < 8) ? __builtin_bit_cast(v4u, __builtin_amdgcn_raw_buffer_load_b128(rk0, (row * A.ldk0 + ch * 8) * 2, k0s, 0))
                                                            : __builtin_bit_cast(v4u, __builtin_amdgcn_raw_buffer_load_b128(rk1, (row * A.ldk1 + (ch - 8) * 8) * 2, k1s, 0)); }
                else kreg[i] = __builtin_bit_cast(v4u, __builtin_amdgcn_raw_buffer_load_b128(rk0, (row * A.ldk0 + ch * 8) * 2, k0s, 0)); } }
#pragma unroll
        for (int i = 0; i < NVI; ++i) { const int c = tid + 512 * i; vreg[i] = __builtin_bit_cast(v4u, __builtin_amdgcn_raw_buffer_load_b128(rvt, c * 16, vs, 0)); }
    };
    auto sstore = [&](int stage, const v4u (&kreg)[NKI], const v4u (&vreg)[NVI]) {
        LAS unsigned char* Kb = lds + stage * BUFB; LAS unsigned char* Vb = Kb + KBUF;
#pragma unroll
        for (int i = 0; i < NKI; ++i) { const int c = tid + 512 * i;
            if ((64 * KCH) % 512 == 0 || c < 64 * KCH) { const int row = c / KCH, ch = c - row * KCH; *(LAS v4u*)(Kb + row * KSB + ch * 16) = kreg[i]; } }
#pragma unroll
        for (int i = 0; i < NVI; ++i) { const int c = tid + 512 * i; const int row = c >> 3, ch = c & 7; *(LAS v4u*)(Vb + row * VSB + ch * 16) = vreg[i]; }
    };
    const int pr = pi32(r32);
    float mhat = 0.f;
    auto compute = [&](int t, int stage, auto ft) {
        constexpr bool FAST = decltype(ft)::value;
        const int kv0 = t * 64;
        const bool skip = (kv0 > qw0 + 31) || (W > 0 && kv0 + 63 <= qw0 - W);
        if (!skip) {
            const LAS unsigned char* Kb = lds + stage * BUFB; const LAS unsigned char* Vb = Kb + KBUF;
            f32x16 p0, p1;
#pragma unroll
            for (int r = 0; r < 16; ++r) { p0[r] = FAST ? 0.f : -mhat; p1[r] = FAST ? 0.f : -mhat; }
            bf16x8 kfr[2 * NKS];
#pragma unroll
            for (int ks = 0; ks < NKS; ++ks) { kfr[2 * ks] = *(const LAS bf16x8*)(Kb + pr * KSB + ks * 32 + hi * 16); kfr[2 * ks + 1] = *(const LAS bf16x8*)(Kb + (32 + pr) * KSB + ks * 32 + hi * 16); }
            asm volatile("s_waitcnt lgkmcnt(0)" ::: "memory");
            bf16x8 vfr[4 * ND0];
#pragma unroll
            for (int d = 0; d < ND0 / 2; ++d)
#pragma unroll
                for (int hf = 0; hf < 2; ++hf)
#pragma unroll
                    for (int jj = 0; jj < 2; ++jj) vfr[4 * d + 2 * hf + jj] = *(const LAS bf16x8*)(Vb + (32 * d + r32) * VSB + (32 * hf + 16 * jj + 8 * hi) * 2);
            __builtin_amdgcn_sched_barrier(0);
#pragma unroll
            for (int ks = 0; ks < NKS; ++ks) { p0 = MFMA32(kfr[2 * ks], qf[ks], p0); p1 = MFMA32(kfr[2 * ks + 1], qf[ks], p1); }
            __builtin_amdgcn_sched_barrier(0);
#pragma unroll
            for (int d = ND0 / 2; d < ND0; ++d)
#pragma unroll
                for (int hf = 0; hf < 2; ++hf)
#pragma unroll
                    for (int jj = 0; jj < 2; ++jj) vfr[4 * d + 2 * hf + jj] = *(const LAS bf16x8*)(Vb + (32 * d + r32) * VSB + (32 * hf + 16 * jj + 8 * hi) * 2);
            __builtin_amdgcn_sched_barrier(0);
            const bool need_mask = (kv0 + 63 > qw0) || (W > 0 && kv0 <= qw0 + 31 - W);
            if (need_mask) {
#pragma unroll
                for (int r = 0; r < 16; ++r) { const int kv = kv0 + 16 * (r >> 3) + 8 * hi + (r & 7);
                    const bool v0 = (kv <= qrow) && (W == 0 || kv > qrow - W), v1 = (kv + 32 <= qrow) && (W == 0 || kv + 32 > qrow - W);
                    p0[r] = v0 ? p0[r] : -INFINITY; p1[r] = v1 ? p1[r] : -INFINITY; }
            }
            if constexpr (!FAST) {
            float mx = fmaxf(max16(p0), max16(p1)); mx = fmaxf(mx, swap32f(mx, hi));
            const bool move = (mx > 8.0f) || (lsum == 0.f && mx != 0.f && mx != -INFINITY);
            if (__any(move)) {
                const float d = move ? mx : 0.f; const float alpha = __builtin_amdgcn_exp2f(-d);
                mhat += d; lsum *= alpha;
#pragma unroll
                for (int r = 0; r < 16; ++r) { p0[r] -= d; p1[r] -= d; }
#pragma unroll
                for (int d0 = 0; d0 < ND0; ++d0)
#pragma unroll
                    for (int r = 0; r < 16; ++r) o[d0][r] *= alpha;
            }
            }
#pragma unroll
            for (int r = 0; r < 16; ++r) { p0[r] = __builtin_amdgcn_exp2f(p0[r]); p1[r] = __builtin_amdgcn_exp2f(p1[r]); }
            lsum += sum32pk(p0, p1);
            bf16x8 pf[2][2];
            pf[0][0] = pack8(p0[0], p0[1], p0[2], p0[3], p0[4], p0[5], p0[6], p0[7]); pf[0][1] = pack8(p0[8], p0[9], p0[10], p0[11], p0[12], p0[13], p0[14], p0[15]);
            pf[1][0] = pack8(p1[0], p1[1], p1[2], p1[3], p1[4], p1[5], p1[6], p1[7]); pf[1][1] = pack8(p1[8], p1[9], p1[10], p1[11], p1[12], p1[13], p1[14], p1[15]);
            asm volatile("s_waitcnt lgkmcnt(0)" ::: "memory");
#pragma unroll
            for (int d = 0; d < ND0; ++d)
#pragma unroll
                for (int hf = 0; hf < 2; ++hf)
#pragma unroll
                    for (int jj = 0; jj < 2; ++jj) o[d] = MFMA32(vfr[4 * d + 2 * hf + jj], pf[hf][jj], o[d]);
        }
    };
    for (int pass = 0; pass < (PAIR ? 2 : 1); ++pass) {
        if (PAIR && pass) { Qp = A.Qb; Kp = A.Kb; }
#pragma unroll
        for (int ks = 0; ks < NKS; ++ks) { if (ks < 4) qf[ks] = *(const bf16x8*)(Qp + (size_t)qrow * A.ldq + ks * 16 + hi * 8); else qf[ks] = *(const bf16x8*)(A.Q1 + (size_t)qrow * A.ldq + (ks - 4) * 16 + hi * 8); }
#pragma unroll
        for (int d = 0; d < ND0; ++d)
#pragma unroll
            for (int r = 0; r < 16; ++r) o[d][r] = 0.f;
        lsum = 0.f; mhat = 0.f;
        gload(t_lo, kA, vA); sstore(0, kA, vA); if (t_lo + 1 < t_hi) gload(t_lo + 1, kA, vA); __syncthreads();
#pragma unroll
        for (int ks = 0; ks < NKS; ++ks) asm volatile("" :: "v"(qf[ks]));
        float q2n = 0.f;
#pragma unroll
        for (int ks = 0; ks < NKS; ++ks) { const v4u w = __builtin_bit_cast(v4u, qf[ks]);
            q2n += (bflo(w.x) * bflo(w.x) + bfhi(w.x) * bfhi(w.x)) + (bflo(w.y) * bflo(w.y) + bfhi(w.y) * bfhi(w.y))
                 + (bflo(w.z) * bflo(w.z) + bfhi(w.z) * bfhi(w.z)) + (bflo(w.w) * bflo(w.w) + bfhi(w.w) * bfhi(w.w)); }
        q2n += swap32f(q2n, hi);
        const bool fast = !__any(!(q2n * A.kbound <= 4096.0f));
        auto run = [&](auto ft) {
        for (int t = t_lo; t < t_hi; ++t) {
            const int buf = (t - t_lo) & 1;
            if (t + 1 < t_hi) sstore(buf ^ 1, kA, vA);
            if (t + 2 < t_hi) gload(t + 2, kA, vA);
            constexpr bool HOST = decltype(ft)::value;
            if constexpr (HOST) bg.begin();
            compute(t, buf, ft);
            if constexpr (HOST) bg.end();
            __syncthreads();
        } };
        if (fast) run(BoolC<true>{}); else run(BoolC<false>{});
        if (PAIR && pass == 0) {
            const float lt0 = lsum + swap32f(lsum, hi); const float inv0 = lt0 > 0.f ? 1.0f / lt0 : 0.f;
            LAS unsigned char* oa = lds + OA_OFF + (32 * wave + r32) * OA_ROWB + 8 * hi;
#pragma unroll
            for (int d = 0; d < ND0; ++d)
#pragma unroll
                for (int g4 = 0; g4 < 4; ++g4) { v2u w; w.x = pk2(o[d][4 * g4] * inv0, o[d][4 * g4 + 1] * inv0); w.y = pk2(o[d][4 * g4 + 2] * inv0, o[d][4 * g4 + 3] * inv0);
                    *(LAS v2u*)(oa + (32 * d + 8 * g4) * 2) = w; }
        }
    }
    const float lt = lsum + swap32f(lsum, hi); const float inv = lt > 0.f ? 1.0f / lt : 0.f;
    const int dep_e = __builtin_amdgcn_readfirstlane(__builtin_bit_cast(int, lt));
    const int lane_e = (int)__builtin_amdgcn_mbcnt_hi(~0u, __builtin_amdgcn_mbcnt_lo(~0u, (unsigned)dep_e)) - dep_e;
    bf16* orow = A.O + (size_t)(qw0 + (lane_e & 31)) * A.ldo - 4 * hi + 4 * (lane_e >> 5);
    if constexpr (PAIR) {
        const LAS unsigned char* oa = lds + OA_OFF + (32 * wave + r32) * OA_ROWB + 8 * hi;
        float ss = 0.f;
#pragma unroll
        for (int d = 0; d < ND0; ++d)
#pragma unroll
            for (int g4 = 0; g4 < 4; ++g4) { const v2u w = *(const LAS v2u*)(oa + (32 * d + 8 * g4) * 2);
                const float d0 = bflo(w.x) - A.lam * (o[d][4 * g4] * inv), d1 = bfhi(w.x) - A.lam * (o[d][4 * g4 + 1] * inv), d2 = bflo(w.y) - A.lam * (o[d][4 * g4 + 2] * inv), d3 = bfhi(w.y) - A.lam * (o[d][4 * g4 + 3] * inv);
                o[d][4 * g4] = d0; o[d][4 * g4 + 1] = d1; o[d][4 * g4 + 2] = d2; o[d][4 * g4 + 3] = d3; ss += (d0 * d0 + d1 * d1) + (d2 * d2 + d3 * d3); }
        ss += swap32f(ss, hi);
        const float rr = A.gscale / sqrtf(ss * (1.0f / DV) + LN_EPS);
#pragma unroll
        for (int d = 0; d < ND0; ++d)
#pragma unroll
            for (int g4 = 0; g4 < 4; ++g4) { const f32x4 gg = *(const f32x4*)(A.gain + 32 * d + 8 * g4 + 4 * hi);
                v2u w; w.x = pk2(o[d][4 * g4] * rr * gg[0], o[d][4 * g4 + 1] * rr * gg[1]); w.y = pk2(o[d][4 * g4 + 2] * rr * gg[2], o[d][4 * g4 + 3] * rr * gg[3]);
                *(v2u*)(orow + 32 * d + 8 * g4 + 4 * hi) = w; }
    } else {
#pragma unroll
    for (int d = 0; d < ND0; ++d)
#pragma unroll
        for (int g4 = 0; g4 < 4; ++g4) { v2u w; w.x = pk2(o[d][4 * g4] * inv, o[d][4 * g4 + 1] * inv); w.y = pk2(o[d][4 * g4 + 2] * inv, o[d][4 * g4 + 3] * inv);
            *(v2u*)(orow + 32 * d + 8 * g4 + 4 * hi) = w; }
    }
}

constexpr int CMP_IMP_B = 64 * 257 * 4, CMP_KB = 64 * 144;
__device__ __forceinline__ float quad_sum(float v) {
    v += __builtin_bit_cast(float, __builtin_amdgcn_update_dpp(0, __builtin_bit_cast(int, v), 0xB1, 0xF, 0xF, true));
    v += __builtin_bit_cast(float, __builtin_amdgcn_update_dpp(0, __builtin_bit_cast(int, v), 0x4E, 0xF, 0xF, true));
    return v;
}
__device__ __forceinline__ void nsa_cmp_unit(LAS unsigned char* lds, const Args& a, int T, int g, int tid_in, int lane_in, int wave, float kbound) {
    const int lane = (int)__builtin_amdgcn_mbcnt_hi(~0u, __builtin_amdgcn_mbcnt_lo(~0u, (unsigned)T)) - T; const int tid = wave * 64 + lane; (void)tid_in; (void)lane_in;
    const bf16* R = WSP(bf16, WS_QK); const bf16* Kc = WSP(bf16, WS_MISC + NSA_KC); const bf16* VcT = WSP(bf16, WS_MISC + NSA_VCT);
    bf16* Oc = WSP(bf16, WS_OH); unsigned* selm = WSP(unsigned, WS_MISC + NSA_SEL);
    const int r32 = lane & 31, hi = lane >> 5, q0 = 64 * T;
    const int ql = 8 * wave + (r32 >> 2), hd = r32 & 3, h = 4 * g + hd, qrow = q0 + ql;
    const int nlim = (qrow >= 31) ? ((qrow - 31) >> 4) : -1;
    const int qw_lo = q0 + 8 * wave, qw_hi = qw_lo + 7;
    const int nlim_lo = (qw_lo >= 31) ? ((qw_lo - 31) >> 4) : -1, nlim_hi = (qw_hi >= 31) ? ((qw_hi - 31) >> 4) : -1;
    const int NT = (((q0 + 32) >> 4) >> 6) + 1;
    LAS float* imp = (LAS float*)lds;
    LAS unsigned char* kb0 = lds + CMP_IMP_B; LAS unsigned char* vb0 = kb0 + 2 * CMP_KB;
    for (int i = tid; i < 64 * 257; i += NTHREADS) imp[i] = 0.f;
    bf16x8 qf[4];
#pragma unroll
    for (int ks = 0; ks < 4; ++ks) qf[ks] = *(const bf16x8*)(R + (size_t)qrow * 1024 + 64 * h + ks * 16 + hi * 8);
    const int pr = pi32(r32);
    const int lrow = tid >> 3, lch = tid & 7;
    const bf16* Ksrc = Kc + (size_t)(g * 1024) * 64 + tid * 8;
    const bf16* Vsrc = VcT + (size_t)lrow * 4096 + g * 1024 + lch * 8;
    const int soff = lrow * 144 + lch * 16;
    v4u kreg, vreg;
    float mhat = 0.f, lsum = 0.f;
    auto qk = [&](const LAS unsigned char* Kb, int n0, f32x16& p0, f32x16& p1, auto ft) {
        constexpr bool FAST = decltype(ft)::value;
#pragma unroll
        for (int r = 0; r < 16; ++r) { p0[r] = FAST ? 0.f : -mhat; p1[r] = FAST ? 0.f : -mhat; }
        bf16x8 kfr[8];
#pragma unroll
        for (int ks = 0; ks < 4; ++ks) { kfr[2 * ks] = *(const LAS bf16x8*)(Kb + pr * 144 + ks * 32 + hi * 16); kfr[2 * ks + 1] = *(const LAS bf16x8*)(Kb + (32 + pr) * 144 + ks * 32 + hi * 16); }
        asm volatile("s_waitcnt lgkmcnt(0)" ::: "memory");
        __builtin_amdgcn_sched_barrier(0);
#pragma unroll
        for (int ks = 0; ks < 4; ++ks) { p0 = MFMA32(kfr[2 * ks], qf[ks], p0); p1 = MFMA32(kfr[2 * ks + 1], qf[ks], p1); }
        if (n0 + 63 > nlim_lo) {
#pragma unroll
            for (int r = 0; r < 16; ++r) { const int n = n0 + 16 * (r >> 3) + 8 * hi + (r & 7); p0[r] = (n <= nlim) ? p0[r] : -INFINITY; p1[r] = (n + 32 <= nlim) ? p1[r] : -INFINITY; }
        }
    };
    kreg = *(const v4u*)Ksrc; *(LAS v4u*)(kb0 + soff) = kreg; if (1 < NT) kreg = *(const v4u*)(Ksrc + 4096); __syncthreads();
#pragma unroll
    for (int ks = 0; ks < 4; ++ks) asm volatile("" :: "v"(qf[ks]));
    float q2n = 0.f;
#pragma unroll
    for (int ks = 0; ks < 4; ++ks) { const v4u w = __builtin_bit_cast(v4u, qf[ks]);
        q2n += (bflo(w.x) * bflo(w.x) + bfhi(w.x) * bfhi(w.x)) + (bflo(w.y) * bflo(w.y) + bfhi(w.y) * bfhi(w.y))
             + (bflo(w.z) * bflo(w.z) + bfhi(w.z) * bfhi(w.z)) + (bflo(w.w) * bflo(w.w) + bfhi(w.w) * bfhi(w.w)); }
    q2n += swap32f(q2n, hi);
    const bool fast = !__any(!(q2n * kbound <= 4096.0f));
    auto pass1 = [&](auto ft) {
    constexpr bool FAST = decltype(ft)::value;
    for (int t = 0; t < NT; ++t) {
        const int buf = t & 1, n0 = 64 * t;
        if (t + 1 < NT) *(LAS v4u*)(kb0 + (buf ^ 1) * CMP_KB + soff) = kreg;
        if (t + 2 < NT) kreg = *(const v4u*)(Ksrc + (size_t)(t + 2) * 4096);
        if (n0 <= nlim_hi) {
            f32x16 p0, p1; qk(kb0 + buf * CMP_KB, n0, p0, p1, ft);
            if constexpr (!FAST) {
            float mx = fmaxf(max16(p0), max16(p1)); mx = fmaxf(mx, swap32f(mx, hi));
            const bool move = (mx > 8.0f) || (lsum == 0.f && mx != 0.f && mx != -INFINITY);
            if (__any(move)) { const float d = move ? mx : 0.f; mhat += d; lsum *= __builtin_amdgcn_exp2f(-d);
#pragma unroll
                for (int r = 0; r < 16; ++r) { p0[r] -= d; p1[r] -= d; } }
            }
#pragma unroll
            for (int r = 0; r < 16; ++r) { p0[r] = __builtin_amdgcn_exp2f(p0[r]); p1[r] = __builtin_amdgcn_exp2f(p1[r]); }
            lsum += sum32pk(p0, p1);
        }
        __syncthreads();
    } };
    if (fast) pass1(BoolC<true>{}); else pass1(BoolC<false>{});
    const float lt = lsum + swap32f(lsum, hi); const float inv = lt > 0.f ? 1.0f / lt : 0.f;
    f32x16 o[2];
#pragma unroll
    for (int d = 0; d < 2; ++d)
#pragma unroll
        for (int r = 0; r < 16; ++r) o[d][r] = 0.f;
    kreg = *(const v4u*)Ksrc; vreg = *(const v4u*)Vsrc;
    *(LAS v4u*)(kb0 + soff) = kreg; *(LAS v4u*)(vb0 + soff) = vreg;
    if (1 < NT) { kreg = *(const v4u*)(Ksrc + 4096); vreg = *(const v4u*)(Vsrc + 64); }
    __syncthreads();
    LAS float* irow = imp + ql * 257 + 4 * hd + 2 * hi;
    for (int t = 0; t < NT; ++t) {
        const int buf = t & 1, n0 = 64 * t;
        if (t + 1 < NT) { *(LAS v4u*)(kb0 + (buf ^ 1) * CMP_KB + soff) = kreg; *(LAS v4u*)(vb0 + (buf ^ 1) * CMP_KB + soff) = vreg; }
        if (t + 2 < NT) { kreg = *(const v4u*)(Ksrc + (size_t)(t + 2) * 4096); vreg = *(const v4u*)(Vsrc + 64 * (t + 2)); }
        if (n0 <= nlim_hi) {
            const LAS unsigned char* Vb = vb0 + buf * CMP_KB;
            f32x16 p0, p1; qk(kb0 + buf * CMP_KB, n0, p0, p1, BoolC<false>{});
            bf16x8 vfr[8];
#pragma unroll
            for (int d = 0; d < 2; ++d)
#pragma unroll
                for (int q = 0; q < 4; ++q) vfr[4 * d + q] = *(const LAS bf16x8*)(Vb + (32 * d + r32) * 144 + (16 * q + 8 * hi) * 2);
#pragma unroll
            for (int r = 0; r < 16; ++r) { p0[r] = __builtin_amdgcn_exp2f(p0[r]) * inv; p1[r] = __builtin_amdgcn_exp2f(p1[r]) * inv; }
            float s0[4], s1[4], s2[4];
#pragma unroll
            for (int gq = 0; gq < 4; ++gq) { const f32x16& p = (gq >> 1) ? p1 : p0; const int b8 = 8 * (gq & 1);
                s0[gq] = quad_sum(2.f * (p[b8] + p[b8 + 1] + p[b8 + 2]) + p[b8 + 3]);
                s1[gq] = quad_sum(p[b8 + 3] + 2.f * (p[b8 + 4] + p[b8 + 5] + p[b8 + 6]) + p[b8 + 7]);
                s2[gq] = quad_sum(p[b8 + 7]); }
            const float a0 = hd == 0 ? s0[0] : hd == 1 ? s0[1] : hd == 2 ? s0[2] : s0[3];
            const float a1 = hd == 0 ? s1[0] : hd == 1 ? s1[1] : hd == 2 ? s1[2] : s1[3];
            const float a2 = hd == 0 ? s2[0] : hd == 1 ? s2[1] : hd == 2 ? s2[2] : s2[3];
            LAS float* ip = irow + (n0 >> 2);
            { const float x0 = ip[0], x1 = ip[1]; ip[0] = x0 + a0; ip[1] = x1 + a1; }
            asm volatile("s_waitcnt lgkmcnt(0)" ::: "memory");
            { const float x2 = ip[2]; ip[2] = x2 + a2; }
            bf16x8 pf[4];
            pf[0] = pack8(p0[0], p0[1], p0[2], p0[3], p0[4], p0[5], p0[6], p0[7]); pf[1] = pack8(p0[8], p0[9], p0[10], p0[11], p0[12], p0[13], p0[14], p0[15]);
            pf[2] = pack8(p1[0], p1[1], p1[2], p1[3], p1[4], p1[5], p1[6], p1[7]); pf[3] = pack8(p1[8], p1[9], p1[10], p1[11], p1[12], p1[13], p1[14], p1[15]);
            asm volatile("s_waitcnt lgkmcnt(0)" ::: "memory");
#pragma unroll
            for (int d = 0; d < 2; ++d)
#pragma unroll
                for (int q = 0; q < 4; ++q) o[d] = MFMA32(vfr[4 * d + q], pf[q], o[d]);
        }
        __syncthreads();
    }
    { bf16* orow = Oc + (size_t)qrow * 1024 + 64 * h;
#pragma unroll
      for (int d = 0; d < 2; ++d)
#pragma unroll
          for (int g4 = 0; g4 < 4; ++g4) { v2u w; w.x = pk2(o[d][4 * g4], o[d][4 * g4 + 1]); w.y = pk2(o[d][4 * g4 + 2], o[d][4 * g4 + 3]); *(v2u*)(orow + 32 * d + 8 * g4 + 4 * hi) = w; } }
    for (int i = 0; i < 8; ++i) {
        const int qq = 8 * wave + i;
        unsigned kb[4]; bool selb[4], cand[4];
#pragma unroll
        for (int s = 0; s < 4; ++s) { const int j = lane + 64 * s; selb[s] = (j <= T) && (T <= 15 || j == 0 || j >= T - 1);
            cand[s] = (T > 15) && (j >= 1) && (j <= T - 2);
            kb[s] = cand[s] ? __float_as_uint(imp[qq * 257 + j]) : 0u; }
        if (T > 15) {
            unsigned prefix = 0u;
            for (int b = 30; b >= 0; --b) { const unsigned t = prefix | (1u << b);
                const int cnt = __popcll(__ballot(cand[0] && kb[0] >= t)) + __popcll(__ballot(cand[1] && kb[1] >= t)) + __popcll(__ballot(cand[2] && kb[2] >= t)) + __popcll(__ballot(cand[3] && kb[3] >= t));
                if (cnt >= 13) prefix = t; }
            const int ngt = __popcll(__ballot(cand[0] && kb[0] > prefix)) + __popcll(__ballot(cand[1] && kb[1] > prefix)) + __popcll(__ballot(cand[2] && kb[2] > prefix)) + __popcll(__ballot(cand[3] && kb[3] > prefix));
            const int need = 13 - ngt; int running = 0;
#pragma unroll
            for (int s = 0; s < 4; ++s) { const bool eq = cand[s] && kb[s] == prefix; const unsigned long long mk = __ballot(eq);
                const int rank = running + (int)__builtin_amdgcn_mbcnt_hi((unsigned)(mk >> 32), __builtin_amdgcn_mbcnt_lo((unsigned)mk, 0u));
                if (cand[s] && (kb[s] > prefix || (eq && rank < need))) selb[s] = true;
                running += __popcll(mk); }
        }
        const unsigned long long m0 = __ballot(selb[0]), m1 = __ballot(selb[1]), m2 = __ballot(selb[2]), m3 = __ballot(selb[3]);
        if (lane == 0) { unsigned* dst = selm + ((size_t)(q0 + qq) * 4 + g) * 8;
            *(v4u*)dst = (v4u){(unsigned)m0, (unsigned)(m0 >> 32), (unsigned)m1, (unsigned)(m1 >> 32)};
            *(v4u*)(dst + 4) = (v4u){(unsigned)m2, (unsigned)(m2 >> 32), (unsigned)m3, (unsigned)(m3 >> 32)}; }
    }
    __syncthreads();
}

__device__ __forceinline__ void nsa_sel_unit(LAS unsigned char* lds, const Args& a, int T, int g, int tid_in, int lane_in, int wave, float kbound) {
    const int lane = (int)__builtin_amdgcn_mbcnt_hi(~0u, __builtin_amdgcn_mbcnt_lo(~0u, (unsigned)T)) - T; const int tid = wave * 64 + lane; (void)tid_in; (void)lane_in;
    const bf16* R = WSP(bf16, WS_QK); const bf16* VT = WSP(bf16, WS_VT); const bf16* P = WSP(bf16, WS_MISC + NSA_P);
    const bf16* Oc = WSP(bf16, WS_OH); const bf16* Ow = WSP(bf16, WS_OH + 32 * MiB); bf16* Ao = WSP(bf16, WS_AO);
    const unsigned* selm = WSP(unsigned, WS_MISC + NSA_SEL);
    constexpr int KSB = 144, VSB = 144, KBUF = 64 * KSB, BUFB = 2 * KBUF;
    const int r32 = lane & 31, hi = lane >> 5, q0 = 64 * T;
    const int ql = 8 * wave + (r32 >> 2), hd = r32 & 3, h = 4 * g + hd, qrow = q0 + ql;
    bf16x8 qf[4];
#pragma unroll
    for (int ks = 0; ks < 4; ++ks) qf[ks] = *(const bf16x8*)(R + (size_t)qrow * 1024 + 64 * h + ks * 16 + hi * 8);
    const unsigned* selp = selm + ((size_t)qrow * 4 + g) * 8; unsigned selw = 0u;
    const v4u sm0 = *(const v4u*)selp, sm1 = *(const v4u*)(selp + 4);
    f32x16 o[2];
#pragma unroll
    for (int d = 0; d < 2; ++d)
#pragma unroll
        for (int r = 0; r < 16; ++r) o[d][r] = 0.f;
    float lsum = 0.f, mhat = 0.f;
    const int lrow = tid >> 3, lch = tid & 7, soff = lrow * 144 + lch * 16;
    const bf16* Ksrc = WSP(bf16, WS_KH) + (size_t)g * S * 64 + tid * 8; const bf16* Vsrc = VT + (size_t)g * S * 64 + tid * 8;
    v4u kA, vA, kB, vB, kC, vC;
    const int NP = T / 3 + 1;
    kA = *(const v4u*)Ksrc; vA = *(const v4u*)Vsrc;
    *(LAS v4u*)(lds + soff) = kA; *(LAS v4u*)(lds + KBUF + soff) = vA;
    if (1 <= T) { kB = *(const v4u*)(Ksrc + 4096); vB = *(const v4u*)(Vsrc + 4096); *(LAS v4u*)(lds + BUFB + soff) = kB; *(LAS v4u*)(lds + BUFB + KBUF + soff) = vB; }
    if (2 <= T) { kC = *(const v4u*)(Ksrc + 2 * 4096); vC = *(const v4u*)(Vsrc + 2 * 4096); *(LAS v4u*)(lds + 2 * BUFB + soff) = kC; *(LAS v4u*)(lds + 2 * BUFB + KBUF + soff) = vC; }
    if (3 <= T) { kA = *(const v4u*)(Ksrc + 3 * 4096); vA = *(const v4u*)(Vsrc + 3 * 4096); }
    if (4 <= T) { kB = *(const v4u*)(Ksrc + 4 * 4096); vB = *(const v4u*)(Vsrc + 4 * 4096); }
    if (5 <= T) { kC = *(const v4u*)(Ksrc + 5 * 4096); vC = *(const v4u*)(Vsrc + 5 * 4096); }
    __syncthreads();
#pragma unroll
    for (int ks = 0; ks < 4; ++ks) asm volatile("" :: "v"(qf[ks]));
    LAS unsigned* smk = (LAS unsigned*)(lds + 6 * BUFB) + tid * 8;
    *(LAS v4u*)smk = sm0; *(LAS v4u*)(smk + 4) = sm1;
    const int pr = pi32(r32);
    auto compute = [&](int j, int boff, auto ft) {
        constexpr bool FAST = decltype(ft)::value;
        if ((j & 31) == 0) selw = smk[j >> 5];
        const bool mine = (selw >> (j & 31)) & 1u;
        if (__any(mine)) {
            const LAS unsigned char* Kb = lds + boff; const LAS unsigned char* Vb = Kb + KBUF;
            f32x16 p0, p1;
            { const float init = mine ? (FAST ? 0.f : -mhat) : -INFINITY;
#pragma unroll
              for (int r = 0; r < 16; ++r) { p0[r] = init; p1[r] = init; } }
            bf16x8 kfr[8];
#pragma unroll
            for (int ks = 0; ks < 4; ++ks) { kfr[2 * ks] = *(const LAS bf16x8*)(Kb + pr * KSB + ks * 32 + hi * 16); kfr[2 * ks + 1] = *(const LAS bf16x8*)(Kb + (32 + pr) * KSB + ks * 32 + hi * 16); }
            asm volatile("s_waitcnt lgkmcnt(0)" ::: "memory");
            bf16x8 vfr[8];
#pragma unroll
            for (int d = 0; d < 2; ++d)
#pragma unroll
                for (int hf = 0; hf < 2; ++hf)
#pragma unroll
                    for (int jj = 0; jj < 2; ++jj) vfr[4 * d + 2 * hf + jj] = *(const LAS bf16x8*)(Vb + (32 * d + r32) * VSB + (32 * hf + 16 * jj + 8 * hi) * 2);
            __builtin_amdgcn_sched_barrier(0);
#pragma unroll
            for (int ks = 0; ks < 4; ++ks) { p0 = MFMA32(kfr[2 * ks], qf[ks], p0); p1 = MFMA32(kfr[2 * ks + 1], qf[ks], p1); }
            if (j == T) {
#pragma unroll
                for (int r = 0; r < 16; ++r) { const int kvl = 16 * (r >> 3) + 8 * hi + (r & 7);
                    p0[r] = (kvl <= ql) ? p0[r] : -INFINITY; p1[r] = (kvl + 32 <= ql) ? p1[r] : -INFINITY; }
            }
            if constexpr (!FAST) {
            float mx = fmaxf(max16(p0), max16(p1)); mx = fmaxf(mx, swap32f(mx, hi));
            const bool move = (mx > 8.0f) || (lsum == 0.f && mx != 0.f && mx != -INFINITY);
            if (__any(move)) {
                const float d = move ? mx : 0.f; const float alpha = __builtin_amdgcn_exp2f(-d);
                mhat += d; lsum *= alpha;
#pragma unroll
                for (int r = 0; r < 16; ++r) { p0[r] -= d; p1[r] -= d; }
#pragma unroll
                for (int d0 = 0; d0 < 2; ++d0)
#pragma unroll
                    for (int r = 0; r < 16; ++r) o[d0][r] *= alpha;
            }
            }
#pragma unroll
            for (int r = 0; r < 16; ++r) { p0[r] = __builtin_amdgcn_exp2f(p0[r]); p1[r] = __builtin_amdgcn_exp2f(p1[r]); }
            lsum += sum32pk(p0, p1);
            bf16x8 pf[2][2];
            pf[0][0] = pack8(p0[0], p0[1], p0[2], p0[3], p0[4], p0[5], p0[6], p0[7]); pf[0][1] = pack8(p0[8], p0[9], p0[10], p0[11], p0[12], p0[13], p0[14], p0[15]);
            pf[1][0] = pack8(p1[0], p1[1], p1[2], p1[3], p1[4], p1[5], p1[6], p1[7]); pf[1][1] = pack8(p1[8], p1[9], p1[10], p1[11], p1[12], p1[13], p1[14], p1[15]);
            asm volatile("s_waitcnt lgkmcnt(0)" ::: "memory");
#pragma unroll
            for (int d = 0; d < 2; ++d)
#pragma unroll
                for (int hf = 0; hf < 2; ++hf)
#pragma unroll
                    for (int jj = 0; jj < 2; ++jj) o[d] = MFMA32(vfr[4 * d + 2 * hf + jj], pf[hf][jj], o[d]);
        }
    };
    float q2n = 0.f;
#pragma unroll
    for (int ks = 0; ks < 4; ++ks) { const v4u w = __builtin_bit_cast(v4u, qf[ks]);
        q2n += (bflo(w.x) * bflo(w.x) + bfhi(w.x) * bfhi(w.x)) + (bflo(w.y) * bflo(w.y) + bfhi(w.y) * bfhi(w.y))
             + (bflo(w.z) * bflo(w.z) + bfhi(w.z) * bfhi(w.z)) + (bflo(w.w) * bflo(w.w) + bfhi(w.w) * bfhi(w.w)); }
    q2n += swap32f(q2n, hi);
    const bool fast = !__any(!(q2n * kbound <= 4096.0f));
    auto run = [&](auto ft) {
    for (int jp = 0; jp < NP; ++jp) {
        const int so = (jp & 1) * (3 * BUFB), sn = 3 * BUFB - so;
        const int j0 = 3 * jp;
        if (j0 + 3 <= T) { *(LAS v4u*)(lds + sn + soff) = kA; *(LAS v4u*)(lds + sn + KBUF + soff) = vA; }
        if (j0 + 4 <= T) { *(LAS v4u*)(lds + sn + BUFB + soff) = kB; *(LAS v4u*)(lds + sn + BUFB + KBUF + soff) = vB; }
        if (j0 + 5 <= T) { *(LAS v4u*)(lds + sn + 2 * BUFB + soff) = kC; *(LAS v4u*)(lds + sn + 2 * BUFB + KBUF + soff) = vC; }
        if (j0 + 6 <= T) { kA = *(const v4u*)(Ksrc + (size_t)(j0 + 6) * 4096); vA = *(const v4u*)(Vsrc + (size_t)(j0 + 6) * 4096); }
        if (j0 + 7 <= T) { kB = *(const v4u*)(Ksrc + (size_t)(j0 + 7) * 4096); vB = *(const v4u*)(Vsrc + (size_t)(j0 + 7) * 4096); }
        if (j0 + 8 <= T) { kC = *(const v4u*)(Ksrc + (size_t)(j0 + 8) * 4096); vC = *(const v4u*)(Vsrc + (size_t)(j0 + 8) * 4096); }
        compute(j0, so, ft);
        if (j0 + 1 <= T) compute(j0 + 1, so + BUFB, ft);
        if (j0 + 2 <= T) compute(j0 + 2, so + 2 * BUFB, ft);
        __syncthreads();
    } };
    if (fast) run(BoolC<true>{}); else run(BoolC<false>{});
    { const float lt = lsum + swap32f(lsum, hi); const float inv = lt > 0.f ? 1.0f / lt : 0.f;
      const size_t rb = (size_t)qrow * 1024 + 64 * h;
      const bf16* gp = P + (size_t)qrow * 768 + 512 + 3 * h;
      const float g0 = 1.0f / (1.0f + __expf(-bf2f(gp[0]))), g1 = inv / (1.0f + __expf(-bf2f(gp[1]))), g2 = 1.0f / (1.0f + __expf(-bf2f(gp[2])));
#pragma unroll
      for (int d = 0; d < 2; ++d)
#pragma unroll
          for (int g4 = 0; g4 < 4; ++g4) { const int dv = 32 * d + 8 * g4 + 4 * hi;
              const v2u wc = *(const v2u*)(Oc + rb + dv), ww = *(const v2u*)(Ow + rb + dv);
              v2u w; w.x = pk2(g0 * bflo(wc.x) + g1 * o[d][4 * g4] + g2 * bflo(ww.x), g0 * bfhi(wc.x) + g1 * o[d][4 * g4 + 1] + g2 * bfhi(ww.x));
              w.y = pk2(g0 * bflo(wc.y) + g1 * o[d][4 * g4 + 2] + g2 * bflo(ww.y), g0 * bfhi(wc.y) + g1 * o[d][4 * g4 + 3] + g2 * bfhi(ww.y));
              *(v2u*)(Ao + rb + dv) = w; } }
}
#ifndef REP
#define REP 0
#endif
#define REPN(bit) (((REP >> (bit)) & 1) ? 2 : 1)
struct Ctx { LAS unsigned char* lds; LAS unsigned* lc; int wave, G, cb; XcdBarrier bar; int ph; };
#define RUN (c.ph >= a.ph_lo && c.ph < a.ph_hi)
#define LANE_ID(K) ((int)__builtin_amdgcn_mbcnt_hi(~0u, __builtin_amdgcn_mbcnt_lo(~0u, (unsigned)(K))) - (K))
#define IDS_(K) const int wave = c.wave; const int lane = LANE_ID(K); const int tid = wave * 64 + lane; (void)lane; (void)tid
#define IDS_T const int tid = threadIdx.x, lane = tid & 63, wave = c.wave; (void)lane; (void)tid
#define IDS_M IDS_(c.ph + 1)
#ifndef MSEL
#define MSEL 31
#endif
#if (MSEL >> 0) & 1
#define IDS0 IDS_M
#else
#define IDS0 IDS_T
#endif
#if (MSEL >> 1) & 1
#define IDS1 IDS_M
#else
#define IDS1 IDS_T
#endif
#if (MSEL >> 2) & 1
#define IDS2 IDS_M
#else
#define IDS2 IDS_T
#endif
#if (MSEL >> 3) & 1
#define IDS3 IDS_M
#else
#define IDS3 IDS_T
#endif
#if (MSEL >> 4) & 1
#define IDS4 IDS_M
#else
#define IDS4 IDS_T
#endif

#define SEAM() do { if (RUN && c.ph + 1 < a.ph_hi) xcd_barrier(c.bar, c.wave * 64 + LANE_ID(c.ph + 77)); ++c.ph; } while (0)
#define CTX_LOCALS LAS unsigned char* lds = c.lds; LAS unsigned* lc = c.lc; const int G = c.G, cb = c.cb; (void)lc; (void)lds; (void)G; (void)cb; \
    const float QS64 = 0.125f * LOG2E, QS96 = 0.10206207261596575f * LOG2E; (void)QS64; (void)QS96; \
    const cs_t* cs64 = WSP(cs_t, WS_CS64); const cs_t* cs32 = WSP(cs_t, WS_CS32); (void)cs64; (void)cs32; \
    bf16* XB = WSP(bf16, WS_XB); bf16* AO = WSP(bf16, WS_AO); bf16* QK = WSP(bf16, WS_QK); bf16* VT = WSP(bf16, WS_VT); bf16* OH = WSP(bf16, WS_OH); bf16* KH = WSP(bf16, WS_KH); (void)KH; bf16* Y16 = WSP(bf16, WS_Y); \
    (void)XB; (void)AO; (void)QK; (void)VT; (void)OH; (void)Y16; unsigned* AMX = WSP(unsigned, WS_CTL) + CW_KMAX; (void)AMX;

template <int LAYER> __device__ __forceinline__ void da_layer(const Args& a, Ctx& c) {
    CTX_LOCALS
    constexpr int j = LAYER / 3; const float lam_init = 0.8f - 0.6f * __expf(-0.3f * (float)LAYER);
    bf16* Wb = WSP(bf16, WS_WDA + (size_t)j * 8 * MiB);
    if (RUN) { IDS0;
        { pg8::Gemm g{XB, Wb, S, 2048, 1024}; pg8::StaticOrder So; So.init(S, 2048, G, cb);
          pg8::EpiRope64 E{QK, 1024, cs64, 32, 4, QS64, 0x7fffffff, 1, 0, 16, KH, S, AMX + (j ? 4 : 0)};
          pg8::gemm_phase<pg8::EpiRope64, pg8::StaticOrder, true, true, 1001>(lds, g, So, E, wave, c.ph + 1000); }
        { pg8::Gemm g{Wb + 2048 * 1024, XB, 1024, S, 1024}; pg8::StaticOrder So; So.init(1024, S, G, cb);
          pg8::EpiVtTiled E{VT, 7, S};
          pg8::gemm_phase<pg8::EpiVtTiled, pg8::StaticOrder, true, true, 1002>(lds, g, So, E, wave, c.ph + 1000); }
    }
    SEAM();
    if (RUN) { IDS0;
        const float lam = da_lambda(a, j, lam_init, lane);
        const float kbound = 2.04f * __builtin_bit_cast(float, xb_ld(AMX + (j ? 4 : 0)));
        const int hp = cb & 7, aa = cb >> 3;
        for (int i_ = 0; i_ < 2 * REPN(1); ++i_) { const int i = i_ & 1; const int qt = (i == 0) ? 63 - aa : aa;
            AttnArgs A; A.Q0 = QK + 64 * (2 * hp); A.Q1 = nullptr; A.ldq = 1024; A.K0 = KH + (size_t)(2 * hp) * S * 64; A.ldk0 = 64; A.K1 = nullptr; A.ldk1 = 0;
            A.Qb = QK + 64 * (2 * hp + 1); A.Kb = KH + (size_t)(2 * hp + 1) * S * 64; A.lam = lam; A.gain = a.in[I_DA_SUBLN] + j * 128; A.gscale = 1.0f - lam_init;
            A.Vt = VT + (size_t)(128 * hp) * S; A.ldv = S; A.O = AO + 128 * hp; A.ldo = 1024; A.window = 0; A.kbound = kbound;
            { BgNone nb_; attn_unit<64, 128, true>(lds, A, qt * 256, tid, lane, wave, nb_); } }
    }
    SEAM();
    if (RUN) { IDS0; pg8::Gemm g{AO, Wb + 3072 * 1024, S, 1024, 1024}; pg8::StaticOrder So; So.init(S, 1024, G, cb); pg8::EpiBf16P E{Y16, 1024, 1.0f};
        pg8::gemm_phase<pg8::EpiBf16P, pg8::StaticOrder, true, true, 1003>(lds, g, So, E, wave, c.ph + 1000); }
    SEAM();
}
__device__ __forceinline__ void mla_layer(const Args& a, Ctx& c) {
    CTX_LOCALS
    bf16* Wb = WSP(bf16, WS_WMLA);
    float* C = WSP(float, WS_MISC + MLA_C); bf16* cqn = WSP(bf16, WS_MISC + MLA_CQN); bf16* ckvn = WSP(bf16, WS_MISC + MLA_CKVN); bf16* Kr = WSP(bf16, WS_MISC + MLA_KR);
    if (RUN) { IDS1; pg8::Gemm g{XB, Wb, S, 512, 1024}; pg8::StaticOrder So; So.init(S, 512, G, cb); pg8::EpiF32 E{C, 512, AMX + 1};
        pg8::gemm_phase<pg8::EpiF32, pg8::StaticOrder, true, true, 1004>(lds, g, So, E, wave, c.ph + 1000); }
    SEAM();
    if (RUN) { IDS1; phase_mla_norm(a, tid, lane, wave); }
    SEAM();
    if (RUN) { IDS1;
        { pg8::Gemm g{cqn, Wb + 1 * MiB / 2, S, 1024, 256}; pg8::StaticOrder So; So.init(S, 1024, G, cb);
          pg8::EpiBf16P E{QK, 1536, QS96};
          pg8::gemm_phase<pg8::EpiBf16P, pg8::StaticOrder, true, true, 1901>(lds, g, So, E, wave, c.ph + 1000); }
        { pg8::Gemm g{cqn, Wb + 1 * MiB / 2 + 1024 * 256, S, 512, 256}; pg8::StaticOrder So; So.init(S, 512, G, (cb + 128) & 255);
          pg8::EpiRope16 E{QK + 1024, 1536, cs32, QS96};
          pg8::gemm_phase<pg8::EpiRope16, pg8::StaticOrder, true, true, 1902>(lds, g, So, E, wave, c.ph + 1000); }
        { pg8::Gemm g{ckvn, Wb + 2 * MiB / 2, S, 1024, 128}; pg8::StaticOrder So; So.init(S, 1024, G, cb);
          pg8::EpiHeadMajor64 E{KH, S, AMX + 1};
          pg8::gemm_phase<pg8::EpiHeadMajor64, pg8::StaticOrder, true, true, 1006>(lds, g, So, E, wave, c.ph + 1000); }
        { pg8::Gemm g{Wb + 2 * MiB / 2 + 1024 * 128, ckvn, 1024, S, 128}; pg8::StaticOrder So; So.init(1024, S, G, (cb + 128) & 255);
          pg8::EpiVtTiled E{VT, 6, S};
          pg8::gemm_phase<pg8::EpiVtTiled, pg8::StaticOrder, true, true, 1007>(lds, g, So, E, wave, c.ph + 1000); }
    }
    SEAM();
    if (RUN) { IDS1;
        const int hh = cb & 15, aa = cb >> 4;
        const float kbound = 3.06f * __builtin_bit_cast(float, xb_ld(AMX + 1));
        BgConv bg; bg.init(&a.jobs[18], 3, cb * NWAVES + wave, G * NWAVES, lane, 3, lds + 49152 + wave * 9216);
        for (int i_ = 0; i_ < 4 * REPN(2); ++i_) { const int i = i_ & 3; const int qt = (i == 0) ? 63 - aa : (i == 1) ? aa : (i == 2) ? 47 - aa : 16 + aa;
            AttnArgs A; A.Q0 = QK + 64 * hh; A.Q1 = QK + 1024 + 32 * hh; A.ldq = 1536; A.K0 = KH + (size_t)hh * S * 64; A.ldk0 = 64; A.K1 = Kr; A.ldk1 = 32;
            A.Vt = VT + (size_t)(64 * hh) * S; A.ldv = S; A.O = AO + 64 * hh; A.ldo = 1024; A.window = 0; A.Qb = nullptr; A.Kb = nullptr; A.lam = 0.f; A.gain = nullptr; A.gscale = 0.f; A.kbound = kbound;
            attn_unit<96, 64, false, BgConv>(lds, A, qt * 256, tid, lane, wave, bg); }
        bg.drain();
    }
    SEAM();
    if (RUN) { IDS1; pg8::Gemm g{AO, Wb + 3 * MiB / 2, S, 1024, 1024}; pg8::StaticOrder So; So.init(S, 1024, G, cb); pg8::EpiBf16P E{Y16, 1024, 1.0f};
        pg8::gemm_phase<pg8::EpiBf16P, pg8::StaticOrder, true, true, 1008>(lds, g, So, E, wave, c.ph + 1000); }
    SEAM();
}
__device__ __forceinline__ void nsa_layer(const Args& a, Ctx& c) {
    CTX_LOCALS
    bf16* Wb = WSP(bf16, WS_WNSA);
    bf16* P = WSP(bf16, WS_MISC + NSA_P); bf16* ACK = WSP(bf16, WS_MISC + NSA_ACK); bf16* ACV = WSP(bf16, WS_MISC + NSA_ACV);
    bf16* HK = WSP(bf16, WS_MISC + NSA_HK); bf16* HV = WSP(bf16, WS_MISC + NSA_HV); bf16* KC = WSP(bf16, WS_MISC + NSA_KC); bf16* VCT = WSP(bf16, WS_MISC + NSA_VCT);
    if (RUN) { IDS2;
        { pg8::Gemm g{XB, Wb, S, 1536, 1024}; pg8::StaticOrder So; So.init(S, 1536, G, cb);
          pg8::EpiRope64 E{QK, 1024, cs64, 24, 4, QS64, 0x7fffffff, 1, 0, 16, KH, S, AMX + 2};
          pg8::gemm_phase<pg8::EpiRope64, pg8::StaticOrder, true, true, 1009>(lds, g, So, E, wave, c.ph + 1000); }
        { pg8::Gemm g{XB, Wb + 1536 * 1024, S, 768, 1024}; pg8::StaticOrder So; So.init(S, 768, G, (cb + 128) & 255);
          pg8::EpiBf16P E{P, 768, 1.0f};
          pg8::gemm_phase<pg8::EpiBf16P, pg8::StaticOrder, true, true, 1010>(lds, g, So, E, wave, c.ph + 1000); }
        { pg8::Gemm g{Wb + 2304 * 1024, XB, 512, S, 1024}; pg8::StaticOrder So; So.init(512, S, G, (cb + 192) & 255);
          pg8::EpiVtTiled E{VT, 6, S};
          pg8::gemm_phase<pg8::EpiVtTiled, pg8::StaticOrder, true, true, 1011>(lds, g, So, E, wave, c.ph + 1000); }
    }
    SEAM();
    if (RUN) { IDS2; phase_nsa_cmp_gather(a, tid); }
    SEAM();
    if (RUN) { IDS2;
        { pg8::Gemm g{ACK, Wb + 6 * MiB / 2, 4096, 256, 2048}; pg8::StaticOrder So; So.init(4096, 256, G, cb); pg8::EpiGeluBf16 E{HK, 256};
          pg8::gemm_phase<pg8::EpiGeluBf16, pg8::StaticOrder, true, true, 1012>(lds, g, So, E, wave, c.ph + 1000); }
        { pg8::Gemm g{ACV, Wb + 7 * MiB / 2, 4096, 256, 2048}; pg8::StaticOrder So; So.init(4096, 256, G, (cb + 240) & 255); pg8::EpiGeluBf16 E{HV, 256};
          pg8::gemm_phase<pg8::EpiGeluBf16, pg8::StaticOrder, true, true, 1013>(lds, g, So, E, wave, c.ph + 1000); }
        if (cb >= 32) {
        for (int idx = cb - 32; idx < 1024 * REPN(6); idx += 224) { const int qt = (idx & 1023) >> 4, hh = idx & 15;
            AttnArgs A; A.Q0 = QK + 64 * hh; A.Q1 = nullptr; A.ldq = 1024; A.K0 = KH + (size_t)(4 + (hh >> 2)) * S * 64; A.ldk0 = 64; A.K1 = nullptr; A.ldk1 = 0;
            A.Vt = VT + (size_t)(256 + 64 * (hh >> 2)) * S; A.ldv = S; A.O = OH + (size_t)S * 1024 + 64 * hh; A.ldo = 1024; A.window = 512; A.Qb = nullptr; A.Kb = nullptr; A.lam = 0.f; A.gain = nullptr; A.gscale = 0.f; A.kbound = 2.04f * __builtin_bit_cast(float, xb_ld(AMX + 2));
            { BgNone nb_; attn_unit<64, 64>(lds, A, qt * 256, tid, lane, wave, nb_); } }
        }
    }
    SEAM();
    if (RUN) { IDS2;
        { pg8::Gemm g{HK, Wb + 8 * MiB / 2, 4096, 256, 256}; pg8::StaticOrder So; So.init(4096, 256, G, cb);
          pg8::EpiRope64 E{KC, 64, cs64, 1, 0, 1.0f, 1023, 16, 31, 1 << 30, nullptr, 0, AMX + 3};
          pg8::gemm_phase<pg8::EpiRope64, pg8::StaticOrder, true, true, 1014>(lds, g, So, E, wave, c.ph + 1000); }
        { pg8::Gemm g{Wb + 8 * MiB / 2 + 65536, HV, 256, 4096, 256}; pg8::StaticOrder So; So.init(256, 4096, G, (cb + 240) & 255);
          pg8::EpiBf16P E{VCT, 4096, 1.0f};
          pg8::gemm_phase<pg8::EpiBf16P, pg8::StaticOrder, true, true, 1015>(lds, g, So, E, wave, c.ph + 1000); }
    }
    SEAM();
    if (RUN) { IDS2;
        const float kb_sel = 2.04f * __builtin_bit_cast(float, xb_ld(AMX + 2)), kb_cmp = 2.04f * __builtin_bit_cast(float, xb_ld(AMX + 3)); (void)kb_cmp;
        for (int i_ = 0; i_ < 4 * REPN(3); ++i_) { const int i = i_ & 3; const int idx = i * 256 + cb, gg = idx & 3, aa = cb >> 2;
            const int T = (i == 0) ? 255 - aa : (i == 1) ? aa : (i == 2) ? 191 - aa : 64 + aa;
            nsa_cmp_unit(lds, a, T, gg, tid, lane, wave, kb_cmp);
            asm volatile("s_waitcnt vmcnt(0)" ::: "memory"); __syncthreads();
            nsa_sel_unit(lds, a, T, gg, tid, lane, wave, kb_sel);
            __syncthreads(); }
    }
    SEAM();
    if (RUN) { IDS2; pg8::Gemm g{AO, Wb + 9 * MiB / 2, S, 1024, 1024}; pg8::StaticOrder So; So.init(S, 1024, G, cb); pg8::EpiBf16P E{Y16, 1024, 1.0f};
        pg8::gemm_phase<pg8::EpiBf16P, pg8::StaticOrder, true, true, 1016>(lds, g, So, E, wave, c.ph + 1000); }
    SEAM();
}
template <int LAYER> __device__ __forceinline__ void moe_layer(const Args& a, Ctx& c) {
    CTX_LOCALS
    bf16* Wm = WSP(bf16, WS_WMOE + (size_t)LAYER * 192 * MiB);
    bf16* Act = WSP(bf16, WS_ACT); bf16* Ys = WSP(bf16, WS_YS);
    if (RUN) { IDS3; phase_ln1_router(a, lds, LAYER, tid, lane, wave); }
    SEAM();
    if (RUN) { IDS3; phase_place(a, lds, LAYER, tid, lane, wave); }
    SEAM();
    if (RUN) { IDS3;
        const int ntl = (int)lc[LC_NT], xcd = cb & 7, t0 = (ntl * xcd) >> 3, t1 = (ntl * (xcd + 1)) >> 3;
        { const v4u* src = (const v4u*)(WSP(unsigned short, WS_ROUTE + 2 * MiB) + (size_t)t0 * 256); LAS v4u* dst = (LAS v4u*)(lds + LDS_GIDX_OFF);
          for (int q = tid; q < (t1 - t0) * 32; q += NTHREADS) dst[q] = src[q]; }
        __syncthreads();
        pg8::MoeOrder So{8, G, cb, ntl, (const LAS int*)(lc + LC_TILEE), REPN(5)};
        {
        pg8::Gemm g{WSP(bf16, WS_AS), Wm, MOE_ROWS, 32 * 2048, 512, (const LAS unsigned short*)(lds + LDS_GIDX_OFF), t0};
        pg8::EpiSwiglu E{Act, a.in[I_MOE_BGU] + (size_t)LAYER * 32 * 2048, 1.0f / 64.0f, (unsigned char*)Act};
        pg8::gemm_phase<pg8::EpiSwiglu, pg8::MoeOrder, true, true, 1702, true, true, false, 1>(lds, g, So, E, wave, c.ph + 1000); } }
    SEAM();
    if (RUN) { IDS3; pg8::MoeOrder So{4, G, cb, (int)lc[LC_NT], (const LAS int*)(lc + LC_TILEE), REPN(5)};
        {
        pg8::Gemm g{Act, Wm + 64 * MiB, MOE_ROWS, 32 * 1024, 512};
        pg8::EpiDown E{Ys, a.in[I_MOE_BDN] + (size_t)LAYER * 32 * 1024, WSP(float, WS_ROUTE + 786432), (unsigned char*)Ys, 1.0f / 64.0f};
        pg8::gemm_phase<pg8::EpiDown, pg8::MoeOrder, true, true, 1019, false, true, false, 1>(lds, g, So, E, wave, c.ph + 1000); } }
    SEAM();
    if (RUN) { IDS3; phase_ln2(a, LAYER, LAYER == NLAYER - 1 ? a.out : nullptr, tid, lane, wave); }
    SEAM();
}

__global__ void __launch_bounds__(NTHREADS, 2) fwd_kernel(Args a) {
    extern __shared__ __attribute__((aligned(16))) unsigned char lds_raw[];
    Ctx c;
    c.lds = (LAS unsigned char*)lds_raw;
    { const int tid0 = threadIdx.x;
      c.wave = __builtin_amdgcn_readfirstlane(tid0 >> 6);
      c.G = gridDim.x; c.cb = blockIdx.x;
      c.lc = (LAS unsigned*)(c.lds + LDSCTL_OFF);
      for (int u = tid0; u < (LDS_BYTES - LDSCTL_OFF) / 4; u += NTHREADS) c.lc[u] = 0u;
      __syncthreads();
      c.bar = xcd_barrier_post(WSP(unsigned, WS_CTL) + CW_BAR, (volatile LAS unsigned*)c.lc, tid0); }
    c.ph = 0;
    if (RUN) { IDS4; for (int rep = 0; rep < REPN(0); ++rep) phase_prologue(a, c.lds, tid, lane, wave); }
    SEAM();
    da_layer<0>(a, c);  moe_layer<0>(a, c);
    mla_layer(a, c);    moe_layer<1>(a, c);
    nsa_layer(a, c);    moe_layer<2>(a, c);
    da_layer<3>(a, c);  moe_layer<3>(a, c);
}

static int add_job(Args& a, const float* src, bf16* dst, long long sbs, long long dbs, int ld, int K, int ncols, int col0, int mode, int nbatch, int f8 = 0) {
    Job& J = a.jobs[a.njobs]; J.src = src; J.dst = dst; J.sbs = sbs; J.dbs = dbs; J.ld = ld; J.K = K; J.ncols = ncols; J.col0 = col0; J.mode = mode; J.nbatch = nbatch; J.item0 = a.nitems; J.pad = f8;
    a.nitems += nbatch * (K / (f8 ? 128 : 64)) * ((ncols + 63) / 64); return a.njobs++;
}
extern "C" void kernel_launch(void* const* d_in, const int* in_sizes, int n_in, void* d_out, int out_size, void* d_ws, size_t ws_size, hipStream_t stream) {
    static int grid = 0;
    if (grid == 0) {
        if (n_in != N_IN || out_size != S * D || ws_size < WS_END) { fprintf(stderr, "kernel_launch: unexpected shapes: n_in %d out %d ws %zu (need %zu)\n", n_in, out_size, ws_size, (size_t)WS_END); grid = -1; return; }
        int dev = 0, cus = 0, per_cu = 0;
        hipGetDevice(&dev); hipDeviceGetAttribute(&cus, hipDeviceAttributeMultiprocessorCount, dev);
        if (hipFuncSetAttribute((const void*)fwd_kernel, hipFuncAttributeMaxDynamicSharedMemorySize, LDS_BYTES) != hipSuccess) { fprintf(stderr, "kernel_launch: hipFuncSetAttribute failed\n"); grid = -1; return; }
        hipOccupancyMaxActiveBlocksPerMultiprocessor(&per_cu, (const void*)fwd_kernel, NTHREADS, LDS_BYTES);
        (void)hipGetLastError();
        if (per_cu < 1 || cus < 256) { fprintf(stderr, "kernel_launch: occupancy %d, CUs %d: this kernel needs 256 resident workgroups\n", per_cu, cus); grid = -1; return; }
        grid = 256;
    }
    if (grid < 0) return;
    hipMemsetAsync((char*)d_ws + WS_CTL, 0, CTL_ZERO_BYTES, stream);
    Args a; memset(&a, 0, sizeof(a));
    for (int i = 0; i < N_IN; ++i) a.in[i] = (const float*)d_in[i];
    a.out = (float*)d_out; a.ws = (unsigned char*)d_ws;
    unsigned char* ws = (unsigned char*)d_ws;
    const long long KK = 1024;
    for (int j = 0; j < 2; ++j) {
        bf16* Wb = (bf16*)(ws + WS_WDA + (size_t)j * 8 * MiB);
        add_job(a, a.in[I_DA_WIN] + (size_t)j * 1024 * 3072, Wb, 0, 0, 3072, 1024, 2048, 0, CM_ROPE64, 1);
        add_job(a, a.in[I_DA_WIN] + (size_t)j * 1024 * 3072, Wb + 2048 * 1024, 0, 0, 3072, 1024, 1024, 2048, CM_IDENT, 1);
        add_job(a, a.in[I_DA_WOUT] + (size_t)j * 1024 * 1024, Wb + 3072 * 1024, 0, 0, 1024, 1024, 1024, 0, CM_IDENT, 1);
    }
    { bf16* Wb = (bf16*)(ws + WS_WMLA);
      add_job(a, a.in[I_MLA_WIN], Wb, 0, 0, 416, 1024, 416, 0, CM_IDENT, 1);
      add_job(a, a.in[I_MLA_WUQ], Wb + 1 * MiB / 2, 0, 0, 1536, 256, 1536, 0, CM_MLAQ, 1);
      add_job(a, a.in[I_MLA_WUKV], Wb + 2 * MiB / 2, 0, 0, 2048, 128, 2048, 0, CM_MLAKV, 1);
      add_job(a, a.in[I_MLA_WOUT], Wb + 3 * MiB / 2, 0, 0, 1024, 1024, 1024, 0, CM_IDENT, 1); }
    { bf16* Wb = (bf16*)(ws + WS_WNSA);
      add_job(a, a.in[I_NSA_WIN], Wb, 0, 0, 2608, 1024, 2608, 0, CM_NSAIN, 1);
      add_job(a, a.in[I_NSA_KW1], Wb + 6 * MiB / 2, 0, 0, 256, 2048, 256, 0, CM_IDENT, 1);
      add_job(a, a.in[I_NSA_VW1], Wb + 7 * MiB / 2, 0, 0, 256, 2048, 256, 0, CM_IDENT, 1);
      add_job(a, a.in[I_NSA_KW2], Wb + 8 * MiB / 2, 0, 0, 64, 256, 64, 0, CM_ROPE64, 1);
      add_job(a, a.in[I_NSA_VW2], Wb + 8 * MiB / 2 + 65536, 0, 0, 64, 256, 64, 0, CM_IDENT, 1);
      add_job(a, a.in[I_NSA_WOUT], Wb + 9 * MiB / 2, 0, 0, 1024, 1024, 1024, 0, CM_IDENT, 1); }
    for (int L = 0; L < NLAYER; ++L) {
        bf16* Wm = (bf16*)(ws + WS_WMOE + (size_t)L * 192 * MiB);
        add_job(a, a.in[I_MOE_WGU] + (size_t)L * 32 * KK * 2048, Wm, KK * 2048, 2048 * KK, 2048, 1024, 2048, 0, CM_SWIGLU, 32, 2);
        add_job(a, a.in[I_MOE_WDN] + (size_t)L * 32 * KK * 1024, Wm + 64 * MiB, KK * 1024, 1024 * KK, 1024, 1024, 1024, 0, CM_IDENT, 32, 2);
    }
    a.nitems = a.jobs[18].item0;
    a.ph_lo = 0; a.ph_hi = 1 << 20;
    hipLaunchKernelGGL(fwd_kernel, dim3(grid), dim3(NTHREADS), LDS_BYTES, stream, a);
    const hipError_t le = hipPeekAtLastError();
    if (le != hipSuccess) fprintf(stderr, "kernel_launch: launch failed: %s\n", hipGetErrorName(le));
}
```

```cpp
#ifndef REP
#define REP 0
#endif
#include <hip/hip_runtime.h>
#include <cstdio>
#include <cstdint>
#include <cstring>
namespace pg8 {
#define PG8_LAS __attribute__((address_space(3)))
typedef unsigned short bf16_t;
typedef short bf16x8 __attribute__((ext_vector_type(8)));
typedef float f32x4 __attribute__((ext_vector_type(4)));
typedef int i32x4 __attribute__((ext_vector_type(4)));
typedef long i64x2 __attribute__((ext_vector_type(2)));
typedef unsigned u32x4 __attribute__((ext_vector_type(4)));
constexpr int BM = 256, BK = 64, HALF = 128, HTB = HALF * BK * 2  , STAGE_BYTES = 8 * HTB, NXCD = 8, WGM = 8;

__host__ __device__ __forceinline__ int lds_byte(int r, int c) { const int st = (r >> 4) * 2 + (c >> 5), rr = r & 15, cc = c & 31, ob = rr * 64 + cc * 2; return st * 1024 + (ob ^ (((ob >> 9) & 1) << 5)); }
__host__ __device__ __forceinline__ void stage_rc(int b, int& R, int& C) { const int st = b / 1024, sb = b % 1024, swz = sb ^ (((sb >> 9) & 1) << 5); R = (st >> 1) * 16 + swz / 64; C = (st & 1) * 32 + (swz % 64) / 2; }
__host__ __device__ __forceinline__ int perm32(int rho) { const int n = rho >> 4, i = rho & 15; return 8 * (i >> 2) + 4 * n + (i & 3); }

struct Unit { int pm, pn, half; };
struct Gemm { const bf16_t* A; const bf16_t* Bt; int M, N, K; const PG8_LAS unsigned short* gidx; int gtile0; };

struct StaticOrder {
    int nM, nN, nwg, G, c;
    __host__ __device__ void init(int M, int N, int G_, int c_) { nM = M / BM; nN = N / BM; nwg = nM * nN; G = G_; c = c_; }
    __host__ __device__ bool next(int i, Unit& u) const {
        long L = (long)i * G + c;
#if defined(REP) && ((REP >> 8) & 1)
        if (L >= 2 * nwg) return false; if (L >= nwg) L -= nwg;
#else
        if (L >= nwg) return false;
#endif
        int wgid = (int)L; { const int q = nwg / NXCD, r = nwg % NXCD, xcd = wgid % NXCD, off = wgid / NXCD; wgid = (xcd < r ? xcd * (q + 1) : r * (q + 1) + (xcd - r) * q) + off; }
        const int nig = WGM * nN, gid = wgid / nig, fm = gid * WGM, gsz = (nM - fm) < WGM ? (nM - fm) : WGM;
        u.pm = fm + ((wgid % nig) % gsz); u.pn = (wgid % nig) / gsz; u.half = 0; return true;
    }
    __device__ __forceinline__ void a_ready(const Unit&) const {}
    __device__ __forceinline__ void done(const Unit&) const {}
};

__device__ __forceinline__ unsigned cvt_pk_bf16(float lo, float hi) { unsigned r; asm volatile("v_cvt_pk_bf16_f32 %0, %1, %2" : "=v"(r) : "v"(lo), "v"(hi)); return r; }
typedef float f32x2 __attribute__((ext_vector_type(2)));
typedef unsigned u32x2 __attribute__((ext_vector_type(2)));
struct __attribute__((aligned(8))) cs_t { float c, s; };
struct EpiBf16P {
    static constexpr bool PERM = true, AFTER_DRAIN = false, AMAX = false;
    bf16_t* O; int ldc; float scale;
    __device__ __forceinline__ void operator()(const f32x4 (&acc)[2][2][4][2], const Unit& u, int wr, int wc, int fr, int fq) const {
        const int row0 = u.pm * BM + wr * 64 + fr, col0 = u.pn * BM + wc * 32 + 8 * fq;
#pragma unroll
        for (int ai = 0; ai < 2; ++ai)
#pragma unroll
            for (int m = 0; m < 4; ++m) { bf16_t* rowp = O + (size_t)(row0 + ai * HALF + m * 16) * ldc + col0;
#pragma unroll
                for (int bj = 0; bj < 2; ++bj) { const f32x4 v0 = acc[ai][bj][m][0] * scale, v1 = acc[ai][bj][m][1] * scale;
                    u32x4 w; w.x = cvt_pk_bf16(v0[0], v0[1]); w.y = cvt_pk_bf16(v0[2], v0[3]); w.z = cvt_pk_bf16(v1[0], v1[1]); w.w = cvt_pk_bf16(v1[2], v1[3]);
                    *(u32x4*)(rowp + bj * HALF) = w; } }
    }
};
struct EpiHeadMajor64 {
    static constexpr bool PERM = true, AFTER_DRAIN = false, AMAX = true;
    bf16_t* O; int nrows; unsigned* amax;
    __device__ __forceinline__ void operator()(const f32x4 (&acc)[2][2][4][2], const Unit& u, int wr, int wc, int fr, int fq) const {
        const int row0 = u.pm * BM + wr * 64 + fr, col0 = u.pn * BM + wc * 32 + 8 * fq;
#pragma unroll
        for (int ai = 0; ai < 2; ++ai)
#pragma unroll
            for (int m = 0; m < 4; ++m) { const int row = row0 + ai * HALF + m * 16;
#pragma unroll
                for (int bj = 0; bj < 2; ++bj) { const int col = col0 + bj * HALF; const f32x4 v0 = acc[ai][bj][m][0], v1 = acc[ai][bj][m][1];
                    u32x4 w; w.x = cvt_pk_bf16(v0[0], v0[1]); w.y = cvt_pk_bf16(v0[2], v0[3]); w.z = cvt_pk_bf16(v1[0], v1[1]); w.w = cvt_pk_bf16(v1[2], v1[3]);
                    *(u32x4*)(O + ((size_t)(col >> 6) * nrows + row) * 64 + (col & 63)) = w; } }
    }
};
struct EpiVtTiled {
    static constexpr bool PERM = true, AFTER_DRAIN = false, AMAX = false;
    bf16_t* O; int dvshift; int ntok;
    __device__ __forceinline__ void operator()(const f32x4 (&acc)[2][2][4][2], const Unit& u, int wr, int wc, int fr, int fq) const {
        const int row0 = u.pm * BM + wr * 64 + fr, col0 = u.pn * BM + wc * 32 + 8 * fq; const int DVm = (1 << dvshift) - 1, nt = ntok >> 6;
#pragma unroll
        for (int ai = 0; ai < 2; ++ai)
#pragma unroll
            for (int m = 0; m < 4; ++m) { const int row = row0 + ai * HALF + m * 16; const int head = row >> dvshift, dv = row & DVm;
#pragma unroll
                for (int bj = 0; bj < 2; ++bj) { const int col = col0 + bj * HALF; const f32x4 v0 = acc[ai][bj][m][0], v1 = acc[ai][bj][m][1];
                    u32x4 w; w.x = cvt_pk_bf16(v0[0], v0[1]); w.y = cvt_pk_bf16(v0[2], v0[3]); w.z = cvt_pk_bf16(v1[0], v1[1]); w.w = cvt_pk_bf16(v1[2], v1[3]);
                    *(u32x4*)(O + ((((size_t)head * nt + (col >> 6)) << dvshift) + dv) * 64 + (col & 63)) = w; } }
    }
};
struct EpiF32 {
    static constexpr bool PERM = false, AFTER_DRAIN = false, AMAX = true;
    float* O; int ldc; unsigned* amax;
    __device__ __forceinline__ void operator()(const f32x4 (&acc)[2][2][4][2], const Unit& u, int wr, int wc, int fr, int fq) const {
        const int row0 = u.pm * BM + wr * 64 + fr, col0 = u.pn * BM + wc * 32 + 4 * fq;
#pragma unroll
        for (int ai = 0; ai < 2; ++ai)
#pragma unroll
            for (int m = 0; m < 4; ++m) { float* rowp = O + (size_t)(row0 + ai * HALF + m * 16) * ldc + col0;
#pragma unroll
                for (int bj = 0; bj < 2; ++bj)
#pragma unroll
                    for (int n = 0; n < 2; ++n) *(f32x4*)(rowp + bj * HALF + n * 16) = acc[ai][bj][m][n]; }
    }
};
struct EpiRope64 {
    static constexpr bool PERM = true, AFTER_DRAIN = false, AMAX = true;
    bf16_t* O; int ldc; const cs_t* cs; int nheads; int nq_tiles; float qscale; int posmask, posmul, posadd; int hm_from; bf16_t* Ohm; int hm_rows; unsigned* amax;
    __device__ __forceinline__ void operator()(const f32x4 (&acc)[2][2][4][2], const Unit& u, int wr, int wc, int fr, int fq) const {
        const int hv = 4 * u.pn + wc; if (hv >= nheads) return;
        const bool hm = hv >= hm_from;
        const float sc = (u.pn < nq_tiles) ? qscale : 1.0f;
        const int row0 = u.pm * BM + wr * 64 + fr, y0 = 8 * fq;
#pragma unroll
        for (int ai = 0; ai < 2; ++ai)
#pragma unroll
            for (int m = 0; m < 4; ++m) { const int row = row0 + ai * HALF + m * 16; const int pos = (row & posmask) * posmul + posadd;
                const f32x4* cp = (const f32x4*)(cs + (size_t)pos * 32 + y0);
                const f32x4 c0 = cp[0], c1 = cp[1], c2 = cp[2], c3 = cp[3];
                const f32x4 a0 = acc[ai][0][m][0], a1 = acc[ai][0][m][1], b0 = acc[ai][1][m][0], b1 = acc[ai][1][m][1];
                float o1[8], o2[8];
                o1[0] = a0[0] * c0[0] - b0[0] * c0[1]; o2[0] = b0[0] * c0[0] + a0[0] * c0[1];
                o1[1] = a0[1] * c0[2] - b0[1] * c0[3]; o2[1] = b0[1] * c0[2] + a0[1] * c0[3];
                o1[2] = a0[2] * c1[0] - b0[2] * c1[1]; o2[2] = b0[2] * c1[0] + a0[2] * c1[1];
                o1[3] = a0[3] * c1[2] - b0[3] * c1[3]; o2[3] = b0[3] * c1[2] + a0[3] * c1[3];
                o1[4] = a1[0] * c2[0] - b1[0] * c2[1]; o2[4] = b1[0] * c2[0] + a1[0] * c2[1];
                o1[5] = a1[1] * c2[2] - b1[1] * c2[3]; o2[5] = b1[1] * c2[2] + a1[1] * c2[3];
                o1[6] = a1[2] * c3[0] - b1[2] * c3[1]; o2[6] = b1[2] * c3[0] + a1[2] * c3[1];
                o1[7] = a1[3] * c3[2] - b1[3] * c3[3]; o2[7] = b1[3] * c3[2] + a1[3] * c3[3];
                bf16_t* rowp = hm ? (Ohm + ((size_t)(hv - hm_from) * hm_rows + row) * 64 + y0) : (O + (size_t)row * ldc + 64 * hv + y0);
                u32x4 w; w.x = cvt_pk_bf16(o1[0] * sc, o1[1] * sc); w.y = cvt_pk_bf16(o1[2] * sc, o1[3] * sc); w.z = cvt_pk_bf16(o1[4] * sc, o1[5] * sc); w.w = cvt_pk_bf16(o1[6] * sc, o1[7] * sc);
                *(u32x4*)rowp = w;
                w.x = cvt_pk_bf16(o2[0] * sc, o2[1] * sc); w.y = cvt_pk_bf16(o2[2] * sc, o2[3] * sc); w.z = cvt_pk_bf16(o2[4] * sc, o2[5] * sc); w.w = cvt_pk_bf16(o2[6] * sc, o2[7] * sc);
                *(u32x4*)(rowp + 32) = w; }
    }
};
struct EpiRope16 {
    static constexpr bool PERM = true, AFTER_DRAIN = false, AMAX = false;
    bf16_t* O; int ldc; const cs_t* cs; float qscale;
    __device__ __forceinline__ void operator()(const f32x4 (&acc)[2][2][4][2], const Unit& u, int wr, int wc, int fr, int fq) const {
        const int row0 = u.pm * BM + wr * 64 + fr; const float sc = qscale;
        const int head = 8 * u.pn + 2 * wc + (fq >> 1), y0 = 8 * (fq & 1);
#pragma unroll
        for (int ai = 0; ai < 2; ++ai)
#pragma unroll
            for (int m = 0; m < 4; ++m) { const int row = row0 + ai * HALF + m * 16;
                const f32x4* cp = (const f32x4*)(cs + (size_t)row * 16 + y0);
                const f32x4 c0 = cp[0], c1 = cp[1], c2 = cp[2], c3 = cp[3];
                const f32x4 a0 = acc[ai][0][m][0], a1 = acc[ai][0][m][1], b0 = acc[ai][1][m][0], b1 = acc[ai][1][m][1];
                float o1[8], o2[8];
                o1[0] = a0[0] * c0[0] - b0[0] * c0[1]; o2[0] = b0[0] * c0[0] + a0[0] * c0[1];
                o1[1] = a0[1] * c0[2] - b0[1] * c0[3]; o2[1] = b0[1] * c0[2] + a0[1] * c0[3];
                o1[2] = a0[2] * c1[0] - b0[2] * c1[1]; o2[2] = b0[2] * c1[0] + a0[2] * c1[1];
                o1[3] = a0[3] * c1[2] - b0[3] * c1[3]; o2[3] = b0[3] * c1[2] + a0[3] * c1[3];
                o1[4] = a1[0] * c2[0] - b1[0] * c2[1]; o2[4] = b1[0] * c2[0] + a1[0] * c2[1];
                o1[5] = a1[1] * c2[2] - b1[1] * c2[3]; o2[5] = b1[1] * c2[2] + a1[1] * c2[3];
                o1[6] = a1[2] * c3[0] - b1[2] * c3[1]; o2[6] = b1[2] * c3[0] + a1[2] * c3[1];
                o1[7] = a1[3] * c3[2] - b1[3] * c3[3]; o2[7] = b1[3] * c3[2] + a1[3] * c3[3];
                bf16_t* rowp = O + (size_t)row * ldc + 32 * head + y0;
                u32x4 w; w.x = cvt_pk_bf16(o1[0] * sc, o1[1] * sc); w.y = cvt_pk_bf16(o1[2] * sc, o1[3] * sc); w.z = cvt_pk_bf16(o1[4] * sc, o1[5] * sc); w.w = cvt_pk_bf16(o1[6] * sc, o1[7] * sc);
                *(u32x4*)rowp = w;
                w.x = cvt_pk_bf16(o2[0] * sc, o2[1] * sc); w.y = cvt_pk_bf16(o2[2] * sc, o2[3] * sc); w.z = cvt_pk_bf16(o2[4] * sc, o2[5] * sc); w.w = cvt_pk_bf16(o2[6] * sc, o2[7] * sc);
                *(u32x4*)(rowp + 16) = w; }
    }
};
__device__ __forceinline__ float gelu_tanh(float x) {
    const float u2 = 1.5957691216057308f * (x + 0.044715f * x * x * x);
    return x * __builtin_amdgcn_rcpf(1.0f + __builtin_amdgcn_exp2f(-1.4426950408889634f * u2));
}
struct EpiGeluBf16 {
    static constexpr bool PERM = true, AFTER_DRAIN = false, AMAX = false;
    bf16_t* O; int ldc;
    __device__ __forceinline__ void operator()(const f32x4 (&acc)[2][2][4][2], const Unit& u, int wr, int wc, int fr, int fq) const {
        const int row0 = u.pm * BM + wr * 64 + fr, col0 = u.pn * BM + wc * 32 + 8 * fq;
#pragma unroll
        for (int ai = 0; ai < 2; ++ai)
#pragma unroll
            for (int m = 0; m < 4; ++m) { bf16_t* rowp = O + (size_t)(row0 + ai * HALF + m * 16) * ldc + col0;
#pragma unroll
                for (int bj = 0; bj < 2; ++bj) { const f32x4 v0 = acc[ai][bj][m][0], v1 = acc[ai][bj][m][1];
                    u32x4 w; w.x = cvt_pk_bf16(gelu_tanh(v0[0]), gelu_tanh(v0[1])); w.y = cvt_pk_bf16(gelu_tanh(v0[2]), gelu_tanh(v0[3]));
                    w.z = cvt_pk_bf16(gelu_tanh(v1[0]), gelu_tanh(v1[1])); w.w = cvt_pk_bf16(gelu_tanh(v1[2]), gelu_tanh(v1[3]));
                    *(u32x4*)(rowp + bj * HALF) = w; } }
    }
};
__device__ __forceinline__ float swiglu1(float g, float l) {
    const float hg = fminf(g, 7.0f), hl = fminf(fmaxf(l, -7.0f), 7.0f);
    return hg * __builtin_amdgcn_rcpf(1.0f + __builtin_amdgcn_exp2f(-1.702f * 1.4426950408889634f * hg)) * (hl + 1.0f);
}
struct EpiSwiglu {
    static constexpr bool PERM = true, AFTER_DRAIN = false, AMAX = false;
    bf16_t* O; const float* bgu; float ws; unsigned char* O8;
    __device__ __forceinline__ void operator()(const f32x4 (&acc)[2][2][4][2], const Unit& u, int wr, int wc, int fr, int fq) const {
        const int e = u.pn >> 3, pnl = u.pn & 7;
        const int row0 = u.pm * BM + wr * 64 + fr, f0 = pnl * 128 + wc * 32 + 8 * fq;
        const f32x4* bp = (const f32x4*)(bgu + (size_t)e * 2048 + 2 * f0);
        const f32x4 q0 = bp[0], q1 = bp[1], q2 = bp[2], q3 = bp[3];
#pragma unroll
        for (int ai = 0; ai < 2; ++ai)
#pragma unroll
            for (int m = 0; m < 4; ++m) { bf16_t* rowp = O + (size_t)(row0 + ai * HALF + m * 16) * 1024 + f0;
                const f32x4 g0 = acc[ai][0][m][0] * ws, g1 = acc[ai][0][m][1] * ws, l0 = acc[ai][1][m][0] * ws, l1 = acc[ai][1][m][1] * ws;
                u32x4 w;
                w.x = cvt_pk_bf16(swiglu1(g0[0] + q0[0], l0[0] + q0[1]), swiglu1(g0[1] + q0[2], l0[1] + q0[3]));
                w.y = cvt_pk_bf16(swiglu1(g0[2] + q1[0], l0[2] + q1[1]), swiglu1(g0[3] + q1[2], l0[3] + q1[3]));
                w.z = cvt_pk_bf16(swiglu1(g1[0] + q2[0], l1[0] + q2[1]), swiglu1(g1[1] + q2[2], l1[1] + q2[3]));
                w.w = cvt_pk_bf16(swiglu1(g1[2] + q3[0], l1[2] + q3[1]), swiglu1(g1[3] + q3[2], l1[3] + q3[3]));
                if (O8 == nullptr) *(u32x4*)rowp = w;
                else { int p0_ = __builtin_amdgcn_cvt_pk_fp8_f32(__builtin_bit_cast(float, w.x << 16), __builtin_bit_cast(float, w.x & 0xffff0000u), 0, false);
                    p0_ = __builtin_amdgcn_cvt_pk_fp8_f32(__builtin_bit_cast(float, w.y << 16), __builtin_bit_cast(float, w.y & 0xffff0000u), p0_, true);
                    int p1_ = __builtin_amdgcn_cvt_pk_fp8_f32(__builtin_bit_cast(float, w.z << 16), __builtin_bit_cast(float, w.z & 0xffff0000u), 0, false);
                    p1_ = __builtin_amdgcn_cvt_pk_fp8_f32(__builtin_bit_cast(float, w.w << 16), __builtin_bit_cast(float, w.w & 0xffff0000u), p1_, true);
                    *(u32x2*)(O8 + (size_t)(row0 + ai * HALF + m * 16) * 1024 + f0) = (u32x2){(unsigned)p0_, (unsigned)p1_}; } }
    }
};
struct EpiDown {
    static constexpr bool PERM = true, AFTER_DRAIN = false, AMAX = false;
    bf16_t* O; const float* bd; const float* rgate; unsigned char* O8; float ws;
    __device__ __forceinline__ void operator()(const f32x4 (&acc)[2][2][4][2], const Unit& u, int wr, int wc, int fr, int fq) const {
        const int e = u.pn >> 2, pnl = u.pn & 3;
        const int row0 = u.pm * BM + wr * 64 + fr, col0 = pnl * BM + wc * 32 + 8 * fq;
        f32x4 bv[2][2];
#pragma unroll
        for (int bj = 0; bj < 2; ++bj)
#pragma unroll
            for (int n = 0; n < 2; ++n) bv[bj][n] = *(const f32x4*)(bd + (size_t)e * 1024 + col0 + bj * HALF + 4 * n);
#pragma unroll
        for (int ai = 0; ai < 2; ++ai)
#pragma unroll
            for (int m = 0; m < 4; ++m) { const int row = row0 + ai * HALF + m * 16; const float gw = rgate[row]; bf16_t* rowp = O + (size_t)row * 1024 + col0;
#pragma unroll
                for (int bj = 0; bj < 2; ++bj) { const f32x4 v0 = (acc[ai][bj][m][0] * ws + bv[bj][0]) * gw, v1 = (acc[ai][bj][m][1] * ws + bv[bj][1]) * gw;
                    if (O8 == nullptr) { u32x4 w; w.x = cvt_pk_bf16(v0[0], v0[1]); w.y = cvt_pk_bf16(v0[2], v0[3]); w.z = cvt_pk_bf16(v1[0], v1[1]); w.w = cvt_pk_bf16(v1[2], v1[3]);
                    *(u32x4*)(rowp + bj * HALF) = w; }
                    else {
                        int p0_ = __builtin_amdgcn_cvt_pk_fp8_f32(v0[0] * 16.f, v0[1] * 16.f, 0, false); p0_ = __builtin_amdgcn_cvt_pk_fp8_f32(v0[2] * 16.f, v0[3] * 16.f, p0_, true);
                        int p1_ = __builtin_amdgcn_cvt_pk_fp8_f32(v1[0] * 16.f, v1[1] * 16.f, 0, false); p1_ = __builtin_amdgcn_cvt_pk_fp8_f32(v1[2] * 16.f, v1[3] * 16.f, p1_, true);
                        *(u32x2*)(O8 + (size_t)row * 1024 + col0 + bj * HALF) = (u32x2){(unsigned)p0_, (unsigned)p1_}; } } }
    }
};
struct EpiDownH {
    static constexpr bool PERM = true, AFTER_DRAIN = false, AMAX = false;
    bf16_t* O; const float* bd; const float* rgate; float ws;
    __device__ __forceinline__ void operator()(const f32x4 (&acc)[2][2][4][2], const Unit& u, int wr, int wc, int fr, int fq) const {
        const int e = u.pn >> 3, pnl = u.pn & 7;
        const int row0 = u.pm * BM + wr * 64 + fr, col0 = pnl * HALF + wc * 32 + 8 * fq;
        const f32x4 bv0 = *(const f32x4*)(bd + (size_t)e * 1024 + col0), bv1 = *(const f32x4*)(bd + (size_t)e * 1024 + col0 + 4);
#pragma unroll
        for (int ai = 0; ai < 2; ++ai)
#pragma unroll
            for (int m = 0; m < 4; ++m) { const int row = row0 + ai * HALF + m * 16; const float gw = rgate[row];
                const f32x4 v0 = (acc[ai][0][m][0] * ws + bv0) * gw, v1 = (acc[ai][0][m][1] * ws + bv1) * gw;
                u32x4 w; w.x = cvt_pk_bf16(v0[0], v0[1]); w.y = cvt_pk_bf16(v0[2], v0[3]); w.z = cvt_pk_bf16(v1[0], v1[1]); w.w = cvt_pk_bf16(v1[2], v1[3]);
                *(u32x4*)(O + (size_t)row * 1024 + col0) = w; }
    }
};
struct MoeOrder {
    int nN, G, c, ntiles; const PG8_LAS int* tile_e; int rep;
    __device__ bool next(int i, Unit& u) const {
        const int xcd = c & 7, jj = c >> 3, per = G >> 3;
        const int t0 = (ntiles * xcd) >> 3, t1 = (ntiles * (xcd + 1)) >> 3;
        int li = i * per + jj; const int tot = (t1 - t0) * nN; if (li >= tot * rep) return false; if (li >= tot) li -= tot;
        const int pm = t0 + li / nN, pnl = li - (li / nN) * nN; const int te = tile_e[pm], e = te & 255;
        u.pm = pm; u.pn = __builtin_amdgcn_readfirstlane(e * nN + pnl); u.half = __builtin_amdgcn_readfirstlane(te >> 8); return true;
    }
    __device__ __forceinline__ void a_ready(const Unit&) const {}
    __device__ __forceinline__ void done(const Unit&) const {}
};
template <class Epi, class Sched, bool ALIGN_EPI, bool SP2, int UIDC, bool GATHER = false, bool F8 = false, bool NHALF = false, int F8N1 = 0>
__device__ __forceinline__ void gemm_phase(PG8_LAS unsigned char* lds, const Gemm g, const Sched& S, const Epi& E, const int wid_in, const int UID) {
    const int wid = wid_in, lane = (int)__builtin_amdgcn_mbcnt_hi(~0u, __builtin_amdgcn_mbcnt_lo(~0u, (unsigned)UID)) - UID, tid = wid * 64 + lane, wr = wid >> 2, wc = wid & 3, fr = lane & 15, fq = lane >> 4;
    int K_l = g.K; asm volatile("; opaque K" : "+s"(K_l));
    const int K = K_l, nt = K / BK;
    static_assert(!GATHER || SP2, "GATHER is wired into the SP2 loop only");
    unsigned voffA[2], voffB[2];
#pragma unroll
    for (int i = 0; i < 2; ++i) { int R, C; stage_rc(tid * 16 + i * 8192, R, C); const int Rb = Epi::PERM ? ((R & ~31) + perm32(R & 31)) : R;
        voffA[i] = (unsigned)(R * K + C) * 2u; voffB[i] = (unsigned)(Rb * K + C) * 2u; }
    const size_t kstep = (size_t)(BK * 2);
    const size_t hstep = (size_t)HALF * K * 2;
    const size_t tstep = 2 * hstep;
    const unsigned ldsw = (unsigned)wid * 1024u;
    const int aoff = lds_byte(wr * 64 + fr, fq * 8), boff = lds_byte(wc * 32 + fr, fq * 8);
#define PG8_SA(b, h) (((b) * 2 + (h)) * HTB)
#define PG8_SB(b, h) ((4 + (b) * 2 + (h)) * HTB)
#define PG8_STAGE(bufoff, gbase, voff) do { _Pragma("unroll") for (int _i = 0; _i < 2; ++_i) \
        __builtin_amdgcn_global_load_lds((const unsigned*)((const char*)(gbase) + (voff)[_i]), (PG8_LAS unsigned*)(lds + (bufoff) + ldsw + _i * 8192), 16, 0, 0); } while (0)
#define PG8_STAGE_A(b, h, gbase, usenext) do { if constexpr (GATHER) { const unsigned _v0 = (usenext) ? vAn[h][0] : vAc[h][0], _v1 = (usenext) ? vAn[h][1] : vAc[h][1]; \
        __builtin_amdgcn_global_load_lds((const unsigned*)((const char*)(gbase) + _v0), (PG8_LAS unsigned*)(lds + PG8_SA(b, h) + ldsw), 16, 0, 0); \
        __builtin_amdgcn_global_load_lds((const unsigned*)((const char*)(gbase) + _v1), (PG8_LAS unsigned*)(lds + PG8_SA(b, h) + ldsw + 8192), 16, 0, 0); } \
    else PG8_STAGE(PG8_SA(b, h), (gbase) + (h) * hstep, voffA); } while (0)
#define PG8_LDA(dst, b, h) do { _Pragma("unroll") for (int m = 0; m < 4; ++m) _Pragma("unroll") for (int k = 0; k < 2; ++k) dst[m][k] = *(const PG8_LAS bf16x8*)(lds + PG8_SA(b, h) + aoff + m * 2048 + k * 1024); } while (0)
#define PG8_LDB(dst, b, h) do { _Pragma("unroll") for (int n = 0; n < 2; ++n) _Pragma("unroll") for (int k = 0; k < 2; ++k) dst[n][k] = *(const PG8_LAS bf16x8*)(lds + PG8_SB(b, h) + boff + n * 2048 + k * 1024); } while (0)
#define PG8_MMA(ai, bj, At, Bt) do { if constexpr (!(NHALF && (bj) == 1)) if ((ai) == 0 || !hf_) { __builtin_amdgcn_s_setprio(1); if constexpr (F8) { _Pragma("unroll") for (int m = 0; m < 4; ++m) _Pragma("unroll") for (int n = 0; n < 2; ++n) { \
        if (NHALF || (bj) == 0 || n < F8N1) acc[ai][bj][m][n] = __builtin_amdgcn_mfma_scale_f32_16x16x128_f8f6f4(__builtin_shufflevector(__builtin_bit_cast(i32x4, Bt[n][0]), __builtin_bit_cast(i32x4, Bt[n][1]), 0, 1, 2, 3, 4, 5, 6, 7), \
            __builtin_shufflevector(__builtin_bit_cast(i32x4, At[m][0]), __builtin_bit_cast(i32x4, At[m][1]), 0, 1, 2, 3, 4, 5, 6, 7), acc[ai][bj][m][n], 0, 0, 0, 0, 0, 0); \
        else { _Pragma("unroll") for (int k = 0; k < 2; ++k) { const i64x2 a_ = __builtin_bit_cast(i64x2, At[m][k]), b_ = __builtin_bit_cast(i64x2, Bt[n][k]); \
            acc[ai][bj][m][n] = __builtin_amdgcn_mfma_f32_16x16x32_fp8_fp8(b_[0], a_[0], acc[ai][bj][m][n], 0, 0, 0); \
            acc[ai][bj][m][n] = __builtin_amdgcn_mfma_f32_16x16x32_fp8_fp8(b_[1], a_[1], acc[ai][bj][m][n], 0, 0, 0); } } } } \
    else { _Pragma("unroll") for (int m = 0; m < 4; ++m) _Pragma("unroll") for (int n = 0; n < 2; ++n) _Pragma("unroll") for (int k = 0; k < 2; ++k) \
        acc[ai][bj][m][n] = __builtin_amdgcn_mfma_f32_16x16x32_bf16(Bt[n][k], At[m][k], acc[ai][bj][m][n], 0, 0, 0); } __builtin_amdgcn_s_setprio(0); } } while (0)
#define PG8_WAIT_V(n) asm volatile("s_waitcnt vmcnt(" #n ")" ::: "memory")
#define PG8_WAIT_L(n) asm volatile("s_waitcnt lgkmcnt(" #n ")" ::: "memory")
#define PG8_BAR __builtin_amdgcn_s_barrier()
#define PG8_SCHED __builtin_amdgcn_sched_barrier(0)
    Unit cur, nxt; int ui = 0;
    if (!S.next(0, cur)) return;
    f32x4 acc[2][2][4][2];
#pragma unroll
    for (int a = 0; a < 2; ++a)
#pragma unroll
        for (int b = 0; b < 2; ++b)
#pragma unroll
            for (int m = 0; m < 4; ++m)
#pragma unroll
                for (int n = 0; n < 2; ++n) acc[a][b][m][n] = (f32x4){0.f, 0.f, 0.f, 0.f};
    bf16x8 At[4][2], B0[2][2], B1[2][2];
    const char* cA = (const char*)g.A + (GATHER ? (size_t)0 : (size_t)cur.pm * tstep); const char* cB = (const char*)g.Bt + (size_t)cur.pn * (NHALF ? hstep : tstep);
    unsigned vAc[2][2], vAn[2][2];
    auto gvoff = [&](int pm, unsigned (&v)[2][2]) {
        const int ln_ = (int)__builtin_amdgcn_mbcnt_hi(~0u, __builtin_amdgcn_mbcnt_lo(~0u, (unsigned)pm)) - pm, tid_ = wid * 64 + ln_;
#pragma unroll
        for (int hh = 0; hh < 2; ++hh)
#pragma unroll
            for (int i = 0; i < 2; ++i) { int R, C; stage_rc(tid_ * 16 + i * 8192, R, C); v[hh][i] = (unsigned)g.gidx[(pm - g.gtile0) * 256 + hh * HALF + R] * (unsigned)(K * 2) + (unsigned)(C * 2); } };
    if constexpr (GATHER) { gvoff(cur.pm, vAc); } else { vAc[0][0] = vAc[0][1] = vAc[1][0] = vAc[1][1] = 0u; }
#pragma unroll
    for (int hh = 0; hh < 2; ++hh) { vAn[hh][0] = vAc[hh][0]; vAn[hh][1] = vAc[hh][1]; }
    S.a_ready(cur);
    if constexpr (SP2) {
        PG8_STAGE(PG8_SB(0, 0), cB, voffB); PG8_STAGE(PG8_SB(0, 1), cB + hstep, voffB); PG8_STAGE_A(0, 0, cA, false); PG8_STAGE_A(0, 1, cA, false);
        if (wr == 1) PG8_BAR;
        PG8_WAIT_V(2); PG8_BAR;
        PG8_STAGE(PG8_SB(1, 0), cB + kstep, voffB); PG8_STAGE_A(1, 0, cA + kstep, false); PG8_STAGE(PG8_SB(1, 1), cB + hstep + kstep, voffB);
        PG8_WAIT_V(6); PG8_BAR;
    } else {
        PG8_STAGE(PG8_SB(0, 0), cB, voffB); PG8_STAGE(PG8_SA(0, 0), cA, voffA); PG8_STAGE(PG8_SB(0, 1), cB + hstep, voffB); PG8_STAGE(PG8_SA(0, 1), cA + hstep, voffA);
        if (wr == 1) PG8_BAR;
        PG8_WAIT_V(4); PG8_BAR;
        PG8_STAGE(PG8_SB(1, 0), cB + kstep, voffB); PG8_STAGE(PG8_SA(1, 0), cA + kstep, voffA); PG8_STAGE(PG8_SB(1, 1), cB + hstep + kstep, voffB);
        PG8_WAIT_V(6); PG8_BAR;
    }
    for (;;) {
        const bool has_next = S.next(ui + 1, nxt);
        const bool hf_ = cur.half != 0;
        const char* nA = (has_next && !GATHER) ? (const char*)g.A + (size_t)nxt.pm * tstep : (GATHER ? (const char*)g.A : cA); const char* nB = has_next ? (const char*)g.Bt + (size_t)nxt.pn * (NHALF ? hstep : tstep) : cB;
        if constexpr (GATHER) { if (has_next) gvoff(nxt.pm, vAn); else {
#pragma unroll
            for (int hh = 0; hh < 2; ++hh) { vAn[hh][0] = vAc[hh][0]; vAn[hh][1] = vAc[hh][1]; } } }
        for (int t = 0; t < nt; t += 2) {
            const bool last = (t == nt - 2);
            const char* a1 = cA + (size_t)(t + 1) * kstep;
            const char* a2 = last ? nA : cA + (size_t)(t + 2) * kstep; const char* b2 = last ? nB : cB + (size_t)(t + 2) * kstep;
            const char* a3 = a2 + kstep; const char* b3 = b2 + kstep;
            if (last && has_next) S.a_ready(nxt);
            if constexpr (SP2) {
            PG8_LDB(B0, 0, 0); PG8_LDB(B1, 0, 1); PG8_SCHED; PG8_LDA(At, 0, 0); PG8_STAGE_A(1, 1, a1, false);
            PG8_WAIT_V(8); PG8_WAIT_L(0); PG8_BAR; PG8_MMA(0, 0, At, B0); PG8_MMA(0, 1, At, B1); PG8_BAR; PG8_SCHED;
            PG8_LDA(At, 0, 1); PG8_STAGE(PG8_SB(0, 0), b2, voffB); PG8_STAGE(PG8_SB(0, 1), b2 + hstep, voffB); PG8_STAGE_A(0, 0, a2, last);
            PG8_WAIT_V(8); PG8_WAIT_L(0); PG8_BAR; PG8_MMA(1, 0, At, B0); PG8_MMA(1, 1, At, B1); PG8_BAR; PG8_SCHED;
            PG8_LDB(B0, 1, 0); PG8_LDB(B1, 1, 1); PG8_SCHED; PG8_LDA(At, 1, 0); PG8_STAGE_A(0, 1, a2, last);
            PG8_WAIT_V(8); PG8_WAIT_L(0); PG8_BAR; PG8_MMA(0, 0, At, B0); PG8_MMA(0, 1, At, B1); PG8_BAR; PG8_SCHED;
            PG8_LDA(At, 1, 1); PG8_STAGE(PG8_SB(1, 0), b3, voffB); PG8_STAGE(PG8_SB(1, 1), b3 + hstep, voffB); PG8_STAGE_A(1, 0, a3, last);
            PG8_WAIT_V(8); PG8_WAIT_L(0); PG8_BAR; PG8_MMA(1, 0, At, B0); PG8_MMA(1, 1, At, B1); PG8_BAR; PG8_SCHED;
            } else {
            PG8_LDB(B0, 0, 0); PG8_SCHED; PG8_LDA(At, 0, 0); PG8_STAGE(PG8_SA(1, 1), a1 + hstep, voffA);
            PG8_WAIT_L(8); PG8_BAR; PG8_WAIT_L(0); PG8_MMA(0, 0, At, B0); PG8_BAR; PG8_SCHED;
            PG8_LDB(B1, 0, 1); PG8_STAGE(PG8_SB(0, 0), b2, voffB);
            PG8_BAR; PG8_WAIT_L(0); PG8_MMA(0, 1, At, B1); PG8_BAR;
            PG8_LDA(At, 0, 1); PG8_STAGE(PG8_SA(0, 0), a2, voffA);
            PG8_BAR; PG8_WAIT_L(0); PG8_MMA(1, 0, At, B0); PG8_BAR; PG8_SCHED;
            PG8_STAGE(PG8_SB(0, 1), b2 + hstep, voffB);
            PG8_WAIT_V(6); PG8_BAR; PG8_MMA(1, 1, At, B1); PG8_BAR;
            PG8_LDB(B0, 1, 0); PG8_SCHED; PG8_LDA(At, 1, 0); PG8_STAGE(PG8_SA(0, 1), a2 + hstep, voffA);
            PG8_WAIT_L(8); PG8_BAR; PG8_WAIT_L(0); PG8_MMA(0, 0, At, B0); PG8_BAR; PG8_SCHED;
            PG8_LDB(B1, 1, 1); PG8_STAGE(PG8_SB(1, 0), b3, voffB);
            PG8_BAR; PG8_WAIT_L(0); PG8_MMA(0, 1, At, B1); PG8_BAR;
            PG8_LDA(At, 1, 1); PG8_STAGE(PG8_SA(1, 0), a3, voffA);
            PG8_BAR; PG8_WAIT_L(0); PG8_MMA(1, 0, At, B0); PG8_BAR; PG8_SCHED;
            PG8_STAGE(PG8_SB(1, 1), b3 + hstep, voffB);
            PG8_WAIT_V(6); PG8_BAR; PG8_MMA(1, 1, At, B1); PG8_BAR;
            }
        }
        if constexpr (ALIGN_EPI) { if (wr == 0) PG8_BAR; }
        if constexpr (!Epi::AFTER_DRAIN) {
            const int dep_ = __builtin_amdgcn_readfirstlane(__builtin_bit_cast(int, acc[1][1][3][1][3]));
            const int lane_e = (int)__builtin_amdgcn_mbcnt_hi(~0u, __builtin_amdgcn_mbcnt_lo(~0u, (unsigned)dep_)) - dep_;
            if constexpr (Epi::AMAX) {
                float mx_ = 0.f;
#pragma unroll
                for (int a_ = 0; a_ < 2; ++a_)
#pragma unroll
                    for (int b_ = 0; b_ < 2; ++b_)
#pragma unroll
                        for (int m_ = 0; m_ < 4; ++m_) { const f32x4 s0_ = acc[a_][b_][m_][0] * acc[a_][b_][m_][0] + acc[a_][b_][m_][1] * acc[a_][b_][m_][1];
                            float s_ = (s0_[0] + s0_[1]) + (s0_[2] + s0_[3]); s_ += __shfl_xor(s_, 16); s_ += __shfl_xor(s_, 32); mx_ = fmaxf(mx_, s_); }
#pragma unroll
                for (int o_ = 8; o_ >= 1; o_ >>= 1) mx_ = fmaxf(mx_, __shfl_xor(mx_, o_));
                if (lane_e == 0) (void)__hip_atomic_fetch_max(E.amax, __builtin_bit_cast(unsigned, mx_), __ATOMIC_RELAXED, __HIP_MEMORY_SCOPE_AGENT); }
            E(acc, cur, wr, wc, lane_e & 15, lane_e >> 4); S.done(cur); }
        if (!has_next) break;
#pragma unroll
        for (int a = 0; a < 2; ++a)
#pragma unroll
            for (int b = 0; b < 2; ++b)
#pragma unroll
                for (int m = 0; m < 4; ++m)
#pragma unroll
                    for (int n = 0; n < 2; ++n) acc[a][b][m][n] = (f32x4){0.f, 0.f, 0.f, 0.f};
        cur = nxt; cA = nA; cB = nB; ++ui;
#pragma unroll
        for (int hh = 0; hh < 2; ++hh) { vAc[hh][0] = vAn[hh][0]; vAc[hh][1] = vAn[hh][1]; }
        if constexpr (ALIGN_EPI) { if (wr == 1) PG8_BAR; }
    }
    PG8_WAIT_V(0);
    if constexpr (!ALIGN_EPI) { if (wr == 0) PG8_BAR; }
    PG8_BAR;
    if constexpr (Epi::AFTER_DRAIN) { E.fused(acc, cur, wr, wc, fr, fq, lds, wid, lane); S.done(cur); }
#undef PG8_SA
#undef PG8_SB
#undef PG8_STAGE
#undef PG8_STAGE_A
#undef PG8_LDA
#undef PG8_LDB
#undef PG8_MMA
#undef PG8_WAIT_V
#undef PG8_WAIT_L
#undef PG8_BAR
#undef PG8_SCHED
}
}
constexpr int S = 16384, D = 1024, NLAYER = 4, NE = 32;
constexpr float ALPHA_DN = 1.6817928305074292f;
constexpr float LN_EPS = 1e-5f, RMS_EPS = 1e-6f;
constexpr float LOG2E = 1.4426950408889634f;
constexpr int NWAVES = 8, NTHREADS = 512;
constexpr int MOE_MAXTILES = 288, MOE_ROWS = MOE_MAXTILES * 256;
constexpr size_t MiB = 1u << 20;
constexpr size_t WS_CTL = 0, CTL_ZERO_BYTES = 1 * MiB;
constexpr size_t WS_CS64 = 1 * MiB, WS_CS32 = 5 * MiB;
constexpr size_t WS_WDA = 8 * MiB;
constexpr size_t WS_WMLA = 24 * MiB;
constexpr size_t WS_WNSA = 30 * MiB;
constexpr size_t WS_WMOE = 64 * MiB;
constexpr size_t WS_H = 832 * MiB, WS_H1 = 896 * MiB, WS_Y = 960 * MiB;
constexpr size_t WS_XB = 1024 * MiB, WS_X1B = 1056 * MiB, WS_AO = 1088 * MiB;
constexpr size_t WS_QK = 1120 * MiB;
constexpr size_t WS_VT = 1184 * MiB;
constexpr size_t WS_OH = 1216 * MiB;
constexpr size_t WS_MISC = 1280 * MiB;
constexpr size_t WS_KH = WS_MISC + 96 * MiB;
constexpr size_t WS_AS = 1408 * MiB, WS_ACT = 1552 * MiB, WS_YS = 1696 * MiB;
constexpr size_t WS_ROUTE = 1840 * MiB;
constexpr size_t WS_END = 1844 * MiB;
constexpr size_t MLA_C = 0, MLA_CQN = 32 * MiB, MLA_CKVN = 40 * MiB, MLA_KR = 44 * MiB;
constexpr size_t NSA_P = 0, NSA_ACK = 24 * MiB, NSA_ACV = 40 * MiB, NSA_HK = 56 * MiB, NSA_HV = 58 * MiB, NSA_KC = 60 * MiB, NSA_VCT = 61 * MiB, NSA_SEL = 63 * MiB;
constexpr int CW_BAR = 4096, CW_CNT = 16384  , CW_ERR = 20480  , CW_KMAX = 20608  ;
constexpr int RING_BYTES = 131072, LDSCTL_OFF = RING_BYTES, LDS_GIDX_OFF = LDSCTL_OFF + 4096  , LDS_BYTES = 155648;
constexpr int LC_HIST = 16, LC_BASE = 48, LC_SEG = 80  , LC_LCNT = 120, LC_NT = 152, LC_TILEE = 160  , LC_POS = 512  , LC_LAM = 800;

#define GAS __attribute__((address_space(1)))
#define LAS __attribute__((address_space(3)))
typedef unsigned short bf16;
typedef unsigned v4u __attribute__((ext_vector_type(4)));
typedef unsigned v2u __attribute__((ext_vector_type(2)));
typedef float f32x4 __attribute__((ext_vector_type(4)));
typedef float f32x16 __attribute__((ext_vector_type(16)));
typedef float f32x8v __attribute__((ext_vector_type(8)));
typedef float f32x2v __attribute__((ext_vector_type(2)));
__device__ __forceinline__ float sum32pk(const f32x16& a, const f32x16& b) {
    const f32x16 s = a + b;
    const f32x8v s8 = __builtin_shufflevector(s, s, 0, 1, 2, 3, 4, 5, 6, 7) + __builtin_shufflevector(s, s, 8, 9, 10, 11, 12, 13, 14, 15);
    const f32x4 s4 = __builtin_shufflevector(s8, s8, 0, 1, 2, 3) + __builtin_shufflevector(s8, s8, 4, 5, 6, 7);
    const f32x2v s2 = __builtin_shufflevector(s4, s4, 0, 1) + __builtin_shufflevector(s4, s4, 2, 3);
    return s2.x + s2.y;
}
typedef short bf16x8 __attribute__((ext_vector_type(8)));
typedef pg8::cs_t cs_t;
__device__ __forceinline__ unsigned f2bf(float f) { unsigned u = __builtin_bit_cast(unsigned, f); return (u + 0x7fffu + ((u >> 16) & 1u)) >> 16; }
__device__ __forceinline__ unsigned pk2(float lo, float hi) { return pg8::cvt_pk_bf16(lo, hi); }
__device__ __forceinline__ float bf2f(unsigned short b) { return __builtin_bit_cast(float, (unsigned)b << 16); }
__device__ __forceinline__ float bflo(unsigned w) { return __builtin_bit_cast(float, w << 16); }
__device__ __forceinline__ float bfhi(unsigned w) { return __builtin_bit_cast(float, w & 0xffff0000u); }
__device__ __forceinline__ float wave_sum(float v) {
#pragma unroll
    for (int o = 1; o < 64; o <<= 1) v += __shfl_xor(v, o);
    return v;
}
__device__ __forceinline__ float wave_max(float v) {
#pragma unroll
    for (int o = 1; o < 64; o <<= 1) v = fmaxf(v, __shfl_xor(v, o));
    return v;
}
__device__ __forceinline__ float swap32f(float v, int hi) {
    auto rr = __builtin_amdgcn_permlane32_swap(__float_as_uint(v), __float_as_uint(v), false, false);
    return hi ? __uint_as_float(rr[0]) : __uint_as_float(rr[1]);
}

__device__ __forceinline__ float swap16f(float v, int odd) {
    auto rr = __builtin_amdgcn_permlane16_swap(__float_as_uint(v), __float_as_uint(v), false, false);
    return odd ? __uint_as_float(rr[0]) : __uint_as_float(rr[1]);
}

#define XB_TMO      128
#define XB_XCNT(j)  (256  + 64 * (j))
#define XB_XSUB(j)  (1280 + 64 * (j))
#define XB_XGEN(j)  (2304 + 64 * (j))
#define XB_TOP      3328
#define XB_TOPGEN   3392
#define XCD_BAR_WORDS 3456
#define XB_SPIN_CAP (1u << 18)
__device__ __forceinline__ unsigned xb_ld(unsigned* p)              { return __hip_atomic_load(p, __ATOMIC_RELAXED, __HIP_MEMORY_SCOPE_AGENT); }
__device__ __forceinline__ unsigned xb_add(unsigned* p, unsigned v) { return __hip_atomic_fetch_add(p, v, __ATOMIC_RELAXED, __HIP_MEMORY_SCOPE_AGENT); }
__device__ __forceinline__ unsigned xb_xcc_id() { return (unsigned)__builtin_amdgcn_s_getreg((3 << 11) | 20) & 0xFu; }
#define XB_SPIN(cond, bar) do { unsigned _sp = 0; while (cond) { __builtin_amdgcn_s_sleep(1); \
    if ((++_sp & 255u) == 0u) { if (xb_ld(&(bar)[XB_TMO])) break; if (_sp > XB_SPIN_CAP) { atomicAdd(&(bar)[XB_TMO], 1u); break; } } } } while (0)
struct XcdBarrier { unsigned* bar; unsigned x; volatile LAS unsigned* st; };
__device__ __forceinline__ XcdBarrier xcd_barrier_post(unsigned* bar, volatile LAS unsigned* st, int tid0) {
    XcdBarrier b; b.bar = bar; b.x = xb_xcc_id(); b.st = st;
    if (tid0 == 0) (void)xb_add(&bar[XB_XCNT(b.x)], 1u);
    return b;
}
__device__ __forceinline__ void xcd_barrier_complete(unsigned* bar, unsigned x, unsigned& nloc, unsigned& nx) {
    const unsigned G = gridDim.x * gridDim.y * gridDim.z;
    unsigned sum, cnt, mine, sp = 0u;
    for (;;) {
        sum = 0u; cnt = 0u; mine = 0u;
#pragma unroll
        for (unsigned j = 0; j < 16; ++j) { const unsigned c = xb_ld(&bar[XB_XCNT(j)]); sum += c; cnt += (c > 0u) ? 1u : 0u; mine = (j == x) ? c : mine; }
        if (sum == G) break;
        __builtin_amdgcn_s_sleep(1);
        if ((++sp & 255u) == 0u) { if (xb_ld(&bar[XB_TMO])) break; if (sp > XB_SPIN_CAP) { atomicAdd(&bar[XB_TMO], 1u); break; } }
    }
    nloc = mine > 0u ? mine : 1u; nx = cnt > 0u ? cnt : 1u;
}
__device__ __forceinline__ void xcd_barrier(const XcdBarrier& b, int tid0) {
    asm volatile("s_waitcnt vmcnt(0)" ::: "memory");
    __syncthreads();
    if (tid0 == 0) {
        unsigned* bar = b.bar;
        __builtin_amdgcn_s_waitcnt(0);
        unsigned nloc = b.st[0], nx = b.st[1];
        if (nloc == 0u) { xcd_barrier_complete(bar, b.x, nloc, nx); b.st[0] = nloc; b.st[1] = nx; }
        const unsigned old = xb_add(&bar[XB_XSUB(b.x)], 1u);
        const unsigned gen = old / nloc;
        if (old + 1u == (gen + 1u) * nloc) {
            __builtin_amdgcn_fence(__ATOMIC_RELEASE, "agent");
            asm volatile("s_waitcnt vmcnt(0)" ::: "memory");
            const unsigned og = xb_add(&bar[XB_TOP], 1u);
            const unsigned tg = og / nx;
            if (og + 1u == (tg + 1u) * nx) xb_add(&bar[XB_TOPGEN], 1u);
            else XB_SPIN(xb_ld(&bar[XB_TOPGEN]) == tg, bar);
            __builtin_amdgcn_fence(__ATOMIC_ACQUIRE, "agent");
            xb_add(&bar[XB_XGEN(b.x)], 1u);
            asm volatile("s_waitcnt vmcnt(0)" ::: "memory");
        } else {
            XB_SPIN(xb_ld(&bar[XB_XGEN(b.x)]) == gen, bar);
            __builtin_amdgcn_fence(__ATOMIC_ACQUIRE, "agent");
            asm volatile("s_waitcnt vmcnt(0)" ::: "memory");
        }
    }
    __syncthreads();
}

enum CvtMode { CM_IDENT = 0, CM_ROPE64 = 1, CM_MLAQ = 2, CM_MLAKV = 3, CM_NSAIN = 4, CM_SWIGLU = 5 };
struct Job { const float* src; bf16* dst; long long sbs, dbs; int ld, K, ncols, col0, mode, nbatch, item0, pad; };
constexpr int MAXJOBS = 32;
enum { I_X = 0, I_DA_WIN, I_DA_LQ1, I_DA_LK1, I_DA_LQ2, I_DA_LK2, I_DA_SUBLN, I_DA_WOUT, I_MLA_WIN, I_MLA_QN, I_MLA_KVN, I_MLA_WUQ, I_MLA_WUKV, I_MLA_WOUT,
       I_NSA_WIN, I_NSA_POSK, I_NSA_POSV, I_NSA_KW1, I_NSA_KW2, I_NSA_VW1, I_NSA_VW2, I_NSA_WOUT, I_LN1G, I_LN1B, I_LN2G, I_LN2B, I_MOE_WR, I_MOE_BR, I_MOE_WGU, I_MOE_BGU, I_MOE_WDN, I_MOE_BDN, N_IN };
struct Args { const float* in[N_IN]; float* out; unsigned char* ws; Job jobs[MAXJOBS]; int njobs, nitems, ph_lo, ph_hi; };

__device__ __forceinline__ int rope64_row(int hv, int d) { return 256 * (hv >> 2) + 128 * (d >> 5) + 32 * (hv & 3) + (d & 31); }
__device__ __forceinline__ int cvt_dst_row(int mode, int f) {
    switch (mode) {
    case CM_ROPE64: return rope64_row(f >> 6, f & 63);
    case CM_MLAQ: { const int head = f / 96, d = f - head * 96; if (d < 64) return 64 * head + d; const int r = d - 64; return 1024 + 256 * (head >> 3) + 128 * (r >> 4) + 16 * (head & 7) + (r & 15); }
    case CM_MLAKV: { const int head = f >> 7, d = f & 127; return d < 64 ? 64 * head + d : 1024 + 64 * head + (d - 64); }
    case CM_NSAIN: {
        if (f < 1024) return rope64_row(f >> 6, f & 63);
        if (f < 1280) return 1536 + (f - 1024);
        if (f < 1536) return 1792 + (f - 1280);
        if (f < 1792) return rope64_row(16 + ((f - 1536) >> 6), f & 63);
        if (f < 2048) return 2304 + (f - 1792);
        if (f < 2304) return rope64_row(20 + ((f - 2048) >> 6), f & 63);
        if (f < 2560) return 2560 + (f - 2304);
        return 2048 + (f - 2560); }
    case CM_SWIGLU: { const int j = f >> 1; return 256 * (j >> 7) + 128 * (f & 1) + (j & 127); }
    default: return f;
    }
}
__device__ __forceinline__ void cvt_item(const Job& J, int item, LAS unsigned char* scr, int lane) {
    const int nblk = (J.ncols + 63) >> 6, per_b = (J.K >> 6) * nblk;
    const int b = item / per_b, r = item - b * per_b, kb = r / nblk, nb = r - kb * nblk, k0 = 64 * kb, n0 = 64 * nb;
    const int col = n0 + lane; const bool ok = col < J.ncols;
    const float* W = J.src + (size_t)b * J.sbs + (size_t)k0 * J.ld + J.col0 + (ok ? col : 0);
    float v[64];
#pragma unroll
    for (int i = 0; i < 64; ++i) v[i] = __builtin_nontemporal_load(W + (size_t)i * J.ld);
#pragma unroll
    for (int q = 0; q < 8; ++q) { v4u o; o.x = pk2(v[8 * q], v[8 * q + 1]); o.y = pk2(v[8 * q + 2], v[8 * q + 3]); o.z = pk2(v[8 * q + 4], v[8 * q + 5]); o.w = pk2(v[8 * q + 6], v[8 * q + 7]);
        *(LAS v4u*)(scr + lane * 144 + q * 16) = o; }
    asm volatile("s_waitcnt lgkmcnt(0)" ::: "memory");
    bf16* dstb = J.dst + (size_t)b * J.dbs + k0;
#pragma unroll
    for (int s = 0; s < 8; ++s) { const int rl = 8 * s + (lane >> 3), ch = lane & 7;
        const v4u o = *(const LAS v4u*)(scr + rl * 144 + ch * 16);
        if (n0 + rl < J.ncols) __builtin_nontemporal_store(o, (v4u*)(dstb + (size_t)cvt_dst_row(J.mode, n0 + rl) * J.K + ch * 8)); }
    asm volatile("s_waitcnt lgkmcnt(0)" ::: "memory");
}
__device__ __forceinline__ void cvt_item_f8(const Job& J, int item, LAS unsigned char* scr, int lane) {
    const int nblk = (J.ncols + 63) >> 6, per_b = (J.K >> 7) * nblk;
    const int b = item / per_b, r = item - b * per_b, kb = r / nblk, nb = r - kb * nblk, n0 = 64 * nb;
    const bool perm = J.pad == 1;
    const float* W = J.src + (size_t)b * J.sbs + J.col0 + n0 + lane;
#pragma unroll
    for (int h = 0; h < 2; ++h) {
        float v[64];
#pragma unroll
        for (int q = 0; q < 4; ++q)
#pragma unroll
            for (int m = 0; m < 16; ++m) { const int row = perm ? 8 * kb + 4 * h + q + 64 * m : 128 * kb + 64 * h + 16 * q + m; v[16 * q + m] = __builtin_nontemporal_load(W + (size_t)row * J.ld); }
#pragma unroll
        for (int q = 0; q < 4; ++q) { v4u o; int w;
            w = __builtin_amdgcn_cvt_pk_fp8_f32(v[16 * q + 0] * 64.f, v[16 * q + 1] * 64.f, 0, false); w = __builtin_amdgcn_cvt_pk_fp8_f32(v[16 * q + 2] * 64.f, v[16 * q + 3] * 64.f, w, true); o.x = (unsigned)w;
            w = __builtin_amdgcn_cvt_pk_fp8_f32(v[16 * q + 4] * 64.f, v[16 * q + 5] * 64.f, 0, false); w = __builtin_amdgcn_cvt_pk_fp8_f32(v[16 * q + 6] * 64.f, v[16 * q + 7] * 64.f, w, true); o.y = (unsigned)w;
            w = __builtin_amdgcn_cvt_pk_fp8_f32(v[16 * q + 8] * 64.f, v[16 * q + 9] * 64.f, 0, false); w = __builtin_amdgcn_cvt_pk_fp8_f32(v[16 * q + 10] * 64.f, v[16 * q + 11] * 64.f, w, true); o.z = (unsigned)w;
            w = __builtin_amdgcn_cvt_pk_fp8_f32(v[16 * q + 12] * 64.f, v[16 * q + 13] * 64.f, 0, false); w = __builtin_amdgcn_cvt_pk_fp8_f32(v[16 * q + 14] * 64.f, v[16 * q + 15] * 64.f, w, true); o.w = (unsigned)w;
            *(LAS v4u*)(scr + lane * 144 + (4 * h + q) * 16) = o; }
    }
    asm volatile("s_waitcnt lgkmcnt(0)" ::: "memory");
    unsigned char* dstb = (unsigned char*)J.dst + (size_t)b * J.dbs + 128 * kb;
#pragma unroll
    for (int s = 0; s < 8; ++s) { const int rl = 8 * s + (lane >> 3), ch = lane & 7;
        const v4u o = *(const LAS v4u*)(scr + rl * 144 + ch * 16);
        __builtin_nontemporal_store(o, (v4u*)(dstb + (size_t)cvt_dst_row(J.mode, n0 + rl) * J.K + ch * 16)); }
    asm volatile("s_waitcnt lgkmcnt(0)" ::: "memory");
}
__device__ __forceinline__ unsigned lds_inc(LAS unsigned* p) { return __hip_atomic_fetch_add(p, 1u, __ATOMIC_RELAXED, __HIP_MEMORY_SCOPE_WORKGROUP); }
#define WSP(T, off) ((T*)(a.ws + (off)))
__device__ __forceinline__ void zero_rows(bf16* dst, int K, int r0, int r1, int gtid, int gthreads) {
    v4u* p = (v4u*)(dst + (size_t)r0 * K); const int n = (r1 - r0) * K / 8;
    for (int i = gtid; i < n; i += gthreads) p[i] = (v4u){0u, 0u, 0u, 0u};
}
__device__ __forceinline__ void phase_prologue(const Args& a, LAS unsigned char* lds, int tid, int lane, int wave) {
    const int gw = blockIdx.x * NWAVES + wave, NGW = gridDim.x * NWAVES;
    const int gtid = blockIdx.x * NTHREADS + tid, GT = gridDim.x * NTHREADS;
    LAS unsigned char* scr = lds + wave * 9216;
    for (int it = gw; it < a.nitems; it += NGW) {
        int j = 0;
        for (int q = 1; q < a.njobs; ++q) if (it >= a.jobs[q].item0) j = q;
        j = __builtin_amdgcn_readfirstlane(j);
        if (a.jobs[j].pad) cvt_item_f8(a.jobs[j], it - a.jobs[j].item0, scr, lane); else cvt_item(a.jobs[j], it - a.jobs[j].item0, scr, lane);
    }
    zero_rows(WSP(bf16, WS_WMLA), 1024, 416, 512, gtid, GT);
    zero_rows(WSP(bf16, WS_WNSA), 1024, 2096, 2304, gtid, GT);
    zero_rows(WSP(bf16, WS_WNSA + 8 * MiB), 256, 32, 128, gtid, GT);
    zero_rows(WSP(bf16, WS_WNSA + 8 * MiB), 256, 160, 256, gtid, GT);
    zero_rows(WSP(bf16, WS_WNSA + 8 * MiB + 131072), 256, 64, 256, gtid, GT);
    cs_t* cs64 = WSP(cs_t, WS_CS64); cs_t* cs32 = WSP(cs_t, WS_CS32);
    for (int i = gtid; i < S * 48; i += GT) {
        int pos, fi; float inv; cs_t* dst;
        if (i < S * 32) { pos = i >> 5; fi = i & 31; inv = exp2f(-(float)fi * (13.287712379549449f / 32.0f)); dst = cs64 + i; }
        else { const int k = i - S * 32; pos = k >> 4; fi = k & 15; inv = exp2f(-(float)fi * (13.287712379549449f / 16.0f)); dst = cs32 + k; }
        const float ang = (float)pos * inv;
        const double t = (double)ang * 0.15915494309189535; const double fr = t - __builtin_rint(t);
        cs_t o; o.c = __builtin_amdgcn_cosf((float)fr); o.s = __builtin_amdgcn_sinf((float)fr); *dst = o;
    }
    const f32x4* x4 = (const f32x4*)a.in[I_X]; v2u* xb = WSP(v2u, WS_XB);
    for (int i = gtid; i < S * D / 4; i += GT) { const f32x4 v = x4[i]; v2u o; o.x = pk2(v[0], v[1]); o.y = pk2(v[2], v[3]); xb[i] = o; }
}

__device__ __forceinline__ void phase_ln1_router(const Args& a, LAS unsigned char* lds, int layer, int tid, int lane, int wave) {
    const float* wr = a.in[I_MOE_WR] + (size_t)layer * 1024 * 32;
    LAS float* wl = (LAS float*)lds;
    for (int i = tid; i < 8192; i += NTHREADS) { const f32x4 v = ((const f32x4*)wr)[i]; const int k = i >> 3, ch = i & 7, R = (k & 15) * 64 + (k >> 4), pch = ch ^ ((R >> 1) & 7); *(LAS f32x4*)(wl + R * 32 + pch * 4) = v; }
    LAS unsigned* lc = (LAS unsigned*)(lds + LDSCTL_OFF);
    if (tid < 32) lc[LC_HIST + tid] = 0u;
    __syncthreads();
    const float* gn = a.in[I_LN1G] + layer * 1024; const float* bn = a.in[I_LN1B] + layer * 1024; const float* br = a.in[I_MOE_BR] + layer * 32;
    const bf16* Y = WSP(bf16, WS_Y); const bf16* XBr = WSP(bf16, WS_XB); bf16* X1B = WSP(bf16, WS_X1B);
    int* top_e = WSP(int, WS_ROUTE); float* gate = WSP(float, WS_ROUTE + 262144);
    const int sw = (lane >> 1) & 7;
    for (int i = 0; i < 8; ++i) {
        const int t = blockIdx.x * 64 + wave * 8 + i;
        float v[16]; float s = 0.f;
        { const v4u* hp = (const v4u*)(XBr + (size_t)t * 1024 + 16 * lane); const v4u* yp = (const v4u*)(Y + (size_t)t * 1024 + 16 * lane);
          const v4u h0 = hp[0], h1 = hp[1], y0 = yp[0], y1 = yp[1];
          const unsigned hw[8] = {h0.x, h0.y, h0.z, h0.w, h1.x, h1.y, h1.z, h1.w}, yw[8] = {y0.x, y0.y, y0.z, y0.w, y1.x, y1.y, y1.z, y1.w};
#pragma unroll
          for (int q = 0; q < 8; ++q) { v[2 * q] = ALPHA_DN * bflo(hw[q]) + bflo(yw[q]); v[2 * q + 1] = ALPHA_DN * bfhi(hw[q]) + bfhi(yw[q]); s += v[2 * q] + v[2 * q + 1]; } }
        const float mean = wave_sum(s) * (1.0f / 1024.0f); float s2 = 0.f;
#pragma unroll
        for (int m = 0; m < 16; ++m) { v[m] -= mean; s2 += v[m] * v[m]; }
        const float rstd = 1.0f / sqrtf(wave_sum(s2) * (1.0f / 1024.0f) + LN_EPS);
        { const f32x4* g4 = (const f32x4*)(gn + 16 * lane); const f32x4* b4 = (const f32x4*)(bn + 16 * lane);
#pragma unroll
          for (int q = 0; q < 4; ++q) { const f32x4 gg = g4[q], bb = b4[q];
#pragma unroll
              for (int e = 0; e < 4; ++e) v[4 * q + e] = v[4 * q + e] * rstd * gg[e] + bb[e]; }
          v4u o0, o1; o0.x = pk2(v[0], v[1]); o0.y = pk2(v[2], v[3]); o0.z = pk2(v[4], v[5]); o0.w = pk2(v[6], v[7]); o1.x = pk2(v[8], v[9]); o1.y = pk2(v[10], v[11]); o1.z = pk2(v[12], v[13]); o1.w = pk2(v[14], v[15]);
          v4u* xp = (v4u*)(X1B + (size_t)t * 1024 + 16 * lane); xp[0] = o0; xp[1] = o1; }
        {
            v4u o; int w;
            w = __builtin_amdgcn_cvt_pk_fp8_f32(v[0], v[1], 0, false); w = __builtin_amdgcn_cvt_pk_fp8_f32(v[2], v[3], w, true); o.x = (unsigned)w;
            w = __builtin_amdgcn_cvt_pk_fp8_f32(v[4], v[5], 0, false); w = __builtin_amdgcn_cvt_pk_fp8_f32(v[6], v[7], w, true); o.y = (unsigned)w;
            w = __builtin_amdgcn_cvt_pk_fp8_f32(v[8], v[9], 0, false); w = __builtin_amdgcn_cvt_pk_fp8_f32(v[10], v[11], w, true); o.z = (unsigned)w;
            w = __builtin_amdgcn_cvt_pk_fp8_f32(v[12], v[13], 0, false); w = __builtin_amdgcn_cvt_pk_fp8_f32(v[14], v[15], w, true); o.w = (unsigned)w;
            *(v4u*)(WSP(unsigned char, WS_AS) + (size_t)t * 1024 + lane * 16) = o; }
        float acc[32];
#pragma unroll
        for (int e = 0; e < 32; ++e) acc[e] = 0.f;
#pragma unroll
        for (int m = 0; m < 16; ++m) { const LAS float* wrow = wl + (lane + 64 * m) * 32;
#pragma unroll
            for (int ch = 0; ch < 8; ++ch) { const f32x4 w = *(const LAS f32x4*)(wrow + ((ch ^ sw) << 2));
                acc[4 * ch + 0] += v[m] * w[0]; acc[4 * ch + 1] += v[m] * w[1]; acc[4 * ch + 2] += v[m] * w[2]; acc[4 * ch + 3] += v[m] * w[3]; } }
        float a16[16], a8[8], a4[4], a2[2];
        { const bool b = (lane & 32) != 0;
#pragma unroll
          for (int q = 0; q < 16; ++q) { const float send = b ? acc[q] : acc[q + 16], keep = b ? acc[q + 16] : acc[q]; a16[q] = keep + __shfl_xor(send, 32); } }
        { const bool b = (lane & 16) != 0;
#pragma unroll
          for (int q = 0; q < 8; ++q) { const float send = b ? a16[q] : a16[q + 8], keep = b ? a16[q + 8] : a16[q]; a8[q] = keep + __shfl_xor(send, 16); } }
        { const bool b = (lane & 8) != 0;
#pragma unroll
          for (int q = 0; q < 4; ++q) { const float send = b ? a8[q] : a8[q + 4], keep = b ? a8[q + 4] : a8[q]; a4[q] = keep + __shfl_xor(send, 8); } }
        { const bool b = (lane & 4) != 0;
#pragma unroll
          for (int q = 0; q < 2; ++q) { const float send = b ? a4[q] : a4[q + 2], keep = b ? a4[q + 2] : a4[q]; a2[q] = keep + __shfl_xor(send, 4); } }
        float lg;
        { const bool b = (lane & 2) != 0; const float send = b ? a2[0] : a2[1], keep = b ? a2[1] : a2[0]; lg = keep + __shfl_xor(send, 2); }
        lg += __shfl_xor(lg, 1);
        lg += br[lane >> 1];
        float tv[4]; int te[4];
#pragma unroll
        for (int r = 0; r < 4; ++r) {
            const float mx = wave_max(lg);
            const unsigned long long bal = __ballot(lg == mx);
            const int sl = __ffsll((long long)bal) - 1; const int e = sl >> 1;
            tv[r] = mx; te[r] = e;
            if ((lane >> 1) == e) lg = -INFINITY;
        }
        if (lane == 0) {
            const float e1 = __expf(tv[1] - tv[0]), e2 = __expf(tv[2] - tv[0]), e3 = __expf(tv[3] - tv[0]); const float inv = 1.0f / (1.0f + e1 + e2 + e3);
            *(int4*)(top_e + (size_t)t * 4) = make_int4(te[0], te[1], te[2], te[3]);
            *(float4*)(gate + (size_t)t * 4) = make_float4(inv, e1 * inv, e2 * inv, e3 * inv);
            lds_inc(lc + LC_HIST + te[0]); lds_inc(lc + LC_HIST + te[1]); lds_inc(lc + LC_HIST + te[2]); lds_inc(lc + LC_HIST + te[3]);
        }
    }
    __syncthreads();
    if (tid < 32) { unsigned* cnt = WSP(unsigned, WS_CTL) + CW_CNT + layer * 32; const unsigned h = lc[LC_HIST + tid]; lc[LC_BASE + tid] = xb_add(cnt + tid, h); }
    __syncthreads();
}

__device__ __forceinline__ void phase_place(const Args& a, LAS unsigned char* lds, int layer, int tid, int lane, int wave) {
    LAS unsigned* lc = (LAS unsigned*)(lds + LDSCTL_OFF);
    unsigned* cnt = WSP(unsigned, WS_CTL) + CW_CNT + layer * 32;
    if (tid < 64) {
        const unsigned c = (lane < 32) ? xb_ld(cnt + lane) : 0u; const unsigned nt = (c + 255u) >> 8;
        unsigned inc = nt;
#pragma unroll
        for (int o = 1; o < 32; o <<= 1) { const unsigned up = __shfl_up(inc, o); if (lane >= o) inc += up; }
        const unsigned ts = inc - nt;
        if (lane < 32) { lc[LC_SEG + lane] = ts * 256u; for (unsigned q = 0; q < nt; ++q) lc[LC_TILEE + ts + q] = (unsigned)lane | ((c - 256u * q <= 128u) ? 256u : 0u); }
        if (lane == 31) lc[LC_NT] = inc;
    }
    if (tid >= 64 && tid < 96) lc[LC_LCNT + tid - 64] = 0u;
    __syncthreads();
    const int* top_e = WSP(int, WS_ROUTE); const float* gate = WSP(float, WS_ROUTE + 262144); int* tokpos = WSP(int, WS_ROUTE + 524288); float* rgate = WSP(float, WS_ROUTE + 786432);
    if (tid < 256) { const int t = blockIdx.x * 64 + (tid >> 2); const int e = top_e[(size_t)t * 4 + (tid & 3)];
        const unsigned rank = lds_inc(lc + LC_LCNT + e); const unsigned pos = lc[LC_SEG + e] + lc[LC_BASE + e] + rank;
        rgate[pos] = gate[(size_t)t * 4 + (tid & 3)]; tokpos[(size_t)t * 4 + (tid & 3)] = (int)pos; WSP(unsigned short, WS_ROUTE + 2 * MiB)[pos] = (unsigned short)t; }
    __syncthreads();
    if (blockIdx.x < 32) { const int e = blockIdx.x; const unsigned c = xb_ld(cnt + e), seg = lc[LC_SEG + e], pad = ((c + 255u) & ~255u) - c;
        unsigned short* rt = WSP(unsigned short, WS_ROUTE + 2 * MiB) + seg + c;
        for (unsigned q = tid; q < pad; q += NTHREADS) rt[q] = 0; }
    __syncthreads();
}

__device__ __forceinline__ void phase_ln2(const Args& a, int layer, float* fout, int tid, int lane, int wave) {
    const float* gn = a.in[I_LN2G] + layer * 1024; const float* bn = a.in[I_LN2B] + layer * 1024;
    const bf16* X1B = WSP(bf16, WS_X1B); const bf16* Ys = WSP(bf16, WS_YS); const int* tokpos = WSP(int, WS_ROUTE + 524288); bf16* XB = WSP(bf16, WS_XB);
    for (int i = 0; i < 8; ++i) {
        const int t = blockIdx.x * 64 + wave * 8 + i;
        const int4 pp = *(const int4*)(tokpos + (size_t)t * 4);
        f32x4 v[4]; float s = 0.f;
#pragma unroll
        for (int j = 0; j < 4; ++j) { const int k = 256 * j + 4 * lane; const v2u hw = *(const v2u*)(X1B + (size_t)t * 1024 + k);
            f32x4 h = (f32x4){bflo(hw.x), bfhi(hw.x), bflo(hw.y), bfhi(hw.y)} * ALPHA_DN;
            const unsigned char* Y8 = (const unsigned char*)Ys;
            const int w0 = *(const int*)(Y8 + (size_t)pp.x * 1024 + k), w1 = *(const int*)(Y8 + (size_t)pp.y * 1024 + k), w2 = *(const int*)(Y8 + (size_t)pp.z * 1024 + k), w3 = *(const int*)(Y8 + (size_t)pp.w * 1024 + k);
            const f32x2v a0 = __builtin_amdgcn_cvt_pk_f32_fp8(w0, false), a1 = __builtin_amdgcn_cvt_pk_f32_fp8(w1, false), a2 = __builtin_amdgcn_cvt_pk_f32_fp8(w2, false), a3 = __builtin_amdgcn_cvt_pk_f32_fp8(w3, false);
            const f32x2v c0 = __builtin_amdgcn_cvt_pk_f32_fp8(w0, true), c1 = __builtin_amdgcn_cvt_pk_f32_fp8(w1, true), c2 = __builtin_amdgcn_cvt_pk_f32_fp8(w2, true), c3 = __builtin_amdgcn_cvt_pk_f32_fp8(w3, true);
            h[0] += ((a0.x + a1.x) + (a2.x + a3.x)) * 0.0625f; h[1] += ((a0.y + a1.y) + (a2.y + a3.y)) * 0.0625f;
            h[2] += ((c0.x + c1.x) + (c2.x + c3.x)) * 0.0625f; h[3] += ((c0.y + c1.y) + (c2.y + c3.y)) * 0.0625f;
            v[j] = h; s += (h[0] + h[1]) + (h[2] + h[3]); }
        const float mean = wave_sum(s) * (1.0f / 1024.0f); float s2 = 0.f;
#pragma unroll
        for (int j = 0; j < 4; ++j) { v[j] = v[j] - mean; s2 += (v[j][0] * v[j][0] + v[j][1] * v[j][1]) + (v[j][2] * v[j][2] + v[j][3] * v[j][3]); }
        const float rstd = 1.0f / sqrtf(wave_sum(s2) * (1.0f / 1024.0f) + LN_EPS);
#pragma unroll
        for (int j = 0; j < 4; ++j) { const int k = 256 * j + 4 * lane; const f32x4 g4 = *(const f32x4*)(gn + k), b4 = *(const f32x4*)(bn + k);
            const f32x4 o = v[j] * rstd * g4 + b4;
            if (fout) *(f32x4*)(fout + (size_t)t * 1024 + k) = o;
            else { v2u w; w.x = pk2(o[0], o[1]); w.y = pk2(o[2], o[3]); *(v2u*)(XB + (size_t)t * 1024 + k) = w; } }
    }
}

__device__ __forceinline__ float da_lambda(const Args& a, int j, float lam_init, int lane) {
    const float q1 = a.in[I_DA_LQ1][j * 64 + lane], k1 = a.in[I_DA_LK1][j * 64 + lane], q2 = a.in[I_DA_LQ2][j * 64 + lane], k2 = a.in[I_DA_LK2][j * 64 + lane];
    return __expf(wave_sum(q1 * k1)) - __expf(wave_sum(q2 * k2)) + lam_init;
}
__device__ __forceinline__ void phase_mla_norm(const Args& a, int tid, int lane, int wave) {
    const float* C = WSP(float, WS_MISC + MLA_C); bf16* cqn = WSP(bf16, WS_MISC + MLA_CQN); bf16* ckvn = WSP(bf16, WS_MISC + MLA_CKVN); bf16* Kr = WSP(bf16, WS_MISC + MLA_KR);
    const cs_t* cs32 = WSP(cs_t, WS_CS32);
    const f32x4 gq = *(const f32x4*)(a.in[I_MLA_QN] + 4 * lane); const float gk0 = a.in[I_MLA_KVN][2 * lane], gk1 = a.in[I_MLA_KVN][2 * lane + 1];
    const int gw = blockIdx.x * NWAVES + wave, NGW = gridDim.x * NWAVES;
    for (int t = gw; t < S; t += NGW) {
        const float* row = C + (size_t)t * 512;
        const f32x4 q = *(const f32x4*)(row + 4 * lane);
        const float rq = 1.0f / sqrtf(wave_sum((q[0] * q[0] + q[1] * q[1]) + (q[2] * q[2] + q[3] * q[3])) * (1.0f / 256.0f) + RMS_EPS);
        v2u w; w.x = pk2(q[0] * rq * gq[0], q[1] * rq * gq[1]); w.y = pk2(q[2] * rq * gq[2], q[3] * rq * gq[3]); *(v2u*)(cqn + (size_t)t * 256 + 4 * lane) = w;
        const float k0 = row[256 + 2 * lane], k1 = row[256 + 2 * lane + 1];
        const float rk = 1.0f / sqrtf(wave_sum(k0 * k0 + k1 * k1) * (1.0f / 128.0f) + RMS_EPS);
        *(unsigned*)(ckvn + (size_t)t * 128 + 2 * lane) = pk2(k0 * rk * gk0, k1 * rk * gk1);
        if (lane < 16) { const float x1 = row[384 + lane], x2 = row[400 + lane]; const cs_t cs = cs32[(size_t)t * 16 + lane];
            Kr[(size_t)t * 32 + lane] = (bf16)f2bf(x1 * cs.c - x2 * cs.s); Kr[(size_t)t * 32 + 16 + lane] = (bf16)f2bf(x2 * cs.c + x1 * cs.s); }
    }
}

__device__ __forceinline__ void phase_nsa_cmp_gather(const Args& a, int tid) {
    const bf16* P = WSP(bf16, WS_MISC + NSA_P);
    const int gtid = blockIdx.x * NTHREADS + tid, GT = gridDim.x * NTHREADS;
    for (int id = gtid; id < 2 * 4096 * 256; id += GT) {
        const int c8 = id & 7, l = (id >> 3) & 31, n = (id >> 8) & 1023, g = (id >> 18) & 3, kv = id >> 20;
        bf16* dst = WSP(bf16, WS_MISC + (kv ? NSA_ACV : NSA_ACK)) + ((size_t)(g * 1024 + n) * 2048 + l * 64 + c8 * 8);
        v4u o = (v4u){0u, 0u, 0u, 0u};
        if (n < 1023) {
            const v4u x = *(const v4u*)(P + (size_t)(16 * n + l) * 768 + kv * 256 + g * 64 + c8 * 8);
            const float* pp = a.in[kv ? I_NSA_POSV : I_NSA_POSK] + l * 64 + c8 * 8;
            const f32x4 p0 = *(const f32x4*)pp, p1 = *(const f32x4*)(pp + 4);
            o.x = pk2(bflo(x.x) + p0[0], bfhi(x.x) + p0[1]); o.y = pk2(bflo(x.y) + p0[2], bfhi(x.y) + p0[3]);
            o.z = pk2(bflo(x.z) + p1[0], bfhi(x.z) + p1[1]); o.w = pk2(bflo(x.w) + p1[2], bfhi(x.w) + p1[3]);
        }
        *(v4u*)dst = o;
    }
}

struct BgConv {
    const Job* jb; LAS unsigned char* scr; int it, it_end, stride, lane, period, tick, sub; bool pending; float v[16];
    __device__ __forceinline__ void init(const Job* jb_, int nlayers, int first, int stride_, int lane_, int period_, LAS unsigned char* scr_) { jb = jb_; it = first; it_end = 12288 * nlayers; stride = stride_; lane = lane_; pending = false; period = period_; tick = 0; scr = scr_; sub = 0; }
    __device__ __forceinline__ int decode(const Job*& J, int& b, int& kb, int& nb) const {
        const int li = it / 12288, loc = it - li * 12288;
        if (loc < 8192) { J = jb + 2 * li; b = loc >> 8; const int r = loc & 255; kb = r >> 5; nb = r & 31; return 2; }
        const int i2 = loc - 8192; J = jb + 2 * li + 1; b = i2 >> 7; const int r = i2 & 127; kb = r >> 4; nb = r & 15; return 2; }
    __device__ __forceinline__ void issue() {
        if (it >= it_end) return;
        const Job* J; int b, kb, nb; const int f8 = decode(J, b, kb, nb);
        const float* W = J->src + (size_t)b * J->sbs + (size_t)(f8 == 1 ? 8 * kb + sub : 128 * kb + 16 * sub) * J->ld + 64 * nb + lane;
        const size_t rstep = (size_t)(f8 == 1 ? 64 : 1) * J->ld;
#pragma unroll
        for (int i = 0; i < 16; ++i) v[i] = __builtin_nontemporal_load(W + (size_t)i * rstep);
        pending = true; }
    __device__ __forceinline__ void retire() {
        if (!pending) return;
        const Job* J; int b, kb, nb; const bool f8 = decode(J, b, kb, nb) != 0;
        if (f8) { v4u o; int w;
            w = __builtin_amdgcn_cvt_pk_fp8_f32(v[0] * 64.f, v[1] * 64.f, 0, false); w = __builtin_amdgcn_cvt_pk_fp8_f32(v[2] * 64.f, v[3] * 64.f, w, true); o.x = (unsigned)w;
            w = __builtin_amdgcn_cvt_pk_fp8_f32(v[4] * 64.f, v[5] * 64.f, 0, false); w = __builtin_amdgcn_cvt_pk_fp8_f32(v[6] * 64.f, v[7] * 64.f, w, true); o.y = (unsigned)w;
            w = __builtin_amdgcn_cvt_pk_fp8_f32(v[8] * 64.f, v[9] * 64.f, 0, false); w = __builtin_amdgcn_cvt_pk_fp8_f32(v[10] * 64.f, v[11] * 64.f, w, true); o.z = (unsigned)w;
            w = __builtin_amdgcn_cvt_pk_fp8_f32(v[12] * 64.f, v[13] * 64.f, 0, false); w = __builtin_amdgcn_cvt_pk_fp8_f32(v[14] * 64.f, v[15] * 64.f, w, true); o.w = (unsigned)w;
            *(LAS v4u*)(scr + lane * 144 + sub * 16) = o;
        } else {
#pragma unroll
        for (int q = 0; q < 2; ++q) { v4u o; o.x = pk2(v[8 * q], v[8 * q + 1]); o.y = pk2(v[8 * q + 2], v[8 * q + 3]); o.z = pk2(v[8 * q + 4], v[8 * q + 5]); o.w = pk2(v[8 * q + 6], v[8 * q + 7]);
            *(LAS v4u*)(scr + lane * 144 + (2 * sub + q) * 16) = o; }
        }
        pending = false;
        if (sub < (f8 ? 7 : 3)) { ++sub; return; }
        asm volatile("s_waitcnt lgkmcnt(0)" ::: "memory");
        unsigned char* dstb = (unsigned char*)J->dst + (f8 ? (size_t)b * J->dbs + 128 * kb : ((size_t)b * J->dbs + 64 * kb) * 2);
        const size_t pitch = f8 ? (size_t)J->K : (size_t)J->K * 2;
        const int ln = (int)__builtin_amdgcn_mbcnt_hi(~0u, __builtin_amdgcn_mbcnt_lo(~0u, (unsigned)it)) - it;
#pragma unroll
        for (int s = 0; s < 8; ++s) { const int rl = 8 * s + (ln >> 3), ch = ln & 7;
            const v4u o = *(const LAS v4u*)(scr + rl * 144 + ch * 16);
            __builtin_nontemporal_store(o, (v4u*)(dstb + (size_t)cvt_dst_row(J->mode, 64 * nb + rl) * pitch + ch * 16)); }
        asm volatile("s_waitcnt lgkmcnt(0)" ::: "memory");
        sub = 0; it += stride; }
    __device__ __forceinline__ void begin() { if (++tick < period) return; tick = 0; issue(); }
    __device__ __forceinline__ void end() { if (tick == period - 1) retire(); }
    __device__ __forceinline__ void drain() { for (;;) { retire(); issue(); if (!pending) break; } }
};
struct BgNone { __device__ __forceinline__ void begin() {} __device__ __forceinline__ void end() {} };

#define MFMA32(A, B, C) __builtin_amdgcn_mfma_f32_32x32x16_bf16((A), (B), (C), 0, 0, 0)
#define MFMA16(A, B, C) __builtin_amdgcn_mfma_f32_16x16x32_bf16((A), (B), (C), 0, 0, 0)
__device__ __forceinline__ bf16x8 pack8(float a0, float a1, float a2, float a3, float a4, float a5, float a6, float a7) {
    v4u w; w.x = pk2(a0, a1); w.y = pk2(a2, a3); w.z = pk2(a4, a5); w.w = pk2(a6, a7); return __builtin_bit_cast(bf16x8, w);
}
__device__ __forceinline__ int pi32(int r) { return (r & ~12) | ((r & 4) << 1) | ((r & 8) >> 1); }
__device__ __forceinline__ float max3f(float a, float b, float c) { return __builtin_fmaxf(__builtin_fmaxf(a, b), c); }
__device__ __forceinline__ float max16(const f32x16& p) {
    const float a = max3f(p[0], p[1], p[2]), b = max3f(p[3], p[4], p[5]), c = max3f(p[6], p[7], p[8]), d = max3f(p[9], p[10], p[11]), e = max3f(p[12], p[13], p[14]);
    return max3f(max3f(a, b, c), max3f(d, e, p[15]), d);
}
struct AttnArgs {
    const bf16* Q0; const bf16* Q1; int ldq;
    const bf16* K0; int ldk0; const bf16* K1; int ldk1;
    const bf16* Vt; int ldv;
    bf16* O; int ldo;
    int window;
    const bf16* Qb; const bf16* Kb;
    float lam; const float* gain; float gscale;
    float kbound;
};
template <bool B> struct BoolC { static constexpr bool value = B; };
template <int DQK, int DV, bool PAIR = false, class BG = BgNone>
__device__ __forceinline__ void attn_unit(LAS unsigned char* lds, const AttnArgs& A, int q0, int tid_in, int lane_in, int wave, BG& bg) {
    const int lane = (int)__builtin_amdgcn_mbcnt_hi(~0u, __builtin_amdgcn_mbcnt_lo(~0u, (unsigned)q0)) - q0; const int tid = wave * 64 + lane; (void)tid_in; (void)lane_in;
    constexpr int KSB = (DQK + 8) * 2, VSB = 144, KBUF = 64 * KSB, BUFB = KBUF + DV * VSB;
    constexpr int NKS = DQK / 16, ND0 = DV / 32, KCH = DQK / 8;
    const int r32 = lane & 31, hi = lane >> 5;
    const int qw0 = q0 + 32 * wave, qrow = qw0 + r32;
    const int W = A.window;
    const int t_hi = (q0 >> 6) + 4;
    int t_lo = 0; if (W > 0) { const int lo = q0 - W + 1; t_lo = lo > 0 ? (lo >> 6) : 0; }
    constexpr int OA_OFF = 2 * BUFB, OA_ROWB = DV * 2 + 16;
    const bf16* Qp = A.Q0; const bf16* Kp = A.K0;
    bf16x8 qf[NKS];
    f32x16 o[ND0];
    float lsum = 0.f;
    constexpr int NKI = (64 * KCH + 511) / 512, NVI = DV * 8 / 512;
    v4u kA[NKI], vA[NVI];
    auto gload = [&](int t, v4u (&kreg)[NKI], v4u (&vreg)[NVI]) {
        const __amdgpu_buffer_rsrc_t rk0 = __builtin_amdgcn_make_buffer_rsrc((void*)Kp, 0, 0x7fffffff, 0x00020000);
        const __amdgpu_buffer_rsrc_t rk1 = __builtin_amdgcn_make_buffer_rsrc((void*)(KCH > 8 ? A.K1 : Kp), 0, 0x7fffffff, 0x00020000);
        const __amdgpu_buffer_rsrc_t rvt = __builtin_amdgcn_make_buffer_rsrc((void*)A.Vt, 0, 0x7fffffff, 0x00020000);
        const int k0s = t * 64 * A.ldk0 * 2, k1s = t * 64 * A.ldk1 * 2, vs = t * DV * 128;
#pragma unroll
        for (int i = 0; i < NKI; ++i) { const int c = tid + 512 * i;
            if ((64 * KCH) % 512 == 0 || c < 64 * KCH) { const int row = c / KCH, ch = c - row * KCH;
                if constexpr (KCH > 8) { kreg[i] = (ch < 8) ? __builtin_bit_cast(v4u, __builtin_amdgcn_raw_buffer_load_b128(rk0, (row * A.ldk0 + ch * 8) * 2, k0s, 0))
                                                            : __builtin_bit_cast(v4u, __builtin_amdgcn_raw_buffer_load_b128(rk1, (row * A.ldk1 + (ch - 8) * 8) * 2, k1s, 0)); }
                else kreg[i] = __builtin_bit_cast(v4u, __builtin_amdgcn_raw_buffer_load_b128(rk0, (row * A.ldk0 + ch * 8) * 2, k0s, 0)); } }
#pragma unroll
        for (int i = 0; i < NVI; ++i) { const int c = tid + 512 * i; vreg[i] = __builtin_bit_cast(v4u, __builtin_amdgcn_raw_buffer_load_b128(rvt, c * 16, vs, 0)); }
    };
    auto sstore = [&](int stage, const v4u (&kreg)[NKI], const v4u (&vreg)[NVI]) {
        LAS unsigned char* Kb = lds + stage * BUFB; LAS unsigned char* Vb = Kb + KBUF;
#pragma unroll
        for (int i = 0; i < NKI; ++i) { const int c = tid + 512 * i;
            if ((64 * KCH) % 512 == 0 || c < 64 * KCH) { const int row = c / KCH, ch = c - row * KCH; *(LAS v4u*)(Kb + row * KSB + ch * 16) = kreg[i]; } }
#pragma unroll
        for (int i = 0; i < NVI; ++i) { const int c = tid + 512 * i; const int row = c >> 3, ch = c & 7; *(LAS v4u*)(Vb + row * VSB + ch * 16) = vreg[i]; }
    };
    const int pr = pi32(r32);
    float mhat = 0.f;
    auto compute = [&](int t, int stage, auto ft) {
        constexpr bool FAST = decltype(ft)::value;
        const int kv0 = t * 64;
        const bool skip = (kv0 > qw0 + 31) || (W > 0 && kv0 + 63 <= qw0 - W);
        if (!skip) {
            const LAS unsigned char* Kb = lds + stage * BUFB; const LAS unsigned char* Vb = Kb + KBUF;
            f32x16 p0, p1;
#pragma unroll
            for (int r = 0; r < 16; ++r) { p0[r] = FAST ? 0.f : -mhat; p1[r] = FAST ? 0.f : -mhat; }
            bf16x8 kfr[2 * NKS];
#pragma unroll
            for (int ks = 0; ks < NKS; ++ks) { kfr[2 * ks] = *(const LAS bf16x8*)(Kb + pr * KSB + ks * 32 + hi * 16); kfr[2 * ks + 1] = *(const LAS bf16x8*)(Kb + (32 + pr) * KSB + ks * 32 + hi * 16); }
            asm volatile("s_waitcnt lgkmcnt(0)" ::: "memory");
            bf16x8 vfr[4 * ND0];
#pragma unroll
            for (int d = 0; d < ND0 / 2; ++d)
#pragma unroll
                for (int hf = 0; hf < 2; ++hf)
#pragma unroll
                    for (int jj = 0; jj < 2; ++jj) vfr[4 * d + 2 * hf + jj] = *(const LAS bf16x8*)(Vb + (32 * d + r32) * VSB + (32 * hf + 16 * jj + 8 * hi) * 2);
            __builtin_amdgcn_sched_barrier(0);
#pragma unroll
            for (int ks = 0; ks < NKS; ++ks) { p0 = MFMA32(kfr[2 * ks], qf[ks], p0); p1 = MFMA32(kfr[2 * ks + 1], qf[ks], p1); }
            __builtin_amdgcn_sched_barrier(0);
#pragma unroll
            for (int d = ND0 / 2; d < ND0; ++d)
#pragma unroll
                for (int hf = 0; hf < 2; ++hf)
#pragma unroll
                    for (int jj = 0; jj < 2; ++jj) vfr[4 * d + 2 * hf + jj] = *(const LAS bf16x8*)(Vb + (32 * d + r32) * VSB + (32 * hf + 16 * jj + 8 * hi) * 2);
            __builtin_amdgcn_sched_barrier(0);
            const bool need_mask = (kv0 + 63 > qw0) || (W > 0 && kv0 <= qw0 + 31 - W);
            if (need_mask) {
#pragma unroll
                for (int r = 0; r < 16; ++r) { const int kv = kv0 + 16 * (r >> 3) + 8 * hi + (r & 7);
                    const bool v0 = (kv <= qrow) && (W == 0 || kv > qrow - W), v1 = (kv + 32 <= qrow) && (W == 0 || kv + 32 > qrow - W);
                    p0[r] = v0 ? p0[r] : -INFINITY; p1[r] = v1 ? p1[r] : -INFINITY; }
            }
            if constexpr (!FAST) {
            float mx = fmaxf(max16(p0), max16(p1)); mx = fmaxf(mx, swap32f(mx, hi));
            const bool move = (mx > 8.0f) || (lsum == 0.f && mx != 0.f && mx != -INFINITY);
            if (__any(move)) {
                const float d = move ? mx : 0.f; const float alpha = __builtin_amdgcn_exp2f(-d);
                mhat += d; lsum *= alpha;
#pragma unroll
                for (int r = 0; r < 16; ++r) { p0[r] -= d; p1[r] -= d; }
#pragma unroll
                for (int d0 = 0; d0 < ND0; ++d0)
#pragma unroll
                    for (int r = 0; r < 16; ++r) o[d0][r] *= alpha;
            }
            }
#pragma unroll
            for (int r = 0; r < 16; ++r) { p0[r] = __builtin_amdgcn_exp2f(p0[r]); p1[r] = __builtin_amdgcn_exp2f(p1[r]); }
            lsum += sum32pk(p0, p1);
            bf16x8 pf[2][2];
            pf[0][0] = pack8(p0[0], p0[1], p0[2], p0[3], p0[4], p0[5], p0[6], p0[7]); pf[0][1] = pack8(p0[8], p0[9], p0[10], p0[11], p0[12], p0[13], p0[14], p0[15]);
            pf[1][0] = pack8(p1[0], p1[1], p1[2], p1[3], p1[4], p1[5], p1[6], p1[7]); pf[1][1] = pack8(p1[8], p1[9], p1[10], p1[11], p1[12], p1[13], p1[14], p1[15]);
            asm volatile("s_waitcnt lgkmcnt(0)" ::: "memory");
#pragma unroll
            for (int d = 0; d < ND0; ++d)
#pragma unroll
                for (int hf = 0; hf < 2; ++hf)
#pragma unroll
                    for (int jj = 0; jj < 2; ++jj) o[d] = MFMA32(vfr[4 * d + 2 * hf + jj], pf[hf][jj], o[d]);
        }
    };
    for (int pass = 0; pass < (PAIR ? 2 : 1); ++pass) {
        if (PAIR && pass) { Qp = A.Qb; Kp = A.Kb; }
#pragma unroll
        for (int ks = 0; ks < NKS; ++ks) { if (ks < 4) qf[ks] = *(const bf16x8*)(Qp + (size_t)qrow * A.ldq + ks * 16 + hi * 8); else qf[ks] = *(const bf16x8*)(A.Q1 + (size_t)qrow * A.ldq + (ks - 4) * 16 + hi * 8); }
#pragma unroll
        for (int d = 0; d < ND0; ++d)
#pragma unroll
            for (int r = 0; r < 16; ++r) o[d][r] = 0.f;
        lsum = 0.f; mhat = 0.f;
        gload(t_lo, kA, vA); sstore(0, kA, vA); if (t_lo + 1 < t_hi) gload(t_lo + 1, kA, vA); __syncthreads();
#pragma unroll
        for (int ks = 0; ks < NKS; ++ks) asm volatile("" :: "v"(qf[ks]));
        float q2n = 0.f;
#pragma unroll
        for (int ks = 0; ks < NKS; ++ks) { const v4u w = __builtin_bit_cast(v4u, qf[ks]);
            q2n += (bflo(w.x) * bflo(w.x) + bfhi(w.x) * bfhi(w.x)) + (bflo(w.y) * bflo(w.y) + bfhi(w.y) * bfhi(w.y))
                 + (bflo(w.z) * bflo(w.z) + bfhi(w.z) * bfhi(w.z)) + (bflo(w.w) * bflo(w.w) + bfhi(w.w) * bfhi(w.w)); }
        q2n += swap32f(q2n, hi);
        const bool fast = !__any(!(q2n * A.kbound <= 4096.0f));
        auto run = [&](auto ft) {
        for (int t = t_lo; t < t_hi; ++t) {
            const int buf = (t - t_lo) & 1;
            if (t + 1 < t_hi) sstore(buf ^ 1, kA, vA);
            if (t + 2 < t_hi) gload(t + 2, kA, vA);
            constexpr bool HOST = decltype(ft)::value;
            if constexpr (HOST) bg.begin();
            compute(t, buf, ft);
            if constexpr (HOST) bg.end();
            __syncthreads();
        } };
        if (fast) run(BoolC<true>{}); else run(BoolC<false>{});
        if (PAIR && pass == 0) {
            const float lt0 = lsum + swap32f(lsum, hi); const float inv0 = lt0 > 0.f ? 1.0f / lt0 : 0.f;
            LAS unsigned char* oa = lds + OA_OFF + (32 * wave + r32) * OA_ROWB + 8 * hi;
#pragma unroll
            for (int d = 0; d < ND0; ++d)
#pragma unroll
                for (int g4 = 0; g4 < 4; ++g4) { v2u w; w.x = pk2(o[d][4 * g4] * inv0, o[d][4 * g4 + 1] * inv0); w.y = pk2(o[d][4 * g4 + 2] * inv0, o[d][4 * g4 + 3] * inv0);
                    *(LAS v2u*)(oa + (32 * d + 8 * g4) * 2) = w; }
        }
    }
    const float lt = lsum + swap32f(lsum, hi); const float inv = lt > 0.f ? 1.0f / lt : 0.f;
    const int dep_e = __builtin_amdgcn_readfirstlane(__builtin_bit_cast(int, lt));
    const int lane_e = (int)__builtin_amdgcn_mbcnt_hi(~0u, __builtin_amdgcn_mbcnt_lo(~0u, (unsigned)dep_e)) - dep_e;
    bf16* orow = A.O + (size_t)(qw0 + (lane_e & 31)) * A.ldo - 4 * hi + 4 * (lane_e >> 5);
    if constexpr (PAIR) {
        const LAS unsigned char* oa = lds + OA_OFF + (32 * wave + r32) * OA_ROWB + 8 * hi;
        float ss = 0.f;
#pragma unroll
        for (int d = 0; d < ND0; ++d)
#pragma unroll
            for (int g4 = 0; g4 < 4; ++g4) { const v2u w = *(const LAS v2u*)(oa + (32 * d + 8 * g4) * 2);
                const float d0 = bflo(w.x) - A.lam * (o[d][4 * g4] * inv), d1 = bfhi(w.x) - A.lam * (o[d][4 * g4 + 1] * inv), d2 = bflo(w.y) - A.lam * (o[d][4 * g4 + 2] * inv), d3 = bfhi(w.y) - A.lam * (o[d][4 * g4 + 3] * inv);
                o[d][4 * g4] = d0; o[d][4 * g4 + 1] = d1; o[d][4 * g4 + 2] = d2; o[d][4 * g4 + 3] = d3; ss += (d0 * d0 + d1 * d1) + (d2 * d2 + d3 * d3); }
        ss += swap32f(ss, hi);
        const float rr = A.gscale / sqrtf(ss * (1.0f / DV) + LN_EPS);
#pragma unroll
        for (int d = 0; d < ND0; ++d)
#pragma unroll
            for (int g4 = 0; g4 < 4; ++g4) { const f32x4 gg = *(const f32x4*)(A.gain + 32 * d + 8 * g4 + 4 * hi);
                v2u w; w.x = pk2(o[d][4 * g4] * rr * gg[0], o[d][4 * g4 + 1] * rr * gg[1]); w.y = pk2(o[d][4 * g4 + 2] * rr * gg[2], o[d][4 * g4 + 3] * rr * gg[3]);
                *(v2u*)(orow + 32 * d + 8 * g4 + 4 * hi) = w; }
    } else {
#pragma unroll
    for (int d = 0; d < ND0; ++d)
#pragma unroll
        for (int g4 = 0; g4 < 4; ++g4) { v2u w; w.x = pk2(o[d][4 * g4] * inv, o[d][4 * g4 + 1] * inv); w.y = pk2(o[d][4 * g4 + 2] * inv, o[d][4 * g4 + 3] * inv);
            *(v2u*)(orow + 32 * d + 8 * g4 + 4 * hi) = w; }
    }
}

constexpr int CMP_IMP_B = 64 * 257 * 4, CMP_KB = 64 * 144;
__device__ __forceinline__ float quad_sum(float v) {
    v += __builtin_bit_cast(float, __builtin_amdgcn_update_dpp(0, __builtin_bit_cast(int, v), 0xB1, 0xF, 0xF, true));
    v += __builtin_bit_cast(float, __builtin_amdgcn_update_dpp(0, __builtin_bit_cast(int, v), 0x4E, 0xF, 0xF, true));
    return v;
}
__device__ __forceinline__ void nsa_cmp_unit(LAS unsigned char* lds, const Args& a, int T, int g, int tid_in, int lane_in, int wave, float kbound) {
    const int lane = (int)__builtin_amdgcn_mbcnt_hi(~0u, __builtin_amdgcn_mbcnt_lo(~0u, (unsigned)T)) - T; const int tid = wave * 64 + lane; (void)tid_in; (void)lane_in;
    const bf16* R = WSP(bf16, WS_QK); const bf16* Kc = WSP(bf16, WS_MISC + NSA_KC); const bf16* VcT = WSP(bf16, WS_MISC + NSA_VCT);
    bf16* Oc = WSP(bf16, WS_OH); unsigned* selm = WSP(unsigned, WS_MISC + NSA_SEL);
    const int r32 = lane & 31, hi = lane >> 5, q0 = 64 * T;
    const int ql = 8 * wave + (r32 >> 2), hd = r32 & 3, h = 4 * g + hd, qrow = q0 + ql;
    const int nlim = (qrow >= 31) ? ((qrow - 31) >> 4) : -1;
    const int qw_lo = q0 + 8 * wave, qw_hi = qw_lo + 7;
    const int nlim_lo = (qw_lo >= 31) ? ((qw_lo - 31) >> 4) : -1, nlim_hi = (qw_hi >= 31) ? ((qw_hi - 31) >> 4) : -1;
    const int NT = (((q0 + 32) >> 4) >> 6) + 1;
    LAS float* imp = (LAS float*)lds;
    LAS unsigned char* kb0 = lds + CMP_IMP_B; LAS unsigned char* vb0 = kb0 + 2 * CMP_KB;
    for (int i = tid; i < 64 * 257; i += NTHREADS) imp[i] = 0.f;
    bf16x8 qf[4];
#pragma unroll
    for (int ks = 0; ks < 4; ++ks) qf[ks] = *(const bf16x8*)(R + (size_t)qrow * 1024 + 64 * h + ks * 16 + hi * 8);
    const int pr = pi32(r32);
    const int lrow = tid >> 3, lch = tid & 7;
    const bf16* Ksrc = Kc + (size_t)(g * 1024) * 64 + tid * 8;
    const bf16* Vsrc = VcT + (size_t)lrow * 4096 + g * 1024 + lch * 8;
    const int soff = lrow * 144 + lch * 16;
    v4u kreg, vreg;
    float mhat = 0.f, lsum = 0.f;
    auto qk = [&](const LAS unsigned char* Kb, int n0, f32x16& p0, f32x16& p1, auto ft) {
        constexpr bool FAST = decltype(ft)::value;
#pragma unroll
        for (int r = 0; r < 16; ++r) { p0[r] = FAST ? 0.f : -mhat; p1[r] = FAST ? 0.f : -mhat; }
        bf16x8 kfr[8];
#pragma unroll
        for (int ks = 0; ks < 4; ++ks) { kfr[2 * ks] = *(const LAS bf16x8*)(Kb + pr * 144 + ks * 32 + hi * 16); kfr[2 * ks + 1] = *(const LAS bf16x8*)(Kb + (32 + pr) * 144 + ks * 32 + hi * 16); }
        asm volatile("s_waitcnt lgkmcnt(0)" ::: "memory");
        __builtin_amdgcn_sched_barrier(0);
#pragma unroll
        for (int ks = 0; ks < 4; ++ks) { p0 = MFMA32(kfr[2 * ks], qf[ks], p0); p1 = MFMA32(kfr[2 * ks + 1], qf[ks], p1); }
        if (n0 + 63 > nlim_lo) {
#pragma unroll
            for (int r = 0; r < 16; ++r) { const int n = n0 + 16 * (r >> 3) + 8 * hi + (r & 7); p0[r] = (n <= nlim) ? p0[r] : -INFINITY; p1[r] = (n + 32 <= nlim) ? p1[r] : -INFINITY; }
        }
    };
    kreg = *(const v4u*)Ksrc; *(LAS v4u*)(kb0 + soff) = kreg; if (1 < NT) kreg = *(const v4u*)(Ksrc + 4096); __syncthreads();
#pragma unroll
    for (int ks = 0; ks < 4; ++ks) asm volatile("" :: "v"(qf[ks]));
    float q2n = 0.f;
#pragma unroll
    for (int ks = 0; ks < 4; ++ks) { const v4u w = __builtin_bit_cast(v4u, qf[ks]);
        q2n += (bflo(w.x) * bflo(w.x) + bfhi(w.x) * bfhi(w.x)) + (bflo(w.y) * bflo(w.y) + bfhi(w.y) * bfhi(w.y))
             + (bflo(w.z) * bflo(w.z) + bfhi(w.z) * bfhi(w.z)) + (bflo(w.w) * bflo(w.w) + bfhi(w.w) * bfhi(w.w)); }
    q2n += swap32f(q2n, hi);
    const bool fast = !__any(!(q2n * kbound <= 4096.0f));
    auto pass1 = [&](auto ft) {
    constexpr bool FAST = decltype(ft)::value;
    for (int t = 0; t < NT; ++t) {
        const int buf = t & 1, n0 = 64 * t;
        if (t + 1 < NT) *(LAS v4u*)(kb0 + (buf ^ 1) * CMP_KB + soff) = kreg;
        if (t + 2 < NT) kreg = *(const v4u*)(Ksrc + (size_t)(t + 2) * 4096);
        if (n0 <= nlim_hi) {
            f32x16 p0, p1; qk(kb0 + buf * CMP_KB, n0, p0, p1, ft);
            if constexpr (!FAST) {
            float mx = fmaxf(max16(p0), max16(p1)); mx = fmaxf(mx, swap32f(mx, hi));
            const bool move = (mx > 8.0f) || (lsum == 0.f && mx != 0.f && mx != -INFINITY);
            if (__any(move)) { const float d = move ? mx : 0.f; mhat += d; lsum *= __builtin_amdgcn_exp2f(-d);
#pragma unroll
                for (int r = 0; r < 16; ++r) { p0[r] -= d; p1[r] -= d; } }
            }
#pragma unroll
            for (int r = 0; r < 16; ++r) { p0[r] = __builtin_amdgcn_exp2f(p0[r]); p1[r] = __builtin_amdgcn_exp2f(p1[r]); }
            lsum += sum32pk(p0, p1);
        }
        __syncthreads();
    } };
    if (fast) pass1(BoolC<true>{}); else pass1(BoolC<false>{});
    const float lt = lsum + swap32f(lsum, hi); const float inv = lt > 0.f ? 1.0f / lt : 0.f;
    f32x16 o[2];
#pragma unroll
    for (int d = 0; d < 2; ++d)
#pragma unroll
        for (int r = 0; r < 16; ++r) o[d][r] = 0.f;
    kreg = *(const v4u*)Ksrc; vreg = *(const v4u*)Vsrc;
    *(LAS v4u*)(kb0 + soff) = kreg; *(LAS v4u*)(vb0 + soff) = vreg;
    if (1 < NT) { kreg = *(const v4u*)(Ksrc + 4096); vreg = *(const v4u*)(Vsrc + 64); }
    __syncthreads();
    LAS float* irow = imp + ql * 257 + 4 * hd + 2 * hi;
    for (int t = 0; t < NT; ++t) {
        const int buf = t & 1, n0 = 64 * t;
        if (t + 1 < NT) { *(LAS v4u*)(kb0 + (buf ^ 1) * CMP_KB + soff) = kreg; *(LAS v4u*)(vb0 + (buf ^ 1) * CMP_KB + soff) = vreg; }
        if (t + 2 < NT) { kreg = *(const v4u*)(Ksrc + (size_t)(t + 2) * 4096); vreg = *(const v4u*)(Vsrc + 64 * (t + 2)); }
        if (n0 <= nlim_hi) {
            const LAS unsigned char* Vb = vb0 + buf * CMP_KB;
            f32x16 p0, p1; qk(kb0 + buf * CMP_KB, n0, p0, p1, BoolC<false>{});
            bf16x8 vfr[8];
#pragma unroll
            for (int d = 0; d < 2; ++d)
#pragma unroll
                for (int q = 0; q < 4; ++q) vfr[4 * d + q] = *(const LAS bf16x8*)(Vb + (32 * d + r32) * 144 + (16 * q + 8 * hi) * 2);
#pragma unroll
            for (int r = 0; r < 16; ++r) { p0[r] = __builtin_amdgcn_exp2f(p0[r]) * inv; p1[r] = __builtin_amdgcn_exp2f(p1[r]) * inv; }
            float s0[4], s1[4], s2[4];
#pragma unroll
            for (int gq = 0; gq < 4; ++gq) { const f32x16& p = (gq >> 1) ? p1 : p0; const int b8 = 8 * (gq & 1);
                s0[gq] = quad_sum(2.f * (p[b8] + p[b8 + 1] + p[b8 + 2]) + p[b8 + 3]);
                s1[gq] = quad_sum(p[b8 + 3] + 2.f * (p[b8 + 4] + p[b8 + 5] + p[b8 + 6]) + p[b8 + 7]);
                s2[gq] = quad_sum(p[b8 + 7]); }
            const float a0 = hd == 0 ? s0[0] : hd == 1 ? s0[1] : hd == 2 ? s0[2] : s0[3];
            const float a1 = hd == 0 ? s1[0] : hd == 1 ? s1[1] : hd == 2 ? s1[2] : s1[3];
            const float a2 = hd == 0 ? s2[0] : hd == 1 ? s2[1] : hd == 2 ? s2[2] : s2[3];
            LAS float* ip = irow + (n0 >> 2);
            { const float x0 = ip[0], x1 = ip[1]; ip[0] = x0 + a0; ip[1] = x1 + a1; }
            asm volatile("s_waitcnt lgkmcnt(0)" ::: "memory");
            { const float x2 = ip[2]; ip[2] = x2 + a2; }
            bf16x8 pf[4];
            pf[0] = pack8(p0[0], p0[1], p0[2], p0[3], p0[4], p0[5], p0[6], p0[7]); pf[1] = pack8(p0[8], p0[9], p0[10], p0[11], p0[12], p0[13], p0[14], p0[15]);
            pf[2] = pack8(p1[0], p1[1], p1[2], p1[3], p1[4], p1[5], p1[6], p1[7]); pf[3] = pack8(p1[8], p1[9], p1[10], p1[11], p1[12], p1[13], p1[14], p1[15]);
            asm volatile("s_waitcnt lgkmcnt(0)" ::: "memory");
#pragma unroll
            for (int d = 0; d < 2; ++d)
#pragma unroll
                for (int q = 0; q < 4; ++q) o[d] = MFMA32(vfr[4 * d + q], pf[q], o[d]);
        }
        __syncthreads();
    }
    { bf16* orow = Oc + (size_t)qrow * 1024 + 64 * h;
#pragma unroll
      for (int d = 0; d < 2; ++d)
#pragma unroll
          for (int g4 = 0; g4 < 4; ++g4) { v2u w; w.x = pk2(o[d][4 * g4], o[d][4 * g4 + 1]); w.y = pk2(o[d][4 * g4 + 2], o[d][4 * g4 + 3]); *(v2u*)(orow + 32 * d + 8 * g4 + 4 * hi) = w; } }
    for (int i = 0; i < 8; ++i) {
        const int qq = 8 * wave + i;
        unsigned kb[4]; bool selb[4], cand[4];
#pragma unroll
        for (int s = 0; s < 4; ++s) { const int j = lane + 64 * s; selb[s] = (j <= T) && (T <= 15 || j == 0 || j >= T - 1);
            cand[s] = (T > 15) && (j >= 1) && (j <= T - 2);
            kb[s] = cand[s] ? __float_as_uint(imp[qq * 257 + j]) : 0u; }
        if (T > 15) {
            unsigned prefix = 0u;
            for (int b = 30; b >= 0; --b) { const unsigned t = prefix | (1u << b);
                const int cnt = __popcll(__ballot(cand[0] && kb[0] >= t)) + __popcll(__ballot(cand[1] && kb[1] >= t)) + __popcll(__ballot(cand[2] && kb[2] >= t)) + __popcll(__ballot(cand[3] && kb[3] >= t));
                if (cnt >= 13) prefix = t;
                if (cnt == 13) break; }
            const int ngt = __popcll(__ballot(cand[0] && kb[0] > prefix)) + __popcll(__ballot(cand[1] && kb[1] > prefix)) + __popcll(__ballot(cand[2] && kb[2] > prefix)) + __popcll(__ballot(cand[3] && kb[3] > prefix));
            const int need = 13 - ngt; int running = 0;
#pragma unroll
            for (int s = 0; s < 4; ++s) { const bool eq = cand[s] && kb[s] == prefix; const unsigned long long mk = __ballot(eq);
                const int rank = running + (int)__builtin_amdgcn_mbcnt_hi((unsigned)(mk >> 32), __builtin_amdgcn_mbcnt_lo((unsigned)mk, 0u));
                if (cand[s] && (kb[s] > prefix || (eq && rank < need))) selb[s] = true;
                running += __popcll(mk); }
        }
        const unsigned long long m0 = __ballot(selb[0]), m1 = __ballot(selb[1]), m2 = __ballot(selb[2]), m3 = __ballot(selb[3]);
        if (lane == 0) { unsigned* dst = selm + ((size_t)(q0 + qq) * 4 + g) * 8;
            *(v4u*)dst = (v4u){(unsigned)m0, (unsigned)(m0 >> 32), (unsigned)m1, (unsigned)(m1 >> 32)};
            *(v4u*)(dst + 4) = (v4u){(unsigned)m2, (unsigned)(m2 >> 32), (unsigned)m3, (unsigned)(m3 >> 32)}; }
    }
    __syncthreads();
}

__device__ __forceinline__ void nsa_sel_unit(LAS unsigned char* lds, const Args& a, int T, int g, int tid_in, int lane_in, int wave, float kbound) {
    const int lane = (int)__builtin_amdgcn_mbcnt_hi(~0u, __builtin_amdgcn_mbcnt_lo(~0u, (unsigned)T)) - T; const int tid = wave * 64 + lane; (void)tid_in; (void)lane_in;
    const bf16* R = WSP(bf16, WS_QK); const bf16* VT = WSP(bf16, WS_VT); const bf16* P = WSP(bf16, WS_MISC + NSA_P);
    const bf16* Oc = WSP(bf16, WS_OH); const bf16* Ow = WSP(bf16, WS_OH + 32 * MiB); bf16* Ao = WSP(bf16, WS_AO);
    const unsigned* selm = WSP(unsigned, WS_MISC + NSA_SEL);
    constexpr int KSB = 144, VSB = 144, KBUF = 64 * KSB, BUFB = 2 * KBUF;
    const int r32 = lane & 31, hi = lane >> 5, q0 = 64 * T;
    const int ql = 8 * wave + (r32 >> 2), hd = r32 & 3, h = 4 * g + hd, qrow = q0 + ql;
    bf16x8 qf[4];
#pragma unroll
    for (int ks = 0; ks < 4; ++ks) qf[ks] = *(const bf16x8*)(R + (size_t)qrow * 1024 + 64 * h + ks * 16 + hi * 8);
    const unsigned* selp = selm + ((size_t)qrow * 4 + g) * 8; unsigned selw = 0u;
    const v4u sm0 = *(const v4u*)selp, sm1 = *(const v4u*)(selp + 4);
    f32x16 o[2];
#pragma unroll
    for (int d = 0; d < 2; ++d)
#pragma unroll
        for (int r = 0; r < 16; ++r) o[d][r] = 0.f;
    float lsum = 0.f, mhat = 0.f;
    const int lrow = tid >> 3, lch = tid & 7, soff = lrow * 144 + lch * 16;
    const bf16* Ksrc = WSP(bf16, WS_KH) + (size_t)g * S * 64 + tid * 8; const bf16* Vsrc = VT + (size_t)g * S * 64 + tid * 8;
    v4u kA, vA, kB, vB, kC, vC;
    const int NP = T / 3 + 1;
    kA = *(const v4u*)Ksrc; vA = *(const v4u*)Vsrc;
    *(LAS v4u*)(lds + soff) = kA; *(LAS v4u*)(lds + KBUF + soff) = vA;
    if (1 <= T) { kB = *(const v4u*)(Ksrc + 4096); vB = *(const v4u*)(Vsrc + 4096); *(LAS v4u*)(lds + BUFB + soff) = kB; *(LAS v4u*)(lds + BUFB + KBUF + soff) = vB; }
    if (2 <= T) { kC = *(const v4u*)(Ksrc + 2 * 4096); vC = *(const v4u*)(Vsrc + 2 * 4096); *(LAS v4u*)(lds + 2 * BUFB + soff) = kC; *(LAS v4u*)(lds + 2 * BUFB + KBUF + soff) = vC; }
    if (3 <= T) { kA = *(const v4u*)(Ksrc + 3 * 4096); vA = *(const v4u*)(Vsrc + 3 * 4096); }
    if (4 <= T) { kB = *(const v4u*)(Ksrc + 4 * 4096); vB = *(const v4u*)(Vsrc + 4 * 4096); }
    if (5 <= T) { kC = *(const v4u*)(Ksrc + 5 * 4096); vC = *(const v4u*)(Vsrc + 5 * 4096); }
    __syncthreads();
#pragma unroll
    for (int ks = 0; ks < 4; ++ks) asm volatile("" :: "v"(qf[ks]));
    LAS unsigned* smk = (LAS unsigned*)(lds + 6 * BUFB) + tid * 8;
    *(LAS v4u*)smk = sm0; *(LAS v4u*)(smk + 4) = sm1;
    const int pr = pi32(r32);
    auto compute = [&](int j, int boff, auto ft) {
        constexpr bool FAST = decltype(ft)::value;
        if ((j & 31) == 0) selw = smk[j >> 5];
        const bool mine = (selw >> (j & 31)) & 1u;
        if (__any(mine)) {
            const LAS unsigned char* Kb = lds + boff; const LAS unsigned char* Vb = Kb + KBUF;
            f32x16 p0, p1;
            { const float init = mine ? (FAST ? 0.f : -mhat) : -INFINITY;
#pragma unroll
              for (int r = 0; r < 16; ++r) { p0[r] = init; p1[r] = init; } }
            bf16x8 kfr[8];
#pragma unroll
            for (int ks = 0; ks < 4; ++ks) { kfr[2 * ks] = *(const LAS bf16x8*)(Kb + pr * KSB + ks * 32 + hi * 16); kfr[2 * ks + 1] = *(const LAS bf16x8*)(Kb + (32 + pr) * KSB + ks * 32 + hi * 16); }
            asm volatile("s_waitcnt lgkmcnt(0)" ::: "memory");
            bf16x8 vfr[8];
#pragma unroll
            for (int d = 0; d < 2; ++d)
#pragma unroll
                for (int hf = 0; hf < 2; ++hf)
#pragma unroll
                    for (int jj = 0; jj < 2; ++jj) vfr[4 * d + 2 * hf + jj] = *(const LAS bf16x8*)(Vb + (32 * d + r32) * VSB + (32 * hf + 16 * jj + 8 * hi) * 2);
            __builtin_amdgcn_sched_barrier(0);
#pragma unroll
            for (int ks = 0; ks < 4; ++ks) { p0 = MFMA32(kfr[2 * ks], qf[ks], p0); p1 = MFMA32(kfr[2 * ks + 1], qf[ks], p1); }
            if (j == T) {
#pragma unroll
                for (int r = 0; r < 16; ++r) { const int kvl = 16 * (r >> 3) + 8 * hi + (r & 7);
                    p0[r] = (kvl <= ql) ? p0[r] : -INFINITY; p1[r] = (kvl + 32 <= ql) ? p1[r] : -INFINITY; }
            }
            if constexpr (!FAST) {
            float mx = fmaxf(max16(p0), max16(p1)); mx = fmaxf(mx, swap32f(mx, hi));
            const bool move = (mx > 8.0f) || (lsum == 0.f && mx != 0.f && mx != -INFINITY);
            if (__any(move)) {
                const float d = move ? mx : 0.f; const float alpha = __builtin_amdgcn_exp2f(-d);
                mhat += d; lsum *= alpha;
#pragma unroll
                for (int r = 0; r < 16; ++r) { p0[r] -= d; p1[r] -= d; }
#pragma unroll
                for (int d0 = 0; d0 < 2; ++d0)
#pragma unroll
                    for (int r = 0; r < 16; ++r) o[d0][r] *= alpha;
            }
            }
#pragma unroll
            for (int r = 0; r < 16; ++r) { p0[r] = __builtin_amdgcn_exp2f(p0[r]); p1[r] = __builtin_amdgcn_exp2f(p1[r]); }
            lsum += sum32pk(p0, p1);
            bf16x8 pf[2][2];
            pf[0][0] = pack8(p0[0], p0[1], p0[2], p0[3], p0[4], p0[5], p0[6], p0[7]); pf[0][1] = pack8(p0[8], p0[9], p0[10], p0[11], p0[12], p0[13], p0[14], p0[15]);
            pf[1][0] = pack8(p1[0], p1[1], p1[2], p1[3], p1[4], p1[5], p1[6], p1[7]); pf[1][1] = pack8(p1[8], p1[9], p1[10], p1[11], p1[12], p1[13], p1[14], p1[15]);
            asm volatile("s_waitcnt lgkmcnt(0)" ::: "memory");
#pragma unroll
            for (int d = 0; d < 2; ++d)
#pragma unroll
                for (int hf = 0; hf < 2; ++hf)
#pragma unroll
                    for (int jj = 0; jj < 2; ++jj) o[d] = MFMA32(vfr[4 * d + 2 * hf + jj], pf[hf][jj], o[d]);
        }
    };
    float q2n = 0.f;
#pragma unroll
    for (int ks = 0; ks < 4; ++ks) { const v4u w = __builtin_bit_cast(v4u, qf[ks]);
        q2n += (bflo(w.x) * bflo(w.x) + bfhi(w.x) * bfhi(w.x)) + (bflo(w.y) * bflo(w.y) + bfhi(w.y) * bfhi(w.y))
             + (bflo(w.z) * bflo(w.z) + bfhi(w.z) * bfhi(w.z)) + (bflo(w.w) * bflo(w.w) + bfhi(w.w) * bfhi(w.w)); }
    q2n += swap32f(q2n, hi);
    const bool fast = !__any(!(q2n * kbound <= 4096.0f));
    auto run = [&](auto ft) {
    for (int jp = 0; jp < NP; ++jp) {
        const int so = (jp & 1) * (3 * BUFB), sn = 3 * BUFB - so;
        const int j0 = 3 * jp;
        if (j0 + 3 <= T) { *(LAS v4u*)(lds + sn + soff) = kA; *(LAS v4u*)(lds + sn + KBUF + soff) = vA; }
        if (j0 + 4 <= T) { *(LAS v4u*)(lds + sn + BUFB + soff) = kB; *(LAS v4u*)(lds + sn + BUFB + KBUF + soff) = vB; }
        if (j0 + 5 <= T) { *(LAS v4u*)(lds + sn + 2 * BUFB + soff) = kC; *(LAS v4u*)(lds + sn + 2 * BUFB + KBUF + soff) = vC; }
        if (j0 + 6 <= T) { kA = *(const v4u*)(Ksrc + (size_t)(j0 + 6) * 4096); vA = *(const v4u*)(Vsrc + (size_t)(j0 + 6) * 4096); }
        if (j0 + 7 <= T) { kB = *(const v4u*)(Ksrc + (size_t)(j0 + 7) * 4096); vB = *(const v4u*)(Vsrc + (size_t)(j0 + 7) * 4096); }
        if (j0 + 8 <= T) { kC = *(const v4u*)(Ksrc + (size_t)(j0 + 8) * 4096); vC = *(const v4u*)(Vsrc + (size_t)(j0 + 8) * 4096); }
        compute(j0, so, ft);
        if (j0 + 1 <= T) compute(j0 + 1, so + BUFB, ft);
        if (j0 + 2 <= T) compute(j0 + 2, so + 2 * BUFB, ft);
        __syncthreads();
    } };
    if (fast) run(BoolC<true>{}); else run(BoolC<false>{});
    { const float lt = lsum + swap32f(lsum, hi); const float inv = lt > 0.f ? 1.0f / lt : 0.f;
      const size_t rb = (size_t)qrow * 1024 + 64 * h;
      const bf16* gp = P + (size_t)qrow * 768 + 512 + 3 * h;
      const float g0 = 1.0f / (1.0f + __expf(-bf2f(gp[0]))), g1 = inv / (1.0f + __expf(-bf2f(gp[1]))), g2 = 1.0f / (1.0f + __expf(-bf2f(gp[2])));
#pragma unroll
      for (int d = 0; d < 2; ++d)
#pragma unroll
          for (int g4 = 0; g4 < 4; ++g4) { const int dv = 32 * d + 8 * g4 + 4 * hi;
              const v2u wc = *(const v2u*)(Oc + rb + dv), ww = *(const v2u*)(Ow + rb + dv);
              v2u w; w.x = pk2(g0 * bflo(wc.x) + g1 * o[d][4 * g4] + g2 * bflo(ww.x), g0 * bfhi(wc.x) + g1 * o[d][4 * g4 + 1] + g2 * bfhi(ww.x));
              w.y = pk2(g0 * bflo(wc.y) + g1 * o[d][4 * g4 + 2] + g2 * bflo(ww.y), g0 * bfhi(wc.y) + g1 * o[d][4 * g4 + 3] + g2 * bfhi(ww.y));
              *(v2u*)(Ao + rb + dv) = w; } }
}
#ifndef REP
#define REP 0
#endif
#define REPN(bit) (((REP >> (bit)) & 1) ? 2 : 1)
struct Ctx { LAS unsigned char* lds; LAS unsigned* lc; int wave, G, cb; XcdBarrier bar; int ph; };
#define RUN (c.ph >= a.ph_lo && c.ph < a.ph_hi)
#define LANE_ID(K) ((int)__builtin_amdgcn_mbcnt_hi(~0u, __builtin_amdgcn_mbcnt_lo(~0u, (unsigned)(K))) - (K))
#define IDS_(K) const int wave = c.wave; const int lane = LANE_ID(K); const int tid = wave * 64 + lane; (void)lane; (void)tid
#define IDS_T const int tid = threadIdx.x, lane = tid & 63, wave = c.wave; (void)lane; (void)tid
#define IDS_M IDS_(c.ph + 1)
#ifndef MSEL
#define MSEL 31
#endif
#if (MSEL >> 0) & 1
#define IDS0 IDS_M
#else
#define IDS0 IDS_T
#endif
#if (MSEL >> 1) & 1
#define IDS1 IDS_M
#else
#define IDS1 IDS_T
#endif
#if (MSEL >> 2) & 1
#define IDS2 IDS_M
#else
#define IDS2 IDS_T
#endif
#if (MSEL >> 3) & 1
#define IDS3 IDS_M
#else
#define IDS3 IDS_T
#endif
#if (MSEL >> 4) & 1
#define IDS4 IDS_M
#else
#define IDS4 IDS_T
#endif

#define SEAM() do { if (RUN && c.ph + 1 < a.ph_hi) xcd_barrier(c.bar, c.wave * 64 + LANE_ID(c.ph + 77)); ++c.ph; } while (0)
#define CTX_LOCALS LAS unsigned char* lds = c.lds; LAS unsigned* lc = c.lc; const int G = c.G, cb = c.cb; (void)lc; (void)lds; (void)G; (void)cb; \
    const float QS64 = 0.125f * LOG2E, QS96 = 0.10206207261596575f * LOG2E; (void)QS64; (void)QS96; \
    const cs_t* cs64 = WSP(cs_t, WS_CS64); const cs_t* cs32 = WSP(cs_t, WS_CS32); (void)cs64; (void)cs32; \
    bf16* XB = WSP(bf16, WS_XB); bf16* AO = WSP(bf16, WS_AO); bf16* QK = WSP(bf16, WS_QK); bf16* VT = WSP(bf16, WS_VT); bf16* OH = WSP(bf16, WS_OH); bf16* KH = WSP(bf16, WS_KH); (void)KH; bf16* Y16 = WSP(bf16, WS_Y); \
    (void)XB; (void)AO; (void)QK; (void)VT; (void)OH; (void)Y16; unsigned* AMX = WSP(unsigned, WS_CTL) + CW_KMAX; (void)AMX;

template <int LAYER> __device__ __forceinline__ void da_layer(const Args& a, Ctx& c) {
    CTX_LOCALS
    constexpr int j = LAYER / 3; const float lam_init = 0.8f - 0.6f * __expf(-0.3f * (float)LAYER);
    bf16* Wb = WSP(bf16, WS_WDA + (size_t)j * 8 * MiB);
    if (RUN) { IDS0;
        { pg8::Gemm g{XB, Wb, S, 2048, 1024}; pg8::StaticOrder So; So.init(S, 2048, G, cb);
          pg8::EpiRope64 E{QK, 1024, cs64, 32, 4, QS64, 0x7fffffff, 1, 0, 16, KH, S, AMX + (j ? 4 : 0)};
          pg8::gemm_phase<pg8::EpiRope64, pg8::StaticOrder, true, true, 1001>(lds, g, So, E, wave, c.ph + 1000); }
        { pg8::Gemm g{Wb + 2048 * 1024, XB, 1024, S, 1024}; pg8::StaticOrder So; So.init(1024, S, G, cb);
          pg8::EpiVtTiled E{VT, 7, S};
          pg8::gemm_phase<pg8::EpiVtTiled, pg8::StaticOrder, true, true, 1002>(lds, g, So, E, wave, c.ph + 1000); }
    }
    SEAM();
    if (RUN) { IDS0;
        const float lam = da_lambda(a, j, lam_init, lane);
        const float kbound = 2.04f * __builtin_bit_cast(float, xb_ld(AMX + (j ? 4 : 0)));
        const int hp = cb & 7, aa = cb >> 3;
        for (int i_ = 0; i_ < 2 * REPN(1); ++i_) { const int i = i_ & 1; const int qt = (i == 0) ? 63 - aa : aa;
            AttnArgs A; A.Q0 = QK + 64 * (2 * hp); A.Q1 = nullptr; A.ldq = 1024; A.K0 = KH + (size_t)(2 * hp) * S * 64; A.ldk0 = 64; A.K1 = nullptr; A.ldk1 = 0;
            A.Qb = QK + 64 * (2 * hp + 1); A.Kb = KH + (size_t)(2 * hp + 1) * S * 64; A.lam = lam; A.gain = a.in[I_DA_SUBLN] + j * 128; A.gscale = 1.0f - lam_init;
            A.Vt = VT + (size_t)(128 * hp) * S; A.ldv = S; A.O = AO + 128 * hp; A.ldo = 1024; A.window = 0; A.kbound = kbound;
            { BgNone nb_; attn_unit<64, 128, true>(lds, A, qt * 256, tid, lane, wave, nb_); } }
    }
    SEAM();
    if (RUN) { IDS0; pg8::Gemm g{AO, Wb + 3072 * 1024, S, 1024, 1024}; pg8::StaticOrder So; So.init(S, 1024, G, cb); pg8::EpiBf16P E{Y16, 1024, 1.0f};
        pg8::gemm_phase<pg8::EpiBf16P, pg8::StaticOrder, true, true, 1003>(lds, g, So, E, wave, c.ph + 1000); }
    SEAM();
}
__device__ __forceinline__ void mla_layer(const Args& a, Ctx& c) {
    CTX_LOCALS
    bf16* Wb = WSP(bf16, WS_WMLA);
    float* C = WSP(float, WS_MISC + MLA_C); bf16* cqn = WSP(bf16, WS_MISC + MLA_CQN); bf16* ckvn = WSP(bf16, WS_MISC + MLA_CKVN); bf16* Kr = WSP(bf16, WS_MISC + MLA_KR);
    if (RUN) { IDS1; pg8::Gemm g{XB, Wb, S, 512, 1024}; pg8::StaticOrder So; So.init(S, 512, G, cb); pg8::EpiF32 E{C, 512, AMX + 1};
        pg8::gemm_phase<pg8::EpiF32, pg8::StaticOrder, true, true, 1004>(lds, g, So, E, wave, c.ph + 1000); }
    SEAM();
    if (RUN) { IDS1; phase_mla_norm(a, tid, lane, wave); }
    SEAM();
    if (RUN) { IDS1;
        { pg8::Gemm g{cqn, Wb + 1 * MiB / 2, S, 1024, 256}; pg8::StaticOrder So; So.init(S, 1024, G, cb);
          pg8::EpiBf16P E{QK, 1536, QS96};
          pg8::gemm_phase<pg8::EpiBf16P, pg8::StaticOrder, true, true, 1901>(lds, g, So, E, wave, c.ph + 1000); }
        { pg8::Gemm g{cqn, Wb + 1 * MiB / 2 + 1024 * 256, S, 512, 256}; pg8::StaticOrder So; So.init(S, 512, G, (cb + 128) & 255);
          pg8::EpiRope16 E{QK + 1024, 1536, cs32, QS96};
          pg8::gemm_phase<pg8::EpiRope16, pg8::StaticOrder, true, true, 1902>(lds, g, So, E, wave, c.ph + 1000); }
        { pg8::Gemm g{ckvn, Wb + 2 * MiB / 2, S, 1024, 128}; pg8::StaticOrder So; So.init(S, 1024, G, cb);
          pg8::EpiHeadMajor64 E{KH, S, AMX + 1};
          pg8::gemm_phase<pg8::EpiHeadMajor64, pg8::StaticOrder, true, true, 1006>(lds, g, So, E, wave, c.ph + 1000); }
        { pg8::Gemm g{Wb + 2 * MiB / 2 + 1024 * 128, ckvn, 1024, S, 128}; pg8::StaticOrder So; So.init(1024, S, G, (cb + 128) & 255);
          pg8::EpiVtTiled E{VT, 6, S};
          pg8::gemm_phase<pg8::EpiVtTiled, pg8::StaticOrder, true, true, 1007>(lds, g, So, E, wave, c.ph + 1000); }
    }
    SEAM();
    if (RUN) { IDS1;
        const int hh = cb & 15, aa = cb >> 4;
        const float kbound = 3.06f * __builtin_bit_cast(float, xb_ld(AMX + 1));
        BgConv bg; bg.init(&a.jobs[18], 3, cb * NWAVES + wave, G * NWAVES, lane, 3, lds + 49152 + wave * 9216);
        for (int i_ = 0; i_ < 4 * REPN(2); ++i_) { const int i = i_ & 3; const int qt = (i == 0) ? 63 - aa : (i == 1) ? aa : (i == 2) ? 47 - aa : 16 + aa;
            AttnArgs A; A.Q0 = QK + 64 * hh; A.Q1 = QK + 1024 + 32 * hh; A.ldq = 1536; A.K0 = KH + (size_t)hh * S * 64; A.ldk0 = 64; A.K1 = Kr; A.ldk1 = 32;
            A.Vt = VT + (size_t)(64 * hh) * S; A.ldv = S; A.O = AO + 64 * hh; A.ldo = 1024; A.window = 0; A.Qb = nullptr; A.Kb = nullptr; A.lam = 0.f; A.gain = nullptr; A.gscale = 0.f; A.kbound = kbound;
            attn_unit<96, 64, false, BgConv>(lds, A, qt * 256, tid, lane, wave, bg); }
        bg.drain();
    }
    SEAM();
    if (RUN) { IDS1; pg8::Gemm g{AO, Wb + 3 * MiB / 2, S, 1024, 1024}; pg8::StaticOrder So; So.init(S, 1024, G, cb); pg8::EpiBf16P E{Y16, 1024, 1.0f};
        pg8::gemm_phase<pg8::EpiBf16P, pg8::StaticOrder, true, true, 1008>(lds, g, So, E, wave, c.ph + 1000); }
    SEAM();
}
__device__ __forceinline__ void nsa_layer(const Args& a, Ctx& c) {
    CTX_LOCALS
    bf16* Wb = WSP(bf16, WS_WNSA);
    bf16* P = WSP(bf16, WS_MISC + NSA_P); bf16* ACK = WSP(bf16, WS_MISC + NSA_ACK); bf16* ACV = WSP(bf16, WS_MISC + NSA_ACV);
    bf16* HK = WSP(bf16, WS_MISC + NSA_HK); bf16* HV = WSP(bf16, WS_MISC + NSA_HV); bf16* KC = WSP(bf16, WS_MISC + NSA_KC); bf16* VCT = WSP(bf16, WS_MISC + NSA_VCT);
    if (RUN) { IDS2;
        { pg8::Gemm g{XB, Wb, S, 1536, 1024}; pg8::StaticOrder So; So.init(S, 1536, G, cb);
          pg8::EpiRope64 E{QK, 1024, cs64, 24, 4, QS64, 0x7fffffff, 1, 0, 16, KH, S, AMX + 2};
          pg8::gemm_phase<pg8::EpiRope64, pg8::StaticOrder, true, true, 1009>(lds, g, So, E, wave, c.ph + 1000); }
        { pg8::Gemm g{XB, Wb + 1536 * 1024, S, 768, 1024}; pg8::StaticOrder So; So.init(S, 768, G, (cb + 128) & 255);
          pg8::EpiBf16P E{P, 768, 1.0f};
          pg8::gemm_phase<pg8::EpiBf16P, pg8::StaticOrder, true, true, 1010>(lds, g, So, E, wave, c.ph + 1000); }
        { pg8::Gemm g{Wb + 2304 * 1024, XB, 512, S, 1024}; pg8::StaticOrder So; So.init(512, S, G, (cb + 192) & 255);
          pg8::EpiVtTiled E{VT, 6, S};
          pg8::gemm_phase<pg8::EpiVtTiled, pg8::StaticOrder, true, true, 1011>(lds, g, So, E, wave, c.ph + 1000); }
    }
    SEAM();
    if (RUN) { IDS2; phase_nsa_cmp_gather(a, tid); }
    SEAM();
    if (RUN) { IDS2;
        { pg8::Gemm g{ACK, Wb + 6 * MiB / 2, 4096, 256, 2048}; pg8::StaticOrder So; So.init(4096, 256, G, cb); pg8::EpiGeluBf16 E{HK, 256};
          pg8::gemm_phase<pg8::EpiGeluBf16, pg8::StaticOrder, true, true, 1012>(lds, g, So, E, wave, c.ph + 1000); }
        { pg8::Gemm g{ACV, Wb + 7 * MiB / 2, 4096, 256, 2048}; pg8::StaticOrder So; So.init(4096, 256, G, (cb + 240) & 255); pg8::EpiGeluBf16 E{HV, 256};
          pg8::gemm_phase<pg8::EpiGeluBf16, pg8::StaticOrder, true, true, 1013>(lds, g, So, E, wave, c.ph + 1000); }
        if (cb >= 32) {
        for (int idx = cb - 32; idx < 1024 * REPN(6); idx += 224) { const int qt = (idx & 1023) >> 4, hh = idx & 15;
            AttnArgs A; A.Q0 = QK + 64 * hh; A.Q1 = nullptr; A.ldq = 1024; A.K0 = KH + (size_t)(4 + (hh >> 2)) * S * 64; A.ldk0 = 64; A.K1 = nullptr; A.ldk1 = 0;
            A.Vt = VT + (size_t)(256 + 64 * (hh >> 2)) * S; A.ldv = S; A.O = OH + (size_t)S * 1024 + 64 * hh; A.ldo = 1024; A.window = 512; A.Qb = nullptr; A.Kb = nullptr; A.lam = 0.f; A.gain = nullptr; A.gscale = 0.f; A.kbound = 2.04f * __builtin_bit_cast(float, xb_ld(AMX + 2));
            { BgNone nb_; attn_unit<64, 64>(lds, A, qt * 256, tid, lane, wave, nb_); } }
        }
    }
    SEAM();
    if (RUN) { IDS2;
        { pg8::Gemm g{HK, Wb + 8 * MiB / 2, 4096, 256, 256}; pg8::StaticOrder So; So.init(4096, 256, G, cb);
          pg8::EpiRope64 E{KC, 64, cs64, 1, 0, 1.0f, 1023, 16, 31, 1 << 30, nullptr, 0, AMX + 3};
          pg8::gemm_phase<pg8::EpiRope64, pg8::StaticOrder, true, true, 1014>(lds, g, So, E, wave, c.ph + 1000); }
        { pg8::Gemm g{Wb + 8 * MiB / 2 + 65536, HV, 256, 4096, 256}; pg8::StaticOrder So; So.init(256, 4096, G, (cb + 240) & 255);
          pg8::EpiBf16P E{VCT, 4096, 1.0f};
          pg8::gemm_phase<pg8::EpiBf16P, pg8::StaticOrder, true, true, 1015>(lds, g, So, E, wave, c.ph + 1000); }
    }
    SEAM();
    if (RUN) { IDS2;
        const float kb_sel = 2.04f * __builtin_bit_cast(float, xb_ld(AMX + 2)), kb_cmp = 2.04f * __builtin_bit_cast(float, xb_ld(AMX + 3)); (void)kb_cmp;
        for (int i_ = 0; i_ < 4 * REPN(3); ++i_) { const int i = i_ & 3; const int idx = i * 256 + cb, gg = idx & 3, aa = cb >> 2;
            const int T = (i == 0) ? 255 - aa : (i == 1) ? aa : (i == 2) ? 191 - aa : 64 + aa;
            nsa_cmp_unit(lds, a, T, gg, tid, lane, wave, kb_cmp);
            asm volatile("s_waitcnt vmcnt(0)" ::: "memory"); __syncthreads();
            nsa_sel_unit(lds, a, T, gg, tid, lane, wave, kb_sel);
            __syncthreads(); }
    }
    SEAM();
    if (RUN) { IDS2; pg8::Gemm g{AO, Wb + 9 * MiB / 2, S, 1024, 1024}; pg8::StaticOrder So; So.init(S, 1024, G, cb); pg8::EpiBf16P E{Y16, 1024, 1.0f};
        pg8::gemm_phase<pg8::EpiBf16P, pg8::StaticOrder, true, true, 1016>(lds, g, So, E, wave, c.ph + 1000); }
    SEAM();
}
template <int LAYER> __device__ __forceinline__ void moe_layer(const Args& a, Ctx& c) {
    CTX_LOCALS
    bf16* Wm = WSP(bf16, WS_WMOE + (size_t)LAYER * 192 * MiB);
    bf16* Act = WSP(bf16, WS_ACT); bf16* Ys = WSP(bf16, WS_YS);
    if (RUN) { IDS3; phase_ln1_router(a, lds, LAYER, tid, lane, wave); }
    SEAM();
    if (RUN) { IDS3; phase_place(a, lds, LAYER, tid, lane, wave); }
    SEAM();
    if (RUN) { IDS3;
        const int ntl = (int)lc[LC_NT], xcd = cb & 7, t0 = (ntl * xcd) >> 3, t1 = (ntl * (xcd + 1)) >> 3;
        { const v4u* src = (const v4u*)(WSP(unsigned short, WS_ROUTE + 2 * MiB) + (size_t)t0 * 256); LAS v4u* dst = (LAS v4u*)(lds + LDS_GIDX_OFF);
          for (int q = tid; q < (t1 - t0) * 32; q += NTHREADS) dst[q] = src[q]; }
        __syncthreads();
        pg8::MoeOrder So{8, G, cb, ntl, (const LAS int*)(lc + LC_TILEE), REPN(5)};
        {
        pg8::Gemm g{WSP(bf16, WS_AS), Wm, MOE_ROWS, 32 * 2048, 512, (const LAS unsigned short*)(lds + LDS_GIDX_OFF), t0};
        pg8::EpiSwiglu E{Act, a.in[I_MOE_BGU] + (size_t)LAYER * 32 * 2048, 1.0f / 64.0f, (unsigned char*)Act};
        pg8::gemm_phase<pg8::EpiSwiglu, pg8::MoeOrder, true, true, 1702, true, true, false, 1>(lds, g, So, E, wave, c.ph + 1000); } }
    SEAM();
    if (RUN) { IDS3; pg8::MoeOrder So{4, G, cb, (int)lc[LC_NT], (const LAS int*)(lc + LC_TILEE), REPN(5)};
        {
        pg8::Gemm g{Act, Wm + 64 * MiB, MOE_ROWS, 32 * 1024, 512};
        pg8::EpiDown E{Ys, a.in[I_MOE_BDN] + (size_t)LAYER * 32 * 1024, WSP(float, WS_ROUTE + 786432), (unsigned char*)Ys, 1.0f / 64.0f};
        pg8::gemm_phase<pg8::EpiDown, pg8::MoeOrder, true, true, 1019, false, true, false, 1>(lds, g, So, E, wave, c.ph + 1000); } }
    SEAM();
    if (RUN) { IDS3; phase_ln2(a, LAYER, LAYER == NLAYER - 1 ? a.out : nullptr, tid, lane, wave); }
    SEAM();
}

__global__ void __launch_bounds__(NTHREADS, 2) fwd_kernel(Args a) {
    extern __shared__ __attribute__((aligned(16))) unsigned char lds_raw[];
    Ctx c;
    c.lds = (LAS unsigned char*)lds_raw;
    { const int tid0 = threadIdx.x;
      c.wave = __builtin_amdgcn_readfirstlane(tid0 >> 6);
      c.G = gridDim.x; c.cb = blockIdx.x;
      c.lc = (LAS unsigned*)(c.lds + LDSCTL_OFF);
      for (int u = tid0; u < (LDS_BYTES - LDSCTL_OFF) / 4; u += NTHREADS) c.lc[u] = 0u;
      __syncthreads();
      c.bar = xcd_barrier_post(WSP(unsigned, WS_CTL) + CW_BAR, (volatile LAS unsigned*)c.lc, tid0); }
    c.ph = 0;
    if (RUN) { IDS4; for (int rep = 0; rep < REPN(0); ++rep) phase_prologue(a, c.lds, tid, lane, wave); }
    SEAM();
    da_layer<0>(a, c);  moe_layer<0>(a, c);
    mla_layer(a, c);    moe_layer<1>(a, c);
    nsa_layer(a, c);    moe_layer<2>(a, c);
    da_layer<3>(a, c);  moe_layer<3>(a, c);
}

static int add_job(Args& a, const float* src, bf16* dst, long long sbs, long long dbs, int ld, int K, int ncols, int col0, int mode, int nbatch, int f8 = 0) {
    Job& J = a.jobs[a.njobs]; J.src = src; J.dst = dst; J.sbs = sbs; J.dbs = dbs; J.ld = ld; J.K = K; J.ncols = ncols; J.col0 = col0; J.mode = mode; J.nbatch = nbatch; J.item0 = a.nitems; J.pad = f8;
    a.nitems += nbatch * (K / (f8 ? 128 : 64)) * ((ncols + 63) / 64); return a.njobs++;
}
extern "C" void kernel_launch(void* const* d_in, const int* in_sizes, int n_in, void* d_out, int out_size, void* d_ws, size_t ws_size, hipStream_t stream) {
    static int grid = 0;
    if (grid == 0) {
        if (n_in != N_IN || out_size != S * D || ws_size < WS_END) { fprintf(stderr, "kernel_launch: unexpected shapes: n_in %d out %d ws %zu (need %zu)\n", n_in, out_size, ws_size, (size_t)WS_END); grid = -1; return; }
        int dev = 0, cus = 0, per_cu = 0;
        hipGetDevice(&dev); hipDeviceGetAttribute(&cus, hipDeviceAttributeMultiprocessorCount, dev);
        if (hipFuncSetAttribute((const void*)fwd_kernel, hipFuncAttributeMaxDynamicSharedMemorySize, LDS_BYTES) != hipSuccess) { fprintf(stderr, "kernel_launch: hipFuncSetAttribute failed\n"); grid = -1; return; }
        hipOccupancyMaxActiveBlocksPerMultiprocessor(&per_cu, (const void*)fwd_kernel, NTHREADS, LDS_BYTES);
        (void)hipGetLastError();
        if (per_cu < 1 || cus < 256) { fprintf(stderr, "kernel_launch: occupancy %d, CUs %d: this kernel needs 256 resident workgroups\n", per_cu, cus); grid = -1; return; }
        grid = 256;
    }
    if (grid < 0) return;
    hipMemsetAsync((char*)d_ws + WS_CTL, 0, CTL_ZERO_BYTES, stream);
    Args a; memset(&a, 0, sizeof(a));
    for (int i = 0; i < N_IN; ++i) a.in[i] = (const float*)d_in[i];
    a.out = (float*)d_out; a.ws = (unsigned char*)d_ws;
    unsigned char* ws = (unsigned char*)d_ws;
    const long long KK = 1024;
    for (int j = 0; j < 2; ++j) {
        bf16* Wb = (bf16*)(ws + WS_WDA + (size_t)j * 8 * MiB);
        add_job(a, a.in[I_DA_WIN] + (size_t)j * 1024 * 3072, Wb, 0, 0, 3072, 1024, 2048, 0, CM_ROPE64, 1);
        add_job(a, a.in[I_DA_WIN] + (size_t)j * 1024 * 3072, Wb + 2048 * 1024, 0, 0, 3072, 1024, 1024, 2048, CM_IDENT, 1);
        add_job(a, a.in[I_DA_WOUT] + (size_t)j * 1024 * 1024, Wb + 3072 * 1024, 0, 0, 1024, 1024, 1024, 0, CM_IDENT, 1);
    }
    { bf16* Wb = (bf16*)(ws + WS_WMLA);
      add_job(a, a.in[I_MLA_WIN], Wb, 0, 0, 416, 1024, 416, 0, CM_IDENT, 1);
      add_job(a, a.in[I_MLA_WUQ], Wb + 1 * MiB / 2, 0, 0, 1536, 256, 1536, 0, CM_MLAQ, 1);
      add_job(a, a.in[I_MLA_WUKV], Wb + 2 * MiB / 2, 0, 0, 2048, 128, 2048, 0, CM_MLAKV, 1);
      add_job(a, a.in[I_MLA_WOUT], Wb + 3 * MiB / 2, 0, 0, 1024, 1024, 1024, 0, CM_IDENT, 1); }
    { bf16* Wb = (bf16*)(ws + WS_WNSA);
      add_job(a, a.in[I_NSA_WIN], Wb, 0, 0, 2608, 1024, 2608, 0, CM_NSAIN, 1);
      add_job(a, a.in[I_NSA_KW1], Wb + 6 * MiB / 2, 0, 0, 256, 2048, 256, 0, CM_IDENT, 1);
      add_job(a, a.in[I_NSA_VW1], Wb + 7 * MiB / 2, 0, 0, 256, 2048, 256, 0, CM_IDENT, 1);
      add_job(a, a.in[I_NSA_KW2], Wb + 8 * MiB / 2, 0, 0, 64, 256, 64, 0, CM_ROPE64, 1);
      add_job(a, a.in[I_NSA_VW2], Wb + 8 * MiB / 2 + 65536, 0, 0, 64, 256, 64, 0, CM_IDENT, 1);
      add_job(a, a.in[I_NSA_WOUT], Wb + 9 * MiB / 2, 0, 0, 1024, 1024, 1024, 0, CM_IDENT, 1); }
    for (int L = 0; L < NLAYER; ++L) {
        bf16* Wm = (bf16*)(ws + WS_WMOE + (size_t)L * 192 * MiB);
        add_job(a, a.in[I_MOE_WGU] + (size_t)L * 32 * KK * 2048, Wm, KK * 2048, 2048 * KK, 2048, 1024, 2048, 0, CM_SWIGLU, 32, 2);
        add_job(a, a.in[I_MOE_WDN] + (size_t)L * 32 * KK * 1024, Wm + 64 * MiB, KK * 1024, 1024 * KK, 1024, 1024, 1024, 0, CM_IDENT, 32, 2);
    }
    a.nitems = a.jobs[18].item0;
    a.ph_lo = 0; a.ph_hi = 1 << 20;
    hipLaunchKernelGGL(fwd_kernel, dim3(grid), dim3(NTHREADS), LDS_BYTES, stream, a);
    const hipError_t le = hipPeekAtLastError();
    if (le != hipSuccess) fprintf(stderr, "kernel_launch: launch failed: %s\n", hipGetErrorName(le));
}
```

```cpp
#ifndef REP
#define REP 0
#endif
#include <hip/hip_runtime.h>
#include <cstdio>
#include <cstdint>
#include <cstring>
namespace pg8 {
#define PG8_LAS __attribute__((address_space(3)))
typedef unsigned short bf16_t;
typedef short bf16x8 __attribute__((ext_vector_type(8)));
typedef float f32x4 __attribute__((ext_vector_type(4)));
typedef int i32x4 __attribute__((ext_vector_type(4)));
typedef long i64x2 __attribute__((ext_vector_type(2)));
typedef unsigned u32x4 __attribute__((ext_vector_type(4)));
constexpr int BM = 256, BK = 64, HALF = 128, HTB = HALF * BK * 2  , STAGE_BYTES = 8 * HTB, NXCD = 8, WGM = 8;

__host__ __device__ __forceinline__ int lds_byte(int r, int c) { const int st = (r >> 4) * 2 + (c >> 5), rr = r & 15, cc = c & 31, ob = rr * 64 + cc * 2; return st * 1024 + (ob ^ (((ob >> 9) & 1) << 5)); }
__host__ __device__ __forceinline__ void stage_rc(int b, int& R, int& C) { const int st = b / 1024, sb = b % 1024, swz = sb ^ (((sb >> 9) & 1) << 5); R = (st >> 1) * 16 + swz / 64; C = (st & 1) * 32 + (swz % 64) / 2; }
__host__ __device__ __forceinline__ int perm32(int rho) { const int n = rho >> 4, i = rho & 15; return 8 * (i >> 2) + 4 * n + (i & 3); }

struct Unit { int pm, pn, half; };
struct Gemm { const bf16_t* A; const bf16_t* Bt; int M, N, K; const PG8_LAS unsigned short* gidx; int gtile0; };

struct StaticOrder {
    int nM, nN, nwg, G, c;
    __host__ __device__ void init(int M, int N, int G_, int c_) { nM = M / BM; nN = N / BM; nwg = nM * nN; G = G_; c = c_; }
    __host__ __device__ bool next(int i, Unit& u) const {
        long L = (long)i * G + c;
#if defined(REP) && ((REP >> 8) & 1)
        if (L >= 2 * nwg) return false; if (L >= nwg) L -= nwg;
#else
        if (L >= nwg) return false;
#endif
        int wgid = (int)L; { const int q = nwg / NXCD, r = nwg % NXCD, xcd = wgid % NXCD, off = wgid / NXCD; wgid = (xcd < r ? xcd * (q + 1) : r * (q + 1) + (xcd - r) * q) + off; }
        const int nig = WGM * nN, gid = wgid / nig, fm = gid * WGM, gsz = (nM - fm) < WGM ? (nM - fm) : WGM;
        u.pm = fm + ((wgid % nig) % gsz); u.pn = (wgid % nig) / gsz; u.half = 0; return true;
    }
    __device__ __forceinline__ void a_ready(const Unit&) const {}
    __device__ __forceinline__ void done(const Unit&) const {}
};

__device__ __forceinline__ unsigned cvt_pk_bf16(float lo, float hi) { unsigned r; asm volatile("v_cvt_pk_bf16_f32 %0, %1, %2" : "=v"(r) : "v"(lo), "v"(hi)); return r; }
typedef float f32x2 __attribute__((ext_vector_type(2)));
typedef unsigned u32x2 __attribute__((ext_vector_type(2)));
struct __attribute__((aligned(8))) cs_t { float c, s; };
struct EpiBf16P {
    static constexpr bool PERM = true, AFTER_DRAIN = false, AMAX = false;
    bf16_t* O; int ldc; float scale;
    __device__ __forceinline__ void operator()(const f32x4 (&acc)[2][2][4][2], const Unit& u, int wr, int wc, int fr, int fq) const {
        const int row0 = u.pm * BM + wr * 64 + fr, col0 = u.pn * BM + wc * 32 + 8 * fq;
#pragma unroll
        for (int ai = 0; ai < 2; ++ai)
#pragma unroll
            for (int m = 0; m < 4; ++m) { bf16_t* rowp = O + (size_t)(row0 + ai * HALF + m * 16) * ldc + col0;
#pragma unroll
                for (int bj = 0; bj < 2; ++bj) { const f32x4 v0 = acc[ai][bj][m][0] * scale, v1 = acc[ai][bj][m][1] * scale;
                    u32x4 w; w.x = cvt_pk_bf16(v0[0], v0[1]); w.y = cvt_pk_bf16(v0[2], v0[3]); w.z = cvt_pk_bf16(v1[0], v1[1]); w.w = cvt_pk_bf16(v1[2], v1[3]);
                    *(u32x4*)(rowp + bj * HALF) = w; } }
    }
};
struct EpiHeadMajor64 {
    static constexpr bool PERM = true, AFTER_DRAIN = false, AMAX = true;
    bf16_t* O; int nrows; unsigned* amax;
    __device__ __forceinline__ void operator()(const f32x4 (&acc)[2][2][4][2], const Unit& u, int wr, int wc, int fr, int fq) const {
        const int row0 = u.pm * BM + wr * 64 + fr, col0 = u.pn * BM + wc * 32 + 8 * fq;
#pragma unroll
        for (int ai = 0; ai < 2; ++ai)
#pragma unroll
            for (int m = 0; m < 4; ++m) { const int row = row0 + ai * HALF + m * 16;
#pragma unroll
                for (int bj = 0; bj < 2; ++bj) { const int col = col0 + bj * HALF; const f32x4 v0 = acc[ai][bj][m][0], v1 = acc[ai][bj][m][1];
                    u32x4 w; w.x = cvt_pk_bf16(v0[0], v0[1]); w.y = cvt_pk_bf16(v0[2], v0[3]); w.z = cvt_pk_bf16(v1[0], v1[1]); w.w = cvt_pk_bf16(v1[2], v1[3]);
                    *(u32x4*)(O + ((size_t)(col >> 6) * nrows + row) * 64 + (col & 63)) = w; } }
    }
};
struct EpiVtTiled {
    static constexpr bool PERM = true, AFTER_DRAIN = false, AMAX = false;
    bf16_t* O; int dvshift; int ntok;
    __device__ __forceinline__ void operator()(const f32x4 (&acc)[2][2][4][2], const Unit& u, int wr, int wc, int fr, int fq) const {
        const int row0 = u.pm * BM + wr * 64 + fr, col0 = u.pn * BM + wc * 32 + 8 * fq; const int DVm = (1 << dvshift) - 1, nt = ntok >> 6;
#pragma unroll
        for (int ai = 0; ai < 2; ++ai)
#pragma unroll
            for (int m = 0; m < 4; ++m) { const int row = row0 + ai * HALF + m * 16; const int head = row >> dvshift, dv = row & DVm;
#pragma unroll
                for (int bj = 0; bj < 2; ++bj) { const int col = col0 + bj * HALF; const f32x4 v0 = acc[ai][bj][m][0], v1 = acc[ai][bj][m][1];
                    u32x4 w; w.x = cvt_pk_bf16(v0[0], v0[1]); w.y = cvt_pk_bf16(v0[2], v0[3]); w.z = cvt_pk_bf16(v1[0], v1[1]); w.w = cvt_pk_bf16(v1[2], v1[3]);
                    *(u32x4*)(O + ((((size_t)head * nt + (col >> 6)) << dvshift) + dv) * 64 + (col & 63)) = w; } }
    }
};
struct EpiF32 {
    static constexpr bool PERM = false, AFTER_DRAIN = false, AMAX = true;
    float* O; int ldc; unsigned* amax;
    __device__ __forceinline__ void operator()(const f32x4 (&acc)[2][2][4][2], const Unit& u, int wr, int wc, int fr, int fq) const {
        const int row0 = u.pm * BM + wr * 64 + fr, col0 = u.pn * BM + wc * 32 + 4 * fq;
#pragma unroll
        for (int ai = 0; ai < 2; ++ai)
#pragma unroll
            for (int m = 0; m < 4; ++m) { float* rowp = O + (size_t)(row0 + ai * HALF + m * 16) * ldc + col0;
#pragma unroll
                for (int bj = 0; bj < 2; ++bj)
#pragma unroll
                    for (int n = 0; n < 2; ++n) *(f32x4*)(rowp + bj * HALF + n * 16) = acc[ai][bj][m][n]; }
    }
};
struct EpiRope64 {
    static constexpr bool PERM = true, AFTER_DRAIN = false, AMAX = true;
    bf16_t* O; int ldc; const cs_t* cs; int nheads; int nq_tiles; float qscale; int posmask, posmul, posadd; int hm_from; bf16_t* Ohm; int hm_rows; unsigned* amax;
    __device__ __forceinline__ void operator()(const f32x4 (&acc)[2][2][4][2], const Unit& u, int wr, int wc, int fr, int fq) const {
        const int hv = 4 * u.pn + wc; if (hv >= nheads) return;
        const bool hm = hv >= hm_from;
        const float sc = (u.pn < nq_tiles) ? qscale : 1.0f;
        const int row0 = u.pm * BM + wr * 64 + fr, y0 = 8 * fq;
#pragma unroll
        for (int ai = 0; ai < 2; ++ai)
#pragma unroll
            for (int m = 0; m < 4; ++m) { const int row = row0 + ai * HALF + m * 16; const int pos = (row & posmask) * posmul + posadd;
                const f32x4* cp = (const f32x4*)(cs + (size_t)pos * 32 + y0);
                const f32x4 c0 = cp[0], c1 = cp[1], c2 = cp[2], c3 = cp[3];
                const f32x4 a0 = acc[ai][0][m][0], a1 = acc[ai][0][m][1], b0 = acc[ai][1][m][0], b1 = acc[ai][1][m][1];
                float o1[8], o2[8];
                o1[0] = a0[0] * c0[0] - b0[0] * c0[1]; o2[0] = b0[0] * c0[0] + a0[0] * c0[1];
                o1[1] = a0[1] * c0[2] - b0[1] * c0[3]; o2[1] = b0[1] * c0[2] + a0[1] * c0[3];
                o1[2] = a0[2] * c1[0] - b0[2] * c1[1]; o2[2] = b0[2] * c1[0] + a0[2] * c1[1];
                o1[3] = a0[3] * c1[2] - b0[3] * c1[3]; o2[3] = b0[3] * c1[2] + a0[3] * c1[3];
                o1[4] = a1[0] * c2[0] - b1[0] * c2[1]; o2[4] = b1[0] * c2[0] + a1[0] * c2[1];
                o1[5] = a1[1] * c2[2] - b1[1] * c2[3]; o2[5] = b1[1] * c2[2] + a1[1] * c2[3];
                o1[6] = a1[2] * c3[0] - b1[2] * c3[1]; o2[6] = b1[2] * c3[0] + a1[2] * c3[1];
                o1[7] = a1[3] * c3[2] - b1[3] * c3[3]; o2[7] = b1[3] * c3[2] + a1[3] * c3[3];
                bf16_t* rowp = hm ? (Ohm + ((size_t)(hv - hm_from) * hm_rows + row) * 64 + y0) : (O + (size_t)row * ldc + 64 * hv + y0);
                u32x4 w; w.x = cvt_pk_bf16(o1[0] * sc, o1[1] * sc); w.y = cvt_pk_bf16(o1[2] * sc, o1[3] * sc); w.z = cvt_pk_bf16(o1[4] * sc, o1[5] * sc); w.w = cvt_pk_bf16(o1[6] * sc, o1[7] * sc);
                *(u32x4*)rowp = w;
                w.x = cvt_pk_bf16(o2[0] * sc, o2[1] * sc); w.y = cvt_pk_bf16(o2[2] * sc, o2[3] * sc); w.z = cvt_pk_bf16(o2[4] * sc, o2[5] * sc); w.w = cvt_pk_bf16(o2[6] * sc, o2[7] * sc);
                *(u32x4*)(rowp + 32) = w; }
    }
};
struct EpiRope16 {
    static constexpr bool PERM = true, AFTER_DRAIN = false, AMAX = false;
    bf16_t* O; int ldc; const cs_t* cs; float qscale;
    __device__ __forceinline__ void operator()(const f32x4 (&acc)[2][2][4][2], const Unit& u, int wr, int wc, int fr, int fq) const {
        const int row0 = u.pm * BM + wr * 64 + fr; const float sc = qscale;
        const int head = 8 * u.pn + 2 * wc + (fq >> 1), y0 = 8 * (fq & 1);
#pragma unroll
        for (int ai = 0; ai < 2; ++ai)
#pragma unroll
            for (int m = 0; m < 4; ++m) { const int row = row0 + ai * HALF + m * 16;
                const f32x4* cp = (const f32x4*)(cs + (size_t)row * 16 + y0);
                const f32x4 c0 = cp[0], c1 = cp[1], c2 = cp[2], c3 = cp[3];
                const f32x4 a0 = acc[ai][0][m][0], a1 = acc[ai][0][m][1], b0 = acc[ai][1][m][0], b1 = acc[ai][1][m][1];
                float o1[8], o2[8];
                o1[0] = a0[0] * c0[0] - b0[0] * c0[1]; o2[0] = b0[0] * c0[0] + a0[0] * c0[1];
                o1[1] = a0[1] * c0[2] - b0[1] * c0[3]; o2[1] = b0[1] * c0[2] + a0[1] * c0[3];
                o1[2] = a0[2] * c1[0] - b0[2] * c1[1]; o2[2] = b0[2] * c1[0] + a0[2] * c1[1];
                o1[3] = a0[3] * c1[2] - b0[3] * c1[3]; o2[3] = b0[3] * c1[2] + a0[3] * c1[3];
                o1[4] = a1[0] * c2[0] - b1[0] * c2[1]; o2[4] = b1[0] * c2[0] + a1[0] * c2[1];
                o1[5] = a1[1] * c2[2] - b1[1] * c2[3]; o2[5] = b1[1] * c2[2] + a1[1] * c2[3];
                o1[6] = a1[2] * c3[0] - b1[2] * c3[1]; o2[6] = b1[2] * c3[0] + a1[2] * c3[1];
                o1[7] = a1[3] * c3[2] - b1[3] * c3[3]; o2[7] = b1[3] * c3[2] + a1[3] * c3[3];
                bf16_t* rowp = O + (size_t)row * ldc + 32 * head + y0;
                u32x4 w; w.x = cvt_pk_bf16(o1[0] * sc, o1[1] * sc); w.y = cvt_pk_bf16(o1[2] * sc, o1[3] * sc); w.z = cvt_pk_bf16(o1[4] * sc, o1[5] * sc); w.w = cvt_pk_bf16(o1[6] * sc, o1[7] * sc);
                *(u32x4*)rowp = w;
                w.x = cvt_pk_bf16(o2[0] * sc, o2[1] * sc); w.y = cvt_pk_bf16(o2[2] * sc, o2[3] * sc); w.z = cvt_pk_bf16(o2[4] * sc, o2[5] * sc); w.w = cvt_pk_bf16(o2[6] * sc, o2[7] * sc);
                *(u32x4*)(rowp + 16) = w; }
    }
};
__device__ __forceinline__ float gelu_tanh(float x) {
    const float u2 = 1.5957691216057308f * (x + 0.044715f * x * x * x);
    return x * __builtin_amdgcn_rcpf(1.0f + __builtin_amdgcn_exp2f(-1.4426950408889634f * u2));
}
struct EpiGeluBf16 {
    static constexpr bool PERM = true, AFTER_DRAIN = false, AMAX = false;
    bf16_t* O; int ldc;
    __device__ __forceinline__ void operator()(const f32x4 (&acc)[2][2][4][2], const Unit& u, int wr, int wc, int fr, int fq) const {
        const int row0 = u.pm * BM + wr * 64 + fr, col0 = u.pn * BM + wc * 32 + 8 * fq;
#pragma unroll
        for (int ai = 0; ai < 2; ++ai)
#pragma unroll
            for (int m = 0; m < 4; ++m) { bf16_t* rowp = O + (size_t)(row0 + ai * HALF + m * 16) * ldc + col0;
#pragma unroll
                for (int bj = 0; bj < 2; ++bj) { const f32x4 v0 = acc[ai][bj][m][0], v1 = acc[ai][bj][m][1];
                    u32x4 w; w.x = cvt_pk_bf16(gelu_tanh(v0[0]), gelu_tanh(v0[1])); w.y = cvt_pk_bf16(gelu_tanh(v0[2]), gelu_tanh(v0[3]));
                    w.z = cvt_pk_bf16(gelu_tanh(v1[0]), gelu_tanh(v1[1])); w.w = cvt_pk_bf16(gelu_tanh(v1[2]), gelu_tanh(v1[3]));
                    *(u32x4*)(rowp + bj * HALF) = w; } }
    }
};
__device__ __forceinline__ float swiglu1(float g, float l) {
    const float hg = fminf(g, 7.0f), hl = fminf(fmaxf(l, -7.0f), 7.0f);
    return hg * __builtin_amdgcn_rcpf(1.0f + __builtin_amdgcn_exp2f(-1.702f * 1.4426950408889634f * hg)) * (hl + 1.0f);
}
struct EpiSwiglu {
    static constexpr bool PERM = true, AFTER_DRAIN = false, AMAX = false;
    bf16_t* O; const float* bgu; float ws; unsigned char* O8;
    __device__ __forceinline__ void operator()(const f32x4 (&acc)[2][2][4][2], const Unit& u, int wr, int wc, int fr, int fq) const {
        const int e = u.pn >> 3, pnl = u.pn & 7;
        const int row0 = u.pm * BM + wr * 64 + fr, f0 = pnl * 128 + wc * 32 + 8 * fq;
        const f32x4* bp = (const f32x4*)(bgu + (size_t)e * 2048 + 2 * f0);
        const f32x4 q0 = bp[0], q1 = bp[1], q2 = bp[2], q3 = bp[3];
#pragma unroll
        for (int ai = 0; ai < 2; ++ai)
#pragma unroll
            for (int m = 0; m < 4; ++m) { bf16_t* rowp = O + (size_t)(row0 + ai * HALF + m * 16) * 1024 + f0;
                const f32x4 g0 = acc[ai][0][m][0] * ws, g1 = acc[ai][0][m][1] * ws, l0 = acc[ai][1][m][0] * ws, l1 = acc[ai][1][m][1] * ws;
                u32x4 w;
                w.x = cvt_pk_bf16(swiglu1(g0[0] + q0[0], l0[0] + q0[1]), swiglu1(g0[1] + q0[2], l0[1] + q0[3]));
                w.y = cvt_pk_bf16(swiglu1(g0[2] + q1[0], l0[2] + q1[1]), swiglu1(g0[3] + q1[2], l0[3] + q1[3]));
                w.z = cvt_pk_bf16(swiglu1(g1[0] + q2[0], l1[0] + q2[1]), swiglu1(g1[1] + q2[2], l1[1] + q2[3]));
                w.w = cvt_pk_bf16(swiglu1(g1[2] + q3[0], l1[2] + q3[1]), swiglu1(g1[3] + q3[2], l1[3] + q3[3]));
                if (O8 == nullptr) *(u32x4*)rowp = w;
                else { int p0_ = __builtin_amdgcn_cvt_pk_fp8_f32(__builtin_bit_cast(float, w.x << 16), __builtin_bit_cast(float, w.x & 0xffff0000u), 0, false);
                    p0_ = __builtin_amdgcn_cvt_pk_fp8_f32(__builtin_bit_cast(float, w.y << 16), __builtin_bit_cast(float, w.y & 0xffff0000u), p0_, true);
                    int p1_ = __builtin_amdgcn_cvt_pk_fp8_f32(__builtin_bit_cast(float, w.z << 16), __builtin_bit_cast(float, w.z & 0xffff0000u), 0, false);
                    p1_ = __builtin_amdgcn_cvt_pk_fp8_f32(__builtin_bit_cast(float, w.w << 16), __builtin_bit_cast(float, w.w & 0xffff0000u), p1_, true);
                    *(u32x2*)(O8 + (size_t)(row0 + ai * HALF + m * 16) * 1024 + f0) = (u32x2){(unsigned)p0_, (unsigned)p1_}; } }
    }
};
struct EpiDown {
    static constexpr bool PERM = true, AFTER_DRAIN = false, AMAX = false;
    bf16_t* O; const float* bd; const float* rgate; unsigned char* O8; float ws;
    __device__ __forceinline__ void operator()(const f32x4 (&acc)[2][2][4][2], const Unit& u, int wr, int wc, int fr, int fq) const {
        const int e = u.pn >> 2, pnl = u.pn & 3;
        const int row0 = u.pm * BM + wr * 64 + fr, col0 = pnl * BM + wc * 32 + 8 * fq;
        f32x4 bv[2][2];
#pragma unroll
        for (int bj = 0; bj < 2; ++bj)
#pragma unroll
            for (int n = 0; n < 2; ++n) bv[bj][n] = *(const f32x4*)(bd + (size_t)e * 1024 + col0 + bj * HALF + 4 * n);
#pragma unroll
        for (int ai = 0; ai < 2; ++ai)
#pragma unroll
            for (int m = 0; m < 4; ++m) { const int row = row0 + ai * HALF + m * 16; const float gw = rgate[row]; bf16_t* rowp = O + (size_t)row * 1024 + col0;
#pragma unroll
                for (int bj = 0; bj < 2; ++bj) { const f32x4 v0 = (acc[ai][bj][m][0] * ws + bv[bj][0]) * gw, v1 = (acc[ai][bj][m][1] * ws + bv[bj][1]) * gw;
                    if (O8 == nullptr) { u32x4 w; w.x = cvt_pk_bf16(v0[0], v0[1]); w.y = cvt_pk_bf16(v0[2], v0[3]); w.z = cvt_pk_bf16(v1[0], v1[1]); w.w = cvt_pk_bf16(v1[2], v1[3]);
                    *(u32x4*)(rowp + bj * HALF) = w; }
                    else {
                        int p0_ = __builtin_amdgcn_cvt_pk_fp8_f32(v0[0] * 16.f, v0[1] * 16.f, 0, false); p0_ = __builtin_amdgcn_cvt_pk_fp8_f32(v0[2] * 16.f, v0[3] * 16.f, p0_, true);
                        int p1_ = __builtin_amdgcn_cvt_pk_fp8_f32(v1[0] * 16.f, v1[1] * 16.f, 0, false); p1_ = __builtin_amdgcn_cvt_pk_fp8_f32(v1[2] * 16.f, v1[3] * 16.f, p1_, true);
                        *(u32x2*)(O8 + (size_t)row * 1024 + col0 + bj * HALF) = (u32x2){(unsigned)p0_, (unsigned)p1_}; } } }
    }
};
struct EpiDownH {
    static constexpr bool PERM = true, AFTER_DRAIN = false, AMAX = false;
    bf16_t* O; const float* bd; const float* rgate; float ws;
    __device__ __forceinline__ void operator()(const f32x4 (&acc)[2][2][4][2], const Unit& u, int wr, int wc, int fr, int fq) const {
        const int e = u.pn >> 3, pnl = u.pn & 7;
        const int row0 = u.pm * BM + wr * 64 + fr, col0 = pnl * HALF + wc * 32 + 8 * fq;
        const f32x4 bv0 = *(const f32x4*)(bd + (size_t)e * 1024 + col0), bv1 = *(const f32x4*)(bd + (size_t)e * 1024 + col0 + 4);
#pragma unroll
        for (int ai = 0; ai < 2; ++ai)
#pragma unroll
            for (int m = 0; m < 4; ++m) { const int row = row0 + ai * HALF + m * 16; const float gw = rgate[row];
                const f32x4 v0 = (acc[ai][0][m][0] * ws + bv0) * gw, v1 = (acc[ai][0][m][1] * ws + bv1) * gw;
                u32x4 w; w.x = cvt_pk_bf16(v0[0], v0[1]); w.y = cvt_pk_bf16(v0[2], v0[3]); w.z = cvt_pk_bf16(v1[0], v1[1]); w.w = cvt_pk_bf16(v1[2], v1[3]);
                *(u32x4*)(O + (size_t)row * 1024 + col0) = w; }
    }
};
struct MoeOrder {
    int nN, G, c, ntiles; const PG8_LAS int* tile_e; int rep;
    __device__ bool next(int i, Unit& u) const {
        const int xcd = c & 7, jj = c >> 3, per = G >> 3;
        const int t0 = (ntiles * xcd) >> 3, t1 = (ntiles * (xcd + 1)) >> 3;
        int li = i * per + jj; const int tot = (t1 - t0) * nN; if (li >= tot * rep) return false; if (li >= tot) li -= tot;
        const int pm = t0 + li / nN, pnl = li - (li / nN) * nN; const int te = tile_e[pm], e = te & 255;
        u.pm = pm; u.pn = __builtin_amdgcn_readfirstlane(e * nN + pnl); u.half = __builtin_amdgcn_readfirstlane(te >> 8); return true;
    }
    __device__ __forceinline__ void a_ready(const Unit&) const {}
    __device__ __forceinline__ void done(const Unit&) const {}
};
template <class Epi, class Sched, bool ALIGN_EPI, bool SP2, int UIDC, bool GATHER = false, bool F8 = false, bool NHALF = false, int F8N1 = 0>
__device__ __forceinline__ void gemm_phase(PG8_LAS unsigned char* lds, const Gemm g, const Sched& S, const Epi& E, const int wid_in, const int UID) {
    const int wid = wid_in, lane = (int)__builtin_amdgcn_mbcnt_hi(~0u, __builtin_amdgcn_mbcnt_lo(~0u, (unsigned)UID)) - UID, tid = wid * 64 + lane, wr = wid >> 2, wc = wid & 3, fr = lane & 15, fq = lane >> 4;
    int K_l = g.K; asm volatile("; opaque K" : "+s"(K_l));
    const int K = K_l, nt = K / BK;
    static_assert(!GATHER || SP2, "GATHER is wired into the SP2 loop only");
    unsigned voffA[2], voffB[2];
#pragma unroll
    for (int i = 0; i < 2; ++i) { int R, C; stage_rc(tid * 16 + i * 8192, R, C); const int Rb = Epi::PERM ? ((R & ~31) + perm32(R & 31)) : R;
        voffA[i] = (unsigned)(R * K + C) * 2u; voffB[i] = (unsigned)(Rb * K + C) * 2u; }
    const size_t kstep = (size_t)(BK * 2);
    const size_t hstep = (size_t)HALF * K * 2;
    const size_t tstep = 2 * hstep;
    const unsigned ldsw = (unsigned)wid * 1024u;
    const int aoff = lds_byte(wr * 64 + fr, fq * 8), boff = lds_byte(wc * 32 + fr, fq * 8);
#define PG8_SA(b, h) (((b) * 2 + (h)) * HTB)
#define PG8_SB(b, h) ((4 + (b) * 2 + (h)) * HTB)
#define PG8_STAGE(bufoff, gbase, voff) do { _Pragma("unroll") for (int _i = 0; _i < 2; ++_i) \
        __builtin_amdgcn_global_load_lds((const unsigned*)((const char*)(gbase) + (voff)[_i]), (PG8_LAS unsigned*)(lds + (bufoff) + ldsw + _i * 8192), 16, 0, 0); } while (0)
#define PG8_STAGE_A(b, h, gbase, usenext) do { if constexpr (GATHER) { const unsigned _v0 = (usenext) ? vAn[h][0] : vAc[h][0], _v1 = (usenext) ? vAn[h][1] : vAc[h][1]; \
        __builtin_amdgcn_global_load_lds((const unsigned*)((const char*)(gbase) + _v0), (PG8_LAS unsigned*)(lds + PG8_SA(b, h) + ldsw), 16, 0, 0); \
        __builtin_amdgcn_global_load_lds((const unsigned*)((const char*)(gbase) + _v1), (PG8_LAS unsigned*)(lds + PG8_SA(b, h) + ldsw + 8192), 16, 0, 0); } \
    else PG8_STAGE(PG8_SA(b, h), (gbase) + (h) * hstep, voffA); } while (0)
#define PG8_LDA(dst, b, h) do { _Pragma("unroll") for (int m = 0; m < 4; ++m) _Pragma("unroll") for (int k = 0; k < 2; ++k) dst[m][k] = *(const PG8_LAS bf16x8*)(lds + PG8_SA(b, h) + aoff + m * 2048 + k * 1024); } while (0)
#define PG8_LDB(dst, b, h) do { _Pragma("unroll") for (int n = 0; n < 2; ++n) _Pragma("unroll") for (int k = 0; k < 2; ++k) dst[n][k] = *(const PG8_LAS bf16x8*)(lds + PG8_SB(b, h) + boff + n * 2048 + k * 1024); } while (0)
#define PG8_MMA(ai, bj, At, Bt) do { if constexpr (!(NHALF && (bj) == 1)) if ((ai) == 0 || !hf_) { __builtin_amdgcn_s_setprio(1); if constexpr (F8) { _Pragma("unroll") for (int m = 0; m < 4; ++m) _Pragma("unroll") for (int n = 0; n < 2; ++n) { \
        if (NHALF || (bj) == 0 || n < F8N1) acc[ai][bj][m][n] = __builtin_amdgcn_mfma_scale_f32_16x16x128_f8f6f4(__builtin_shufflevector(__builtin_bit_cast(i32x4, Bt[n][0]), __builtin_bit_cast(i32x4, Bt[n][1]), 0, 1, 2, 3, 4, 5, 6, 7), \
            __builtin_shufflevector(__builtin_bit_cast(i32x4, At[m][0]), __builtin_bit_cast(i32x4, At[m][1]), 0, 1, 2, 3, 4, 5, 6, 7), acc[ai][bj][m][n], 0, 0, 0, 0, 0, 0); \
        else { _Pragma("unroll") for (int k = 0; k < 2; ++k) { const i64x2 a_ = __builtin_bit_cast(i64x2, At[m][k]), b_ = __builtin_bit_cast(i64x2, Bt[n][k]); \
            acc[ai][bj][m][n] = __builtin_amdgcn_mfma_f32_16x16x32_fp8_fp8(b_[0], a_[0], acc[ai][bj][m][n], 0, 0, 0); \
            acc[ai][bj][m][n] = __builtin_amdgcn_mfma_f32_16x16x32_fp8_fp8(b_[1], a_[1], acc[ai][bj][m][n], 0, 0, 0); } } } } \
    else { _Pragma("unroll") for (int m = 0; m < 4; ++m) _Pragma("unroll") for (int n = 0; n < 2; ++n) _Pragma("unroll") for (int k = 0; k < 2; ++k) \
        acc[ai][bj][m][n] = __builtin_amdgcn_mfma_f32_16x16x32_bf16(Bt[n][k], At[m][k], acc[ai][bj][m][n], 0, 0, 0); } __builtin_amdgcn_s_setprio(0); } } while (0)
#define PG8_WAIT_V(n) asm volatile("s_waitcnt vmcnt(" #n ")" ::: "memory")
#define PG8_WAIT_L(n) asm volatile("s_waitcnt lgkmcnt(" #n ")" ::: "memory")
#define PG8_BAR __builtin_amdgcn_s_barrier()
#define PG8_SCHED __builtin_amdgcn_sched_barrier(0)
    Unit cur, nxt; int ui = 0;
    if (!S.next(0, cur)) return;
    f32x4 acc[2][2][4][2];
#pragma unroll
    for (int a = 0; a < 2; ++a)
#pragma unroll
        for (int b = 0; b < 2; ++b)
#pragma unroll
            for (int m = 0; m < 4; ++m)
#pragma unroll
                for (int n = 0; n < 2; ++n) acc[a][b][m][n] = (f32x4){0.f, 0.f, 0.f, 0.f};
    bf16x8 At[4][2], B0[2][2], B1[2][2];
    const char* cA = (const char*)g.A + (GATHER ? (size_t)0 : (size_t)cur.pm * tstep); const char* cB = (const char*)g.Bt + (size_t)cur.pn * (NHALF ? hstep : tstep);
    unsigned vAc[2][2], vAn[2][2];
    auto gvoff = [&](int pm, unsigned (&v)[2][2]) {
        const int ln_ = (int)__builtin_amdgcn_mbcnt_hi(~0u, __builtin_amdgcn_mbcnt_lo(~0u, (unsigned)pm)) - pm, tid_ = wid * 64 + ln_;
#pragma unroll
        for (int hh = 0; hh < 2; ++hh)
#pragma unroll
            for (int i = 0; i < 2; ++i) { int R, C; stage_rc(tid_ * 16 + i * 8192, R, C); v[hh][i] = (unsigned)g.gidx[(pm - g.gtile0) * 256 + hh * HALF + R] * (unsigned)(K * 2) + (unsigned)(C * 2); } };
    if constexpr (GATHER) { gvoff(cur.pm, vAc); } else { vAc[0][0] = vAc[0][1] = vAc[1][0] = vAc[1][1] = 0u; }
#pragma unroll
    for (int hh = 0; hh < 2; ++hh) { vAn[hh][0] = vAc[hh][0]; vAn[hh][1] = vAc[hh][1]; }
    S.a_ready(cur);
    if constexpr (SP2) {
        PG8_STAGE(PG8_SB(0, 0), cB, voffB); PG8_STAGE(PG8_SB(0, 1), cB + hstep, voffB); PG8_STAGE_A(0, 0, cA, false); PG8_STAGE_A(0, 1, cA, false);
        if (wr == 1) PG8_BAR;
        PG8_WAIT_V(2); PG8_BAR;
        PG8_STAGE(PG8_SB(1, 0), cB + kstep, voffB); PG8_STAGE_A(1, 0, cA + kstep, false); PG8_STAGE(PG8_SB(1, 1), cB + hstep + kstep, voffB);
        PG8_WAIT_V(6); PG8_BAR;
    } else {
        PG8_STAGE(PG8_SB(0, 0), cB, voffB); PG8_STAGE(PG8_SA(0, 0), cA, voffA); PG8_STAGE(PG8_SB(0, 1), cB + hstep, voffB); PG8_STAGE(PG8_SA(0, 1), cA + hstep, voffA);
        if (wr == 1) PG8_BAR;
        PG8_WAIT_V(4); PG8_BAR;
        PG8_STAGE(PG8_SB(1, 0), cB + kstep, voffB); PG8_STAGE(PG8_SA(1, 0), cA + kstep, voffA); PG8_STAGE(PG8_SB(1, 1), cB + hstep + kstep, voffB);
        PG8_WAIT_V(6); PG8_BAR;
    }
    for (;;) {
        const bool has_next = S.next(ui + 1, nxt);
        const bool hf_ = cur.half != 0;
        const char* nA = (has_next && !GATHER) ? (const char*)g.A + (size_t)nxt.pm * tstep : (GATHER ? (const char*)g.A : cA); const char* nB = has_next ? (const char*)g.Bt + (size_t)nxt.pn * (NHALF ? hstep : tstep) : cB;
        if constexpr (GATHER) { if (has_next) gvoff(nxt.pm, vAn); else {
#pragma unroll
            for (int hh = 0; hh < 2; ++hh) { vAn[hh][0] = vAc[hh][0]; vAn[hh][1] = vAc[hh][1]; } } }
        for (int t = 0; t < nt; t += 2) {
            const bool last = (t == nt - 2);
            const char* a1 = cA + (size_t)(t + 1) * kstep;
            const char* a2 = last ? nA : cA + (size_t)(t + 2) * kstep; const char* b2 = last ? nB : cB + (size_t)(t + 2) * kstep;
            const char* a3 = a2 + kstep; const char* b3 = b2 + kstep;
            if (last && has_next) S.a_ready(nxt);
            if constexpr (SP2) {
            PG8_LDB(B0, 0, 0); PG8_LDB(B1, 0, 1); PG8_SCHED; PG8_LDA(At, 0, 0); PG8_STAGE_A(1, 1, a1, false);
            PG8_WAIT_V(8); PG8_WAIT_L(0); PG8_BAR; PG8_MMA(0, 0, At, B0); PG8_MMA(0, 1, At, B1); PG8_BAR; PG8_SCHED;
            PG8_LDA(At, 0, 1); PG8_STAGE(PG8_SB(0, 0), b2, voffB); PG8_STAGE(PG8_SB(0, 1), b2 + hstep, voffB); PG8_STAGE_A(0, 0, a2, last);
            PG8_WAIT_V(8); PG8_WAIT_L(0); PG8_BAR; PG8_MMA(1, 0, At, B0); PG8_MMA(1, 1, At, B1); PG8_BAR; PG8_SCHED;
            PG8_LDB(B0, 1, 0); PG8_LDB(B1, 1, 1); PG8_SCHED; PG8_LDA(At, 1, 0); PG8_STAGE_A(0, 1, a2, last);
            PG8_WAIT_V(8); PG8_WAIT_L(0); PG8_BAR; PG8_MMA(0, 0, At, B0); PG8_MMA(0, 1, At, B1); PG8_BAR; PG8_SCHED;
            PG8_LDA(At, 1, 1); PG8_STAGE(PG8_SB(1, 0), b3, voffB); PG8_STAGE(PG8_SB(1, 1), b3 + hstep, voffB); PG8_STAGE_A(1, 0, a3, last);
            PG8_WAIT_V(8); PG8_WAIT_L(0); PG8_BAR; PG8_MMA(1, 0, At, B0); PG8_MMA(1, 1, At, B1); PG8_BAR; PG8_SCHED;
            } else {
            PG8_LDB(B0, 0, 0); PG8_SCHED; PG8_LDA(At, 0, 0); PG8_STAGE(PG8_SA(1, 1), a1 + hstep, voffA);
            PG8_WAIT_L(8); PG8_BAR; PG8_WAIT_L(0); PG8_MMA(0, 0, At, B0); PG8_BAR; PG8_SCHED;
            PG8_LDB(B1, 0, 1); PG8_STAGE(PG8_SB(0, 0), b2, voffB);
            PG8_BAR; PG8_WAIT_L(0); PG8_MMA(0, 1, At, B1); PG8_BAR;
            PG8_LDA(At, 0, 1); PG8_STAGE(PG8_SA(0, 0), a2, voffA);
            PG8_BAR; PG8_WAIT_L(0); PG8_MMA(1, 0, At, B0); PG8_BAR; PG8_SCHED;
            PG8_STAGE(PG8_SB(0, 1), b2 + hstep, voffB);
            PG8_WAIT_V(6); PG8_BAR; PG8_MMA(1, 1, At, B1); PG8_BAR;
            PG8_LDB(B0, 1, 0); PG8_SCHED; PG8_LDA(At, 1, 0); PG8_STAGE(PG8_SA(0, 1), a2 + hstep, voffA);
            PG8_WAIT_L(8); PG8_BAR; PG8_WAIT_L(0); PG8_MMA(0, 0, At, B0); PG8_BAR; PG8_SCHED;
            PG8_LDB(B1, 1, 1); PG8_STAGE(PG8_SB(1, 0), b3, voffB);
            PG8_BAR; PG8_WAIT_L(0); PG8_MMA(0, 1, At, B1); PG8_BAR;
            PG8_LDA(At, 1, 1); PG8_STAGE(PG8_SA(1, 0), a3, voffA);
            PG8_BAR; PG8_WAIT_L(0); PG8_MMA(1, 0, At, B0); PG8_BAR; PG8_SCHED;
            PG8_STAGE(PG8_SB(1, 1), b3 + hstep, voffB);
            PG8_WAIT_V(6); PG8_BAR; PG8_MMA(1, 1, At, B1); PG8_BAR;
            }
        }
        if constexpr (ALIGN_EPI) { if (wr == 0) PG8_BAR; }
        if constexpr (!Epi::AFTER_DRAIN) {
            const int dep_ = __builtin_amdgcn_readfirstlane(__builtin_bit_cast(int, acc[1][1][3][1][3]));
            const int lane_e = (int)__builtin_amdgcn_mbcnt_hi(~0u, __builtin_amdgcn_mbcnt_lo(~0u, (unsigned)dep_)) - dep_;
            if constexpr (Epi::AMAX) {
                float mx_ = 0.f;
#pragma unroll
                for (int a_ = 0; a_ < 2; ++a_)
#pragma unroll
                    for (int b_ = 0; b_ < 2; ++b_)
#pragma unroll
                        for (int m_ = 0; m_ < 4; ++m_) { const f32x4 s0_ = acc[a_][b_][m_][0] * acc[a_][b_][m_][0] + acc[a_][b_][m_][1] * acc[a_][b_][m_][1];
                            float s_ = (s0_[0] + s0_[1]) + (s0_[2] + s0_[3]); s_ += __shfl_xor(s_, 16); s_ += __shfl_xor(s_, 32); mx_ = fmaxf(mx_, s_); }
#pragma unroll
                for (int o_ = 8; o_ >= 1; o_ >>= 1) mx_ = fmaxf(mx_, __shfl_xor(mx_, o_));
                if (lane_e == 0) (void)__hip_atomic_fetch_max(E.amax, __builtin_bit_cast(unsigned, mx_), __ATOMIC_RELAXED, __HIP_MEMORY_SCOPE_AGENT); }
            E(acc, cur, wr, wc, lane_e & 15, lane_e >> 4); S.done(cur); }
        if (!has_next) break;
#pragma unroll
        for (int a = 0; a < 2; ++a)
#pragma unroll
            for (int b = 0; b < 2; ++b)
#pragma unroll
                for (int m = 0; m < 4; ++m)
#pragma unroll
                    for (int n = 0; n < 2; ++n) acc[a][b][m][n] = (f32x4){0.f, 0.f, 0.f, 0.f};
        cur = nxt; cA = nA; cB = nB; ++ui;
#pragma unroll
        for (int hh = 0; hh < 2; ++hh) { vAc[hh][0] = vAn[hh][0]; vAc[hh][1] = vAn[hh][1]; }
        if constexpr (ALIGN_EPI) { if (wr == 1) PG8_BAR; }
    }
    PG8_WAIT_V(0);
    if constexpr (!ALIGN_EPI) { if (wr == 0) PG8_BAR; }
    PG8_BAR;
    if constexpr (Epi::AFTER_DRAIN) { E.fused(acc, cur, wr, wc, fr, fq, lds, wid, lane); S.done(cur); }
#undef PG8_SA
#undef PG8_SB
#undef PG8_STAGE
#undef PG8_STAGE_A
#undef PG8_LDA
#undef PG8_LDB
#undef PG8_MMA
#undef PG8_WAIT_V
#undef PG8_WAIT_L
#undef PG8_BAR
#undef PG8_SCHED
}
}
constexpr int S = 16384, D = 1024, NLAYER = 4, NE = 32;
constexpr float ALPHA_DN = 1.6817928305074292f;
constexpr float LN_EPS = 1e-5f, RMS_EPS = 1e-6f;
constexpr float LOG2E = 1.4426950408889634f;
constexpr int NWAVES = 8, NTHREADS = 512;
constexpr int MOE_MAXTILES = 288, MOE_ROWS = MOE_MAXTILES * 256;
constexpr size_t MiB = 1u << 20;
constexpr size_t WS_CTL = 0, CTL_ZERO_BYTES = 1 * MiB;
constexpr size_t WS_CS64 = 1 * MiB, WS_CS32 = 5 * MiB;
constexpr size_t WS_WDA = 8 * MiB;
constexpr size_t WS_WMLA = 24 * MiB;
constexpr size_t WS_WNSA = 30 * MiB;
constexpr size_t WS_WMOE = 64 * MiB;
constexpr size_t WS_H = 832 * MiB, WS_H1 = 896 * MiB, WS_Y = 960 * MiB;
constexpr size_t WS_XB = 1024 * MiB, WS_X1B = 1056 * MiB, WS_AO = 1088 * MiB;
constexpr size_t WS_QK = 1120 * MiB;
constexpr size_t WS_VT = 1184 * MiB;
constexpr size_t WS_OH = 1216 * MiB;
constexpr size_t WS_MISC = 1280 * MiB;
constexpr size_t WS_KH = WS_MISC + 96 * MiB;
constexpr size_t WS_AS = 1408 * MiB, WS_ACT = 1552 * MiB, WS_YS = 1696 * MiB;
constexpr size_t WS_ROUTE = 1840 * MiB;
constexpr size_t WS_END = 1844 * MiB;
constexpr size_t MLA_C = 0, MLA_CQN = 32 * MiB, MLA_CKVN = 40 * MiB, MLA_KR = 44 * MiB;
constexpr size_t NSA_P = 0, NSA_ACK = 24 * MiB, NSA_ACV = 40 * MiB, NSA_HK = 56 * MiB, NSA_HV = 58 * MiB, NSA_KC = 60 * MiB, NSA_VCT = 61 * MiB, NSA_SEL = 63 * MiB;
constexpr int CW_BAR = 4096, CW_CNT = 16384  , CW_ERR = 20480  , CW_KMAX = 20608  ;
constexpr int RING_BYTES = 131072, LDSCTL_OFF = RING_BYTES, LDS_GIDX_OFF = LDSCTL_OFF + 4096  , LDS_BYTES = 155648;
constexpr int LC_HIST = 16, LC_BASE = 48, LC_SEG = 80  , LC_LCNT = 120, LC_NT = 152, LC_TILEE = 160  , LC_POS = 512  , LC_LAM = 800;

#define GAS __attribute__((address_space(1)))
#define LAS __attribute__((address_space(3)))
typedef unsigned short bf16;
typedef unsigned v4u __attribute__((ext_vector_type(4)));
typedef unsigned v2u __attribute__((ext_vector_type(2)));
typedef float f32x4 __attribute__((ext_vector_type(4)));
typedef float f32x16 __attribute__((ext_vector_type(16)));
typedef float f32x8v __attribute__((ext_vector_type(8)));
typedef float f32x2v __attribute__((ext_vector_type(2)));
__device__ __forceinline__ float sum32pk(const f32x16& a, const f32x16& b) {
    const f32x16 s = a + b;
    const f32x8v s8 = __builtin_shufflevector(s, s, 0, 1, 2, 3, 4, 5, 6, 7) + __builtin_shufflevector(s, s, 8, 9, 10, 11, 12, 13, 14, 15);
    const f32x4 s4 = __builtin_shufflevector(s8, s8, 0, 1, 2, 3) + __builtin_shufflevector(s8, s8, 4, 5, 6, 7);
    const f32x2v s2 = __builtin_shufflevector(s4, s4, 0, 1) + __builtin_shufflevector(s4, s4, 2, 3);
    return s2.x + s2.y;
}
typedef short bf16x8 __attribute__((ext_vector_type(8)));
typedef pg8::cs_t cs_t;
__device__ __forceinline__ unsigned f2bf(float f) { unsigned u = __builtin_bit_cast(unsigned, f); return (u + 0x7fffu + ((u >> 16) & 1u)) >> 16; }
__device__ __forceinline__ unsigned pk2(float lo, float hi) { return pg8::cvt_pk_bf16(lo, hi); }
__device__ __forceinline__ float bf2f(unsigned short b) { return __builtin_bit_cast(float, (unsigned)b << 16); }
__device__ __forceinline__ float bflo(unsigned w) { return __builtin_bit_cast(float, w << 16); }
__device__ __forceinline__ float bfhi(unsigned w) { return __builtin_bit_cast(float, w & 0xffff0000u); }
__device__ __forceinline__ float wave_sum(float v) {
#pragma unroll
    for (int o = 1; o < 64; o <<= 1) v += __shfl_xor(v, o);
    return v;
}
__device__ __forceinline__ float wave_max(float v) {
#pragma unroll
    for (int o = 1; o < 64; o <<= 1) v = fmaxf(v, __shfl_xor(v, o));
    return v;
}
__device__ __forceinline__ float swap32f(float v, int hi) {
    auto rr = __builtin_amdgcn_permlane32_swap(__float_as_uint(v), __float_as_uint(v), false, false);
    return hi ? __uint_as_float(rr[0]) : __uint_as_float(rr[1]);
}

__device__ __forceinline__ float swap16f(float v, int odd) {
    auto rr = __builtin_amdgcn_permlane16_swap(__float_as_uint(v), __float_as_uint(v), false, false);
    return odd ? __uint_as_float(rr[0]) : __uint_as_float(rr[1]);
}

#define XB_TMO      128
#define XB_XCNT(j)  (256  + 64 * (j))
#define XB_XSUB(j)  (1280 + 64 * (j))
#define XB_XGEN(j)  (2304 + 64 * (j))
#define XB_TOP      3328
#define XB_TOPGEN   3392
#define XCD_BAR_WORDS 3456
#define XB_SPIN_CAP (1u << 18)
__device__ __forceinline__ unsigned xb_ld(unsigned* p)              { return __hip_atomic_load(p, __ATOMIC_RELAXED, __HIP_MEMORY_SCOPE_AGENT); }
__device__ __forceinline__ unsigned xb_add(unsigned* p, unsigned v) { return __hip_atomic_fetch_add(p, v, __ATOMIC_RELAXED, __HIP_MEMORY_SCOPE_AGENT); }
__device__ __forceinline__ unsigned xb_xcc_id() { return (unsigned)__builtin_amdgcn_s_getreg((3 << 11) | 20) & 0xFu; }
#define XB_SPIN(cond, bar) do { unsigned _sp = 0; while (cond) { __builtin_amdgcn_s_sleep(1); \
    if ((++_sp & 255u) == 0u) { if (xb_ld(&(bar)[XB_TMO])) break; if (_sp > XB_SPIN_CAP) { atomicAdd(&(bar)[XB_TMO], 1u); break; } } } } while (0)
struct XcdBarrier { unsigned* bar; unsigned x; volatile LAS unsigned* st; };
__device__ __forceinline__ XcdBarrier xcd_barrier_post(unsigned* bar, volatile LAS unsigned* st, int tid0) {
    XcdBarrier b; b.bar = bar; b.x = xb_xcc_id(); b.st = st;
    if (tid0 == 0) (void)xb_add(&bar[XB_XCNT(b.x)], 1u);
    return b;
}
__device__ __forceinline__ void xcd_barrier_complete(unsigned* bar, unsigned x, unsigned& nloc, unsigned& nx) {
    const unsigned G = gridDim.x * gridDim.y * gridDim.z;
    unsigned sum, cnt, mine, sp = 0u;
    for (;;) {
        sum = 0u; cnt = 0u; mine = 0u;
#pragma unroll
        for (unsigned j = 0; j < 16; ++j) { const unsigned c = xb_ld(&bar[XB_XCNT(j)]); sum += c; cnt += (c > 0u) ? 1u : 0u; mine = (j == x) ? c : mine; }
        if (sum == G) break;
        __builtin_amdgcn_s_sleep(1);
        if ((++sp & 255u) == 0u) { if (xb_ld(&bar[XB_TMO])) break; if (sp > XB_SPIN_CAP) { atomicAdd(&bar[XB_TMO], 1u); break; } }
    }
    nloc = mine > 0u ? mine : 1u; nx = cnt > 0u ? cnt : 1u;
}
__device__ __forceinline__ void xcd_barrier(const XcdBarrier& b, int tid0) {
    asm volatile("s_waitcnt vmcnt(0)" ::: "memory");
    __syncthreads();
    if (tid0 == 0) {
        unsigned* bar = b.bar;
        __builtin_amdgcn_s_waitcnt(0);
        unsigned nloc = b.st[0], nx = b.st[1];
        if (nloc == 0u) { xcd_barrier_complete(bar, b.x, nloc, nx); b.st[0] = nloc; b.st[1] = nx; }
        const unsigned old = xb_add(&bar[XB_XSUB(b.x)], 1u);
        const unsigned gen = old / nloc;
        if (old + 1u == (gen + 1u) * nloc) {
            __builtin_amdgcn_fence(__ATOMIC_RELEASE, "agent");
            asm volatile("s_waitcnt vmcnt(0)" ::: "memory");
            const unsigned og = xb_add(&bar[XB_TOP], 1u);
            const unsigned tg = og / nx;
            if (og + 1u == (tg + 1u) * nx) xb_add(&bar[XB_TOPGEN], 1u);
            else XB_SPIN(xb_ld(&bar[XB_TOPGEN]) == tg, bar);
            __builtin_amdgcn_fence(__ATOMIC_ACQUIRE, "agent");
            xb_add(&bar[XB_XGEN(b.x)], 1u);
            asm volatile("s_waitcnt vmcnt(0)" ::: "memory");
        } else {
            XB_SPIN(xb_ld(&bar[XB_XGEN(b.x)]) == gen, bar);
            __builtin_amdgcn_fence(__ATOMIC_ACQUIRE, "agent");
            asm volatile("s_waitcnt vmcnt(0)" ::: "memory");
        }
    }
    __syncthreads();
}

enum CvtMode { CM_IDENT = 0, CM_ROPE64 = 1, CM_MLAQ = 2, CM_MLAKV = 3, CM_NSAIN = 4, CM_SWIGLU = 5 };
struct Job { const float* src; bf16* dst; long long sbs, dbs; int ld, K, ncols, col0, mode, nbatch, item0, pad; };
constexpr int MAXJOBS = 32;
enum { I_X = 0, I_DA_WIN, I_DA_LQ1, I_DA_LK1, I_DA_LQ2, I_DA_LK2, I_DA_SUBLN, I_DA_WOUT, I_MLA_WIN, I_MLA_QN, I_MLA_KVN, I_MLA_WUQ, I_MLA_WUKV, I_MLA_WOUT,
       I_NSA_WIN, I_NSA_POSK, I_NSA_POSV, I_NSA_KW1, I_NSA_KW2, I_NSA_VW1, I_NSA_VW2, I_NSA_WOUT, I_LN1G, I_LN1B, I_LN2G, I_LN2B, I_MOE_WR, I_MOE_BR, I_MOE_WGU, I_MOE_BGU, I_MOE_WDN, I_MOE_BDN, N_IN };
struct Args { const float* in[N_IN]; float* out; unsigned char* ws; Job jobs[MAXJOBS]; int njobs, nitems, ph_lo, ph_hi; };

__device__ __forceinline__ int rope64_row(int hv, int d) { return 256 * (hv >> 2) + 128 * (d >> 5) + 32 * (hv & 3) + (d & 31); }
__device__ __forceinline__ int cvt_dst_row(int mode, int f) {
    switch (mode) {
    case CM_ROPE64: return rope64_row(f >> 6, f & 63);
    case CM_MLAQ: { const int head = f / 96, d = f - head * 96; if (d < 64) return 64 * head + d; const int r = d - 64; return 1024 + 256 * (head >> 3) + 128 * (r >> 4) + 16 * (head & 7) + (r & 15); }
    case CM_MLAKV: { const int head = f >> 7, d = f & 127; return d < 64 ? 64 * head + d : 1024 + 64 * head + (d - 64); }
    case CM_NSAIN: {
        if (f < 1024) return rope64_row(f >> 6, f & 63);
        if (f < 1280) return 1536 + (f - 1024);
        if (f < 1536) return 1792 + (f - 1280);
        if (f < 1792) return rope64_row(16 + ((f - 1536) >> 6), f & 63);
        if (f < 2048) return 2304 + (f - 1792);
        if (f < 2304) return rope64_row(20 + ((f - 2048) >> 6), f & 63);
        if (f < 2560) return 2560 + (f - 2304);
        return 2048 + (f - 2560); }
    case CM_SWIGLU: { const int j = f >> 1; return 256 * (j >> 7) + 128 * (f & 1) + (j & 127); }
    default: return f;
    }
}
__device__ __forceinline__ void cvt_item(const Job& J, int item, LAS unsigned char* scr, int lane) {
    const int nblk = (J.ncols + 63) >> 6, per_b = (J.K >> 6) * nblk;
    const int b = item / per_b, r = item - b * per_b, kb = r / nblk, nb = r - kb * nblk, k0 = 64 * kb, n0 = 64 * nb;
    const int col = n0 + lane; const bool ok = col < J.ncols;
    const float* W = J.src + (size_t)b * J.sbs + (size_t)k0 * J.ld + J.col0 + (ok ? col : 0);
    float v[64];
#pragma unroll
    for (int i = 0; i < 64; ++i) v[i] = __builtin_nontemporal_load(W + (size_t)i * J.ld);
#pragma unroll
    for (int q = 0; q < 8; ++q) { v4u o; o.x = pk2(v[8 * q], v[8 * q + 1]); o.y = pk2(v[8 * q + 2], v[8 * q + 3]); o.z = pk2(v[8 * q + 4], v[8 * q + 5]); o.w = pk2(v[8 * q + 6], v[8 * q + 7]);
        *(LAS v4u*)(scr + lane * 144 + q * 16) = o; }
    asm volatile("s_waitcnt lgkmcnt(0)" ::: "memory");
    bf16* dstb = J.dst + (size_t)b * J.dbs + k0;
#pragma unroll
    for (int s = 0; s < 8; ++s) { const int rl = 8 * s + (lane >> 3), ch = lane & 7;
        const v4u o = *(const LAS v4u*)(scr + rl * 144 + ch * 16);
        if (n0 + rl < J.ncols) __builtin_nontemporal_store(o, (v4u*)(dstb + (size_t)cvt_dst_row(J.mode, n0 + rl) * J.K + ch * 8)); }
    asm volatile("s_waitcnt lgkmcnt(0)" ::: "memory");
}
__device__ __forceinline__ void cvt_item_f8(const Job& J, int item, LAS unsigned char* scr, int lane) {
    const int nblk = (J.ncols + 63) >> 6, per_b = (J.K >> 7) * nblk;
    const int b = item / per_b, r = item - b * per_b, kb = r / nblk, nb = r - kb * nblk, n0 = 64 * nb;
    const bool perm = J.pad == 1;
    const float* W = J.src + (size_t)b * J.sbs + J.col0 + n0 + lane;
#pragma unroll
    for (int h = 0; h < 2; ++h) {
        float v[64];
#pragma unroll
        for (int q = 0; q < 4; ++q)
#pragma unroll
            for (int m = 0; m < 16; ++m) { const int row = perm ? 8 * kb + 4 * h + q + 64 * m : 128 * kb + 64 * h + 16 * q + m; v[16 * q + m] = __builtin_nontemporal_load(W + (size_t)row * J.ld); }
#pragma unroll
        for (int q = 0; q < 4; ++q) { v4u o; int w;
            w = __builtin_amdgcn_cvt_pk_fp8_f32(v[16 * q + 0] * 64.f, v[16 * q + 1] * 64.f, 0, false); w = __builtin_amdgcn_cvt_pk_fp8_f32(v[16 * q + 2] * 64.f, v[16 * q + 3] * 64.f, w, true); o.x = (unsigned)w;
            w = __builtin_amdgcn_cvt_pk_fp8_f32(v[16 * q + 4] * 64.f, v[16 * q + 5] * 64.f, 0, false); w = __builtin_amdgcn_cvt_pk_fp8_f32(v[16 * q + 6] * 64.f, v[16 * q + 7] * 64.f, w, true); o.y = (unsigned)w;
            w = __builtin_amdgcn_cvt_pk_fp8_f32(v[16 * q + 8] * 64.f, v[16 * q + 9] * 64.f, 0, false); w = __builtin_amdgcn_cvt_pk_fp8_f32(v[16 * q + 10] * 64.f, v[16 * q + 11] * 64.f, w, true); o.z = (unsigned)w;
            w = __builtin_amdgcn_cvt_pk_fp8_f32(v[16 * q + 12] * 64.f, v[16 * q + 13] * 64.f, 0, false); w = __builtin_amdgcn_cvt_pk_fp8_f32(v[16 * q + 14] * 64.f, v[16 * q + 15] * 64.f, w, true); o.w = (unsigned)w;
            *(LAS v4u*)(scr + lane * 144 + (4 * h + q) * 16) = o; }
    }
    asm volatile("s_waitcnt lgkmcnt(0)" ::: "memory");
    unsigned char* dstb = (unsigned char*)J.dst + (size_t)b * J.dbs + 128 * kb;
#pragma unroll
    for (int s = 0; s < 8; ++s) { const int rl = 8 * s + (lane >> 3), ch = lane & 7;
        const v4u o = *(const LAS v4u*)(scr + rl * 144 + ch * 16);
        __builtin_nontemporal_store(o, (v4u*)(dstb + (size_t)cvt_dst_row(J.mode, n0 + rl) * J.K + ch * 16)); }
    asm volatile("s_waitcnt lgkmcnt(0)" ::: "memory");
}
__device__ __forceinline__ unsigned lds_inc(LAS unsigned* p) { return __hip_atomic_fetch_add(p, 1u, __ATOMIC_RELAXED, __HIP_MEMORY_SCOPE_WORKGROUP); }
#define WSP(T, off) ((T*)(a.ws + (off)))
__device__ __forceinline__ void zero_rows(bf16* dst, int K, int r0, int r1, int gtid, int gthreads) {
    v4u* p = (v4u*)(dst + (size_t)r0 * K); const int n = (r1 - r0) * K / 8;
    for (int i = gtid; i < n; i += gthreads) p[i] = (v4u){0u, 0u, 0u, 0u};
}
__device__ __forceinline__ void phase_prologue(const Args& a, LAS unsigned char* lds, int tid, int lane, int wave) {
    const int gw = blockIdx.x * NWAVES + wave, NGW = gridDim.x * NWAVES;
    const int gtid = blockIdx.x * NTHREADS + tid, GT = gridDim.x * NTHREADS;
    LAS unsigned char* scr = lds + wave * 9216;
    for (int it = gw; it < a.nitems; it += NGW) {
        int j = 0;
        for (int q = 1; q < a.njobs; ++q) if (it >= a.jobs[q].item0) j = q;
        j = __builtin_amdgcn_readfirstlane(j);
        if (a.jobs[j].pad) cvt_item_f8(a.jobs[j], it - a.jobs[j].item0, scr, lane); else cvt_item(a.jobs[j], it - a.jobs[j].item0, scr, lane);
    }
    zero_rows(WSP(bf16, WS_WMLA), 1024, 416, 512, gtid, GT);
    zero_rows(WSP(bf16, WS_WNSA), 1024, 2096, 2304, gtid, GT);
    zero_rows(WSP(bf16, WS_WNSA + 8 * MiB), 256, 32, 128, gtid, GT);
    zero_rows(WSP(bf16, WS_WNSA + 8 * MiB), 256, 160, 256, gtid, GT);
    zero_rows(WSP(bf16, WS_WNSA + 8 * MiB + 131072), 256, 64, 256, gtid, GT);
    cs_t* cs64 = WSP(cs_t, WS_CS64); cs_t* cs32 = WSP(cs_t, WS_CS32);
    for (int i = gtid; i < S * 48; i += GT) {
        int pos, fi; float inv; cs_t* dst;
        if (i < S * 32) { pos = i >> 5; fi = i & 31; inv = exp2f(-(float)fi * (13.287712379549449f / 32.0f)); dst = cs64 + i; }
        else { const int k = i - S * 32; pos = k >> 4; fi = k & 15; inv = exp2f(-(float)fi * (13.287712379549449f / 16.0f)); dst = cs32 + k; }
        const float ang = (float)pos * inv;
        const double t = (double)ang * 0.15915494309189535; const double fr = t - __builtin_rint(t);
        cs_t o; o.c = __builtin_amdgcn_cosf((float)fr); o.s = __builtin_amdgcn_sinf((float)fr); *dst = o;
    }
    const f32x4* x4 = (const f32x4*)a.in[I_X]; v2u* xb = WSP(v2u, WS_XB);
    for (int i = gtid; i < S * D / 4; i += GT) { const f32x4 v = x4[i]; v2u o; o.x = pk2(v[0], v[1]); o.y = pk2(v[2], v[3]); xb[i] = o; }
}

__device__ __forceinline__ void phase_ln1_router(const Args& a, LAS unsigned char* lds, int layer, int tid, int lane, int wave) {
    const float* wr = a.in[I_MOE_WR] + (size_t)layer * 1024 * 32;
    LAS float* wl = (LAS float*)lds;
    for (int i = tid; i < 8192; i += NTHREADS) { const f32x4 v = ((const f32x4*)wr)[i]; const int k = i >> 3, ch = i & 7, R = (k & 15) * 64 + (k >> 4), pch = ch ^ ((R >> 1) & 7); *(LAS f32x4*)(wl + R * 32 + pch * 4) = v; }
    LAS unsigned* lc = (LAS unsigned*)(lds + LDSCTL_OFF);
    if (tid < 32) lc[LC_HIST + tid] = 0u;
    __syncthreads();
    const float* gn = a.in[I_LN1G] + layer * 1024; const float* bn = a.in[I_LN1B] + layer * 1024; const float* br = a.in[I_MOE_BR] + layer * 32;
    const bf16* Y = WSP(bf16, WS_Y); const bf16* XBr = WSP(bf16, WS_XB); bf16* X1B = WSP(bf16, WS_X1B);
    int* top_e = WSP(int, WS_ROUTE); float* gate = WSP(float, WS_ROUTE + 262144);
    const int sw = (lane >> 1) & 7;
    for (int i = 0; i < 8; ++i) {
        const int t = blockIdx.x * 64 + wave * 8 + i;
        float v[16]; float s = 0.f;
        { const v4u* hp = (const v4u*)(XBr + (size_t)t * 1024 + 16 * lane); const v4u* yp = (const v4u*)(Y + (size_t)t * 1024 + 16 * lane);
          const v4u h0 = hp[0], h1 = hp[1], y0 = yp[0], y1 = yp[1];
          const unsigned hw[8] = {h0.x, h0.y, h0.z, h0.w, h1.x, h1.y, h1.z, h1.w}, yw[8] = {y0.x, y0.y, y0.z, y0.w, y1.x, y1.y, y1.z, y1.w};
#pragma unroll
          for (int q = 0; q < 8; ++q) { v[2 * q] = ALPHA_DN * bflo(hw[q]) + bflo(yw[q]); v[2 * q + 1] = ALPHA_DN * bfhi(hw[q]) + bfhi(yw[q]); s += v[2 * q] + v[2 * q + 1]; } }
        const float mean = wave_sum(s) * (1.0f / 1024.0f); float s2 = 0.f;
#pragma unroll
        for (int m = 0; m < 16; ++m) { v[m] -= mean; s2 += v[m] * v[m]; }
        const float rstd = 1.0f / sqrtf(wave_sum(s2) * (1.0f / 1024.0f) + LN_EPS);
        { const f32x4* g4 = (const f32x4*)(gn + 16 * lane); const f32x4* b4 = (const f32x4*)(bn + 16 * lane);
#pragma unroll
          for (int q = 0; q < 4; ++q) { const f32x4 gg = g4[q], bb = b4[q];
#pragma unroll
              for (int e = 0; e < 4; ++e) v[4 * q + e] = v[4 * q + e] * rstd * gg[e] + bb[e]; }
          v4u o0, o1; o0.x = pk2(v[0], v[1]); o0.y = pk2(v[2], v[3]); o0.z = pk2(v[4], v[5]); o0.w = pk2(v[6], v[7]); o1.x = pk2(v[8], v[9]); o1.y = pk2(v[10], v[11]); o1.z = pk2(v[12], v[13]); o1.w = pk2(v[14], v[15]);
          v4u* xp = (v4u*)(X1B + (size_t)t * 1024 + 16 * lane); xp[0] = o0; xp[1] = o1; }
        {
            v4u o; int w;
            w = __builtin_amdgcn_cvt_pk_fp8_f32(v[0], v[1], 0, false); w = __builtin_amdgcn_cvt_pk_fp8_f32(v[2], v[3], w, true); o.x = (unsigned)w;
            w = __builtin_amdgcn_cvt_pk_fp8_f32(v[4], v[5], 0, false); w = __builtin_amdgcn_cvt_pk_fp8_f32(v[6], v[7], w, true); o.y = (unsigned)w;
            w = __builtin_amdgcn_cvt_pk_fp8_f32(v[8], v[9], 0, false); w = __builtin_amdgcn_cvt_pk_fp8_f32(v[10], v[11], w, true); o.z = (unsigned)w;
            w = __builtin_amdgcn_cvt_pk_fp8_f32(v[12], v[13], 0, false); w = __builtin_amdgcn_cvt_pk_fp8_f32(v[14], v[15], w, true); o.w = (unsigned)w;
            *(v4u*)(WSP(unsigned char, WS_AS) + (size_t)t * 1024 + lane * 16) = o; }
        float acc[32];
#pragma unroll
        for (int e = 0; e < 32; ++e) acc[e] = 0.f;
#pragma unroll
        for (int m = 0; m < 16; ++m) { const LAS float* wrow = wl + (lane + 64 * m) * 32;
#pragma unroll
            for (int ch = 0; ch < 8; ++ch) { const f32x4 w = *(const LAS f32x4*)(wrow + ((ch ^ sw) << 2));
                acc[4 * ch + 0] += v[m] * w[0]; acc[4 * ch + 1] += v[m] * w[1]; acc[4 * ch + 2] += v[m] * w[2]; acc[4 * ch + 3] += v[m] * w[3]; } }
        float a16[16], a8[8], a4[4], a2[2];
        { const bool b = (lane & 32) != 0;
#pragma unroll
          for (int q = 0; q < 16; ++q) { const float send = b ? acc[q] : acc[q + 16], keep = b ? acc[q + 16] : acc[q]; a16[q] = keep + __shfl_xor(send, 32); } }
        { const bool b = (lane & 16) != 0;
#pragma unroll
          for (int q = 0; q < 8; ++q) { const float send = b ? a16[q] : a16[q + 8], keep = b ? a16[q + 8] : a16[q]; a8[q] = keep + __shfl_xor(send, 16); } }
        { const bool b = (lane & 8) != 0;
#pragma unroll
          for (int q = 0; q < 4; ++q) { const float send = b ? a8[q] : a8[q + 4], keep = b ? a8[q + 4] : a8[q]; a4[q] = keep + __shfl_xor(send, 8); } }
        { const bool b = (lane & 4) != 0;
#pragma unroll
          for (int q = 0; q < 2; ++q) { const float send = b ? a4[q] : a4[q + 2], keep = b ? a4[q + 2] : a4[q]; a2[q] = keep + __shfl_xor(send, 4); } }
        float lg;
        { const bool b = (lane & 2) != 0; const float send = b ? a2[0] : a2[1], keep = b ? a2[1] : a2[0]; lg = keep + __shfl_xor(send, 2); }
        lg += __shfl_xor(lg, 1);
        lg += br[lane >> 1];
        float tv[4]; int te[4];
#pragma unroll
        for (int r = 0; r < 4; ++r) {
            const float mx = wave_max(lg);
            const unsigned long long bal = __ballot(lg == mx);
            const int sl = __ffsll((long long)bal) - 1; const int e = sl >> 1;
            tv[r] = mx; te[r] = e;
            if ((lane >> 1) == e) lg = -INFINITY;
        }
        if (lane == 0) {
            const float e1 = __expf(tv[1] - tv[0]), e2 = __expf(tv[2] - tv[0]), e3 = __expf(tv[3] - tv[0]); const float inv = 1.0f / (1.0f + e1 + e2 + e3);
            *(int4*)(top_e + (size_t)t * 4) = make_int4(te[0], te[1], te[2], te[3]);
            *(float4*)(gate + (size_t)t * 4) = make_float4(inv, e1 * inv, e2 * inv, e3 * inv);
            lds_inc(lc + LC_HIST + te[0]); lds_inc(lc + LC_HIST + te[1]); lds_inc(lc + LC_HIST + te[2]); lds_inc(lc + LC_HIST + te[3]);
        }
    }
    __syncthreads();
    if (tid < 32) { unsigned* cnt = WSP(unsigned, WS_CTL) + CW_CNT + layer * 32; const unsigned h = lc[LC_HIST + tid]; lc[LC_BASE + tid] = xb_add(cnt + tid, h); }
    __syncthreads();
}

__device__ __forceinline__ void phase_place(const Args& a, LAS unsigned char* lds, int layer, int tid, int lane, int wave) {
    LAS unsigned* lc = (LAS unsigned*)(lds + LDSCTL_OFF);
    unsigned* cnt = WSP(unsigned, WS_CTL) + CW_CNT + layer * 32;
    if (tid < 64) {
        const unsigned c = (lane < 32) ? xb_ld(cnt + lane) : 0u; const unsigned nt = (c + 255u) >> 8;
        unsigned inc = nt;
#pragma unroll
        for (int o = 1; o < 32; o <<= 1) { const unsigned up = __shfl_up(inc, o); if (lane >= o) inc += up; }
        const unsigned ts = inc - nt;
        if (lane < 32) { lc[LC_SEG + lane] = ts * 256u; for (unsigned q = 0; q < nt; ++q) lc[LC_TILEE + ts + q] = (unsigned)lane | ((c - 256u * q <= 128u) ? 256u : 0u); }
        if (lane == 31) lc[LC_NT] = inc;
    }
    if (tid >= 64 && tid < 96) lc[LC_LCNT + tid - 64] = 0u;
    __syncthreads();
    const int* top_e = WSP(int, WS_ROUTE); const float* gate = WSP(float, WS_ROUTE + 262144); int* tokpos = WSP(int, WS_ROUTE + 524288); float* rgate = WSP(float, WS_ROUTE + 786432);
    if (tid < 256) { const int t = blockIdx.x * 64 + (tid >> 2); const int e = top_e[(size_t)t * 4 + (tid & 3)];
        const unsigned rank = lds_inc(lc + LC_LCNT + e); const unsigned pos = lc[LC_SEG + e] + lc[LC_BASE + e] + rank;
        rgate[pos] = gate[(size_t)t * 4 + (tid & 3)]; tokpos[(size_t)t * 4 + (tid & 3)] = (int)pos; WSP(unsigned short, WS_ROUTE + 2 * MiB)[pos] = (unsigned short)t; }
    __syncthreads();
    if (blockIdx.x < 32) { const int e = blockIdx.x; const unsigned c = xb_ld(cnt + e), seg = lc[LC_SEG + e], pad = ((c + 255u) & ~255u) - c;
        unsigned short* rt = WSP(unsigned short, WS_ROUTE + 2 * MiB) + seg + c;
        for (unsigned q = tid; q < pad; q += NTHREADS) rt[q] = 0; }
    __syncthreads();
}

__device__ __forceinline__ void phase_ln2(const Args& a, int layer, float* fout, int tid, int lane, int wave) {
    const float* gn = a.in[I_LN2G] + layer * 1024; const float* bn = a.in[I_LN2B] + layer * 1024;
    const bf16* X1B = WSP(bf16, WS_X1B); const bf16* Ys = WSP(bf16, WS_YS); const int* tokpos = WSP(int, WS_ROUTE + 524288); bf16* XB = WSP(bf16, WS_XB);
    for (int i = 0; i < 8; ++i) {
        const int t = blockIdx.x * 64 + wave * 8 + i;
        const int4 pp = *(const int4*)(tokpos + (size_t)t * 4);
        f32x4 v[4]; float s = 0.f;
#pragma unroll
        for (int j = 0; j < 4; ++j) { const int k = 256 * j + 4 * lane; const v2u hw = *(const v2u*)(X1B + (size_t)t * 1024 + k);
            f32x4 h = (f32x4){bflo(hw.x), bfhi(hw.x), bflo(hw.y), bfhi(hw.y)} * ALPHA_DN;
            const unsigned char* Y8 = (const unsigned char*)Ys;
            const int w0 = *(const int*)(Y8 + (size_t)pp.x * 1024 + k), w1 = *(const int*)(Y8 + (size_t)pp.y * 1024 + k), w2 = *(const int*)(Y8 + (size_t)pp.z * 1024 + k), w3 = *(const int*)(Y8 + (size_t)pp.w * 1024 + k);
            const f32x2v a0 = __builtin_amdgcn_cvt_pk_f32_fp8(w0, false), a1 = __builtin_amdgcn_cvt_pk_f32_fp8(w1, false), a2 = __builtin_amdgcn_cvt_pk_f32_fp8(w2, false), a3 = __builtin_amdgcn_cvt_pk_f32_fp8(w3, false);
            const f32x2v c0 = __builtin_amdgcn_cvt_pk_f32_fp8(w0, true), c1 = __builtin_amdgcn_cvt_pk_f32_fp8(w1, true), c2 = __builtin_amdgcn_cvt_pk_f32_fp8(w2, true), c3 = __builtin_amdgcn_cvt_pk_f32_fp8(w3, true);
            h[0] += ((a0.x + a1.x) + (a2.x + a3.x)) * 0.0625f; h[1] += ((a0.y + a1.y) + (a2.y + a3.y)) * 0.0625f;
            h[2] += ((c0.x + c1.x) + (c2.x + c3.x)) * 0.0625f; h[3] += ((c0.y + c1.y) + (c2.y + c3.y)) * 0.0625f;
            v[j] = h; s += (h[0] + h[1]) + (h[2] + h[3]); }
        const float mean = wave_sum(s) * (1.0f / 1024.0f); float s2 = 0.f;
#pragma unroll
        for (int j = 0; j < 4; ++j) { v[j] = v[j] - mean; s2 += (v[j][0] * v[j][0] + v[j][1] * v[j][1]) + (v[j][2] * v[j][2] + v[j][3] * v[j][3]); }
        const float rstd = 1.0f / sqrtf(wave_sum(s2) * (1.0f / 1024.0f) + LN_EPS);
#pragma unroll
        for (int j = 0; j < 4; ++j) { const int k = 256 * j + 4 * lane; const f32x4 g4 = *(const f32x4*)(gn + k), b4 = *(const f32x4*)(bn + k);
            const f32x4 o = v[j] * rstd * g4 + b4;
            if (fout) *(f32x4*)(fout + (size_t)t * 1024 + k) = o;
            else { v2u w; w.x = pk2(o[0], o[1]); w.y = pk2(o[2], o[3]); *(v2u*)(XB + (size_t)t * 1024 + k) = w; } }
    }
}

__device__ __forceinline__ float da_lambda(const Args& a, int j, float lam_init, int lane) {
    const float q1 = a.in[I_DA_LQ1][j * 64 + lane], k1 = a.in[I_DA_LK1][j * 64 + lane], q2 = a.in[I_DA_LQ2][j * 64 + lane], k2 = a.in[I_DA_LK2][j * 64 + lane];
    return __expf(wave_sum(q1 * k1)) - __expf(wave_sum(q2 * k2)) + lam_init;
}
__device__ __forceinline__ void phase_mla_norm(const Args& a, int tid, int lane, int wave) {
    const float* C = WSP(float, WS_MISC + MLA_C); bf16* cqn = WSP(bf16, WS_MISC + MLA_CQN); bf16* ckvn = WSP(bf16, WS_MISC + MLA_CKVN); bf16* Kr = WSP(bf16, WS_MISC + MLA_KR);
    const cs_t* cs32 = WSP(cs_t, WS_CS32);
    const f32x4 gq = *(const f32x4*)(a.in[I_MLA_QN] + 4 * lane); const float gk0 = a.in[I_MLA_KVN][2 * lane], gk1 = a.in[I_MLA_KVN][2 * lane + 1];
    const int gw = blockIdx.x * NWAVES + wave, NGW = gridDim.x * NWAVES;
    for (int t = gw; t < S; t += NGW) {
        const float* row = C + (size_t)t * 512;
        const f32x4 q = *(const f32x4*)(row + 4 * lane);
        const float rq = 1.0f / sqrtf(wave_sum((q[0] * q[0] + q[1] * q[1]) + (q[2] * q[2] + q[3] * q[3])) * (1.0f / 256.0f) + RMS_EPS);
        v2u w; w.x = pk2(q[0] * rq * gq[0], q[1] * rq * gq[1]); w.y = pk2(q[2] * rq * gq[2], q[3] * rq * gq[3]); *(v2u*)(cqn + (size_t)t * 256 + 4 * lane) = w;
        const float k0 = row[256 + 2 * lane], k1 = row[256 + 2 * lane + 1];
        const float rk = 1.0f / sqrtf(wave_sum(k0 * k0 + k1 * k1) * (1.0f / 128.0f) + RMS_EPS);
        *(unsigned*)(ckvn + (size_t)t * 128 + 2 * lane) = pk2(k0 * rk * gk0, k1 * rk * gk1);
        if (lane < 16) { const float x1 = row[384 + lane], x2 = row[400 + lane]; const cs_t cs = cs32[(size_t)t * 16 + lane];
            Kr[(size_t)t * 32 + lane] = (bf16)f2bf(x1 * cs.c - x2 * cs.s); Kr[(size_t)t * 32 + 16 + lane] = (bf16)f2bf(x2 * cs.c + x1 * cs.s); }
    }
}

__device__ __forceinline__ void phase_nsa_cmp_gather(const Args& a, int tid) {
    const bf16* P = WSP(bf16, WS_MISC + NSA_P);
    const int gtid = blockIdx.x * NTHREADS + tid, GT = gridDim.x * NTHREADS;
    for (int id = gtid; id < 2 * 4096 * 256; id += GT) {
        const int c8 = id & 7, l = (id >> 3) & 31, n = (id >> 8) & 1023, g = (id >> 18) & 3, kv = id >> 20;
        bf16* dst = WSP(bf16, WS_MISC + (kv ? NSA_ACV : NSA_ACK)) + ((size_t)(g * 1024 + n) * 2048 + l * 64 + c8 * 8);
        v4u o = (v4u){0u, 0u, 0u, 0u};
        if (n < 1023) {
            const v4u x = *(const v4u*)(P + (size_t)(16 * n + l) * 768 + kv * 256 + g * 64 + c8 * 8);
            const float* pp = a.in[kv ? I_NSA_POSV : I_NSA_POSK] + l * 64 + c8 * 8;
            const f32x4 p0 = *(const f32x4*)pp, p1 = *(const f32x4*)(pp + 4);
            o.x = pk2(bflo(x.x) + p0[0], bfhi(x.x) + p0[1]); o.y = pk2(bflo(x.y) + p0[2], bfhi(x.y) + p0[3]);
            o.z = pk2(bflo(x.z) + p1[0], bfhi(x.z) + p1[1]); o.w = pk2(bflo(x.w) + p1[2], bfhi(x.w) + p1[3]);
        }
        *(v4u*)dst = o;
    }
}

struct BgConv {
    const Job* jb; LAS unsigned char* scr; int it, it_end, stride, lane, period, tick, sub; bool pending; float v[16];
    __device__ __forceinline__ void init(const Job* jb_, int nlayers, int first, int stride_, int lane_, int period_, LAS unsigned char* scr_) { jb = jb_; it = first; it_end = 12288 * nlayers; stride = stride_; lane = lane_; pending = false; period = period_; tick = 0; scr = scr_; sub = 0; }
    __device__ __forceinline__ int decode(const Job*& J, int& b, int& kb, int& nb) const {
        const int li = it / 12288, loc = it - li * 12288;
        if (loc < 8192) { J = jb + 2 * li; b = loc >> 8; const int r = loc & 255; kb = r >> 5; nb = r & 31; return 2; }
        const int i2 = loc - 8192; J = jb + 2 * li + 1; b = i2 >> 7; const int r = i2 & 127; kb = r >> 4; nb = r & 15; return 2; }
    __device__ __forceinline__ void issue() {
        if (it >= it_end) return;
        const Job* J; int b, kb, nb; const int f8 = decode(J, b, kb, nb);
        const float* W = J->src + (size_t)b * J->sbs + (size_t)(f8 == 1 ? 8 * kb + sub : 128 * kb + 16 * sub) * J->ld + 64 * nb + lane;
        const size_t rstep = (size_t)(f8 == 1 ? 64 : 1) * J->ld;
#pragma unroll
        for (int i = 0; i < 16; ++i) v[i] = __builtin_nontemporal_load(W + (size_t)i * rstep);
        pending = true; }
    __device__ __forceinline__ void retire() {
        if (!pending) return;
        const Job* J; int b, kb, nb; const bool f8 = decode(J, b, kb, nb) != 0;
        if (f8) { v4u o; int w;
            w = __builtin_amdgcn_cvt_pk_fp8_f32(v[0] * 64.f, v[1] * 64.f, 0, false); w = __builtin_amdgcn_cvt_pk_fp8_f32(v[2] * 64.f, v[3] * 64.f, w, true); o.x = (unsigned)w;
            w = __builtin_amdgcn_cvt_pk_fp8_f32(v[4] * 64.f, v[5] * 64.f, 0, false); w = __builtin_amdgcn_cvt_pk_fp8_f32(v[6] * 64.f, v[7] * 64.f, w, true); o.y = (unsigned)w;
            w = __builtin_amdgcn_cvt_pk_fp8_f32(v[8] * 64.f, v[9] * 64.f, 0, false); w = __builtin_amdgcn_cvt_pk_fp8_f32(v[10] * 64.f, v[11] * 64.f, w, true); o.z = (unsigned)w;
            w = __builtin_amdgcn_cvt_pk_fp8_f32(v[12] * 64.f, v[13] * 64.f, 0, false); w = __builtin_amdgcn_cvt_pk_fp8_f32(v[14] * 64.f, v[15] * 64.f, w, true); o.w = (unsigned)w;
            *(LAS v4u*)(scr + lane * 144 + sub * 16) = o;
        } else {
#pragma unroll
        for (int q = 0; q < 2; ++q) { v4u o; o.x = pk2(v[8 * q], v[8 * q + 1]); o.y = pk2(v[8 * q + 2], v[8 * q + 3]); o.z = pk2(v[8 * q + 4], v[8 * q + 5]); o.w = pk2(v[8 * q + 6], v[8 * q + 7]);
            *(LAS v4u*)(scr + lane * 144 + (2 * sub + q) * 16) = o; }
        }
        pending = false;
        if (sub < (f8 ? 7 : 3)) { ++sub; return; }
        asm volatile("s_waitcnt lgkmcnt(0)" ::: "memory");
        unsigned char* dstb = (unsigned char*)J->dst + (f8 ? (size_t)b * J->dbs + 128 * kb : ((size_t)b * J->dbs + 64 * kb) * 2);
        const size_t pitch = f8 ? (size_t)J->K : (size_t)J->K * 2;
        const int ln = (int)__builtin_amdgcn_mbcnt_hi(~0u, __builtin_amdgcn_mbcnt_lo(~0u, (unsigned)it)) - it;
#pragma unroll
        for (int s = 0; s < 8; ++s) { const int rl = 8 * s + (ln >> 3), ch = ln & 7;
            const v4u o = *(const LAS v4u*)(scr + rl * 144 + ch * 16);
            __builtin_nontemporal_store(o, (v4u*)(dstb + (size_t)cvt_dst_row(J->mode, 64 * nb + rl) * pitch + ch * 16)); }
        asm volatile("s_waitcnt lgkmcnt(0)" ::: "memory");
        sub = 0; it += stride; }
    __device__ __forceinline__ void begin() { if (++tick < period) return; tick = 0; issue(); }
    __device__ __forceinline__ void end() { if (tick == period - 1) retire(); }
    __device__ __forceinline__ void drain() { for (;;) { retire(); issue(); if (!pending) break; } }
};
struct BgNone { __device__ __forceinline__ void begin() {} __device__ __forceinline__ void end() {} };

#define MFMA32(A, B, C) __builtin_amdgcn_mfma_f32_32x32x16_bf16((A), (B), (C), 0, 0, 0)
#define MFMA16(A, B, C) __builtin_amdgcn_mfma_f32_16x16x32_bf16((A), (B), (C), 0, 0, 0)
__device__ __forceinline__ bf16x8 pack8(float a0, float a1, float a2, float a3, float a4, float a5, float a6, float a7) {
    v4u w; w.x = pk2(a0, a1); w.y = pk2(a2, a3); w.z = pk2(a4, a5); w.w = pk2(a6, a7); return __builtin_bit_cast(bf16x8, w);
}
__device__ __forceinline__ int pi32(int r) { return (r & ~12) | ((r & 4) << 1) | ((r & 8) >> 1); }
__device__ __forceinline__ float max3f(float a, float b, float c) { return __builtin_fmaxf(__builtin_fmaxf(a, b), c); }
__device__ __forceinline__ float max16(const f32x16& p) {
    const float a = max3f(p[0], p[1], p[2]), b = max3f(p[3], p[4], p[5]), c = max3f(p[6], p[7], p[8]), d = max3f(p[9], p[10], p[11]), e = max3f(p[12], p[13], p[14]);
    return max3f(max3f(a, b, c), max3f(d, e, p[15]), d);
}
struct AttnArgs {
    const bf16* Q0; const bf16* Q1; int ldq;
    const bf16* K0; int ldk0; const bf16* K1; int ldk1;
    const bf16* Vt; int ldv;
    bf16* O; int ldo;
    int window;
    const bf16* Qb; const bf16* Kb;
    float lam; const float* gain; float gscale;
    float kbound;
};
template <bool B> struct BoolC { static constexpr bool value = B; };
template <int DQK, int DV, bool PAIR = false, class BG = BgNone>
__device__ __forceinline__ void attn_unit(LAS unsigned char* lds, const AttnArgs& A, int q0, int tid_in, int lane_in, int wave, BG& bg) {
    const int lane = (int)__builtin_amdgcn_mbcnt_hi(~0u, __builtin_amdgcn_mbcnt_lo(~0u, (unsigned)q0)) - q0; const int tid = wave * 64 + lane; (void)tid_in; (void)lane_in;
    constexpr int KSB = (DQK + 8) * 2, VSB = 144, KBUF = 64 * KSB, BUFB = KBUF + DV * VSB;
    constexpr int NKS = DQK / 16, ND0 = DV / 32, KCH = DQK / 8;
    const int r32 = lane & 31, hi = lane >> 5;
    const int qw0 = q0 + 32 * wave, qrow = qw0 + r32;
    const int W = A.window;
    const int t_hi = (q0 >> 6) + 4;
    int t_lo = 0; if (W > 0) { const int lo = q0 - W + 1; t_lo = lo > 0 ? (lo >> 6) : 0; }
    constexpr int OA_OFF = 2 * BUFB, OA_ROWB = DV * 2 + 16;
    const bf16* Qp = A.Q0; const bf16* Kp = A.K0;
    bf16x8 qf[NKS];
    f32x16 o[ND0];
    float lsum = 0.f;
    constexpr int NKI = (64 * KCH + 511) / 512, NVI = DV * 8 / 512;
    v4u kA[NKI], vA[NVI];
    auto gload = [&](int t, v4u (&kreg)[NKI], v4u (&vreg)[NVI]) {
        const __amdgpu_buffer_rsrc_t rk0 = __builtin_amdgcn_make_buffer_rsrc((void*)Kp, 0, 0x7fffffff, 0x00020000);
        const __amdgpu_buffer_rsrc_t rk1 = __builtin_amdgcn_make_buffer_rsrc((void*)(KCH > 8 ? A.K1 : Kp), 0, 0x7fffffff, 0x00020000);
        const __amdgpu_buffer_rsrc_t rvt = __builtin_amdgcn_make_buffer_rsrc((void*)A.Vt, 0, 0x7fffffff, 0x00020000);
        const int k0s = t * 64 * A.ldk0 * 2, k1s = t * 64 * A.ldk1 * 2, vs = t * DV * 128;
#pragma unroll
        for (int i = 0; i < NKI; ++i) { const int c = tid + 512 * i;
            if ((64 * KCH) % 512 == 0 || c < 64 * KCH) { const int row = c / KCH, ch = c - row * KCH;
                if constexpr (KCH > 8) { kreg[i] = (ch < 8) ? __builtin_bit_cast(v4u, __builtin_amdgcn_raw_buffer_load_b128(rk0, (row * A.ldk0 + ch * 8) * 2, k0s, 0))
                                                            : __builtin_bit_cast(v4u, __builtin_amdgcn_raw_buffer_load_b128(rk1, (row * A.ldk1 + (ch - 8) * 8) * 2, k1s, 0)); }
                else kreg[i] = __builtin_bit_cast(v4u, __builtin_amdgcn_raw_buffer_load_b128(rk0, (row * A.ldk0 + ch * 8) * 2, k0s, 0)); } }
#pragma unroll
        for (int i = 0; i < NVI; ++i) { const int c = tid + 512 * i; vreg[i] = __builtin_bit_cast(v4u, __builtin_amdgcn_raw_buffer_load_b128(rvt, c * 16, vs, 0)); }
    };
    auto sstore = [&](int stage, const v4u (&kreg)[NKI], const v4u (&vreg)[NVI]) {
        LAS unsigned char* Kb = lds + stage * BUFB; LAS unsigned char* Vb = Kb + KBUF;
#pragma unroll
        for (int i = 0; i < NKI; ++i) { const int c = tid + 512 * i;
            if ((64 * KCH) % 512 == 0 || c < 64 * KCH) { const int row = c / KCH, ch = c - row * KCH; *(LAS v4u*)(Kb + row * KSB + ch * 16) = kreg[i]; } }
#pragma unroll
        for (int i = 0; i < NVI; ++i) { const int c = tid + 512 * i; const int row = c >> 3, ch = c & 7; *(LAS v4u*)(Vb + row * VSB + ch * 16) = vreg[i]; }
    };
    const int pr = pi32(r32);
    float mhat = 0.f;
    auto compute = [&](int t, int stage, auto ft) {
        constexpr bool FAST = decltype(ft)::value;
        const int kv0 = t * 64;
        const bool skip = (kv0 > qw0 + 31) || (W > 0 && kv0 + 63 <= qw0 - W);
        if (!skip) {
            const LAS unsigned char* Kb = lds + stage * BUFB; const LAS unsigned char* Vb = Kb + KBUF;
            f32x16 p0, p1;
#pragma unroll
            for (int r = 0; r < 16; ++r) { p0[r] = FAST ? 0.f : -mhat; p1[r] = FAST ? 0.f : -mhat; }
            bf16x8 kfr[2 * NKS];
#pragma unroll
            for (int ks = 0; ks < NKS; ++ks) { kfr[2 * ks] = *(const LAS bf16x8*)(Kb + pr * KSB + ks * 32 + hi * 16); kfr[2 * ks + 1] = *(const LAS bf16x8*)(Kb + (32 + pr) * KSB + ks * 32 + hi * 16); }
            asm volatile("s_waitcnt lgkmcnt(0)" ::: "memory");
            bf16x8 vfr[4 * ND0];
#pragma unroll
            for (int d = 0; d < ND0 / 2; ++d)
#pragma unroll
                for (int hf = 0; hf < 2; ++hf)
#pragma unroll
                    for (int jj = 0; jj < 2; ++jj) vfr[4 * d + 2 * hf + jj] = *(const LAS bf16x8*)(Vb + (32 * d + r32) * VSB + (32 * hf + 16 * jj + 8 * hi) * 2);
            __builtin_amdgcn_sched_barrier(0);
#pragma unroll
            for (int ks = 0; ks < NKS; ++ks) { p0 = MFMA32(kfr[2 * ks], qf[ks], p0); p1 = MFMA32(kfr[2 * ks + 1], qf[ks], p1); }
            __builtin_amdgcn_sched_barrier(0);
#pragma unroll
            for (int d = ND0 / 2; d < ND0; ++d)
#pragma unroll
                for (int hf = 0; hf < 2; ++hf)
#pragma unroll
                    for (int jj = 0; jj < 2; ++jj) vfr[4 * d + 2 * hf + jj] = *(const LAS bf16x8*)(Vb + (32 * d + r32) * VSB + (32 * hf + 16 * jj + 8 * hi) * 2);
            __builtin_amdgcn_sched_barrier(0);
            const bool need_mask = (kv0 + 63 > qw0) || (W > 0 && kv0 <= qw0 + 31 - W);
            if (need_mask) {
#pragma unroll
                for (int r = 0; r < 16; ++r) { const int kv = kv0 + 16 * (r >> 3) + 8 * hi + (r & 7);
                    const bool v0 = (kv <= qrow) && (W == 0 || kv > qrow - W), v1 = (kv + 32 <= qrow) && (W == 0 || kv + 32 > qrow - W);
                    p0[r] = v0 ? p0[r] : -INFINITY; p1[r] = v1 ? p1[r] : -INFINITY; }
            }
            if constexpr (!FAST) {
            float mx = fmaxf(max16(p0), max16(p1)); mx = fmaxf(mx, swap32f(mx, hi));
            const bool move = (mx > 8.0f) || (lsum == 0.f && mx != 0.f && mx != -INFINITY);
            if (__any(move)) {
                const float d = move ? mx : 0.f; const float alpha = __builtin_amdgcn_exp2f(-d);
                mhat += d; lsum *= alpha;
#pragma unroll
                for (int r = 0; r < 16; ++r) { p0[r] -= d; p1[r] -= d; }
#pragma unroll
                for (int d0 = 0; d0 < ND0; ++d0)
#pragma unroll
                    for (int r = 0; r < 16; ++r) o[d0][r] *= alpha;
            }
            }
#pragma unroll
            for (int r = 0; r < 16; ++r) { p0[r] = __builtin_amdgcn_exp2f(p0[r]); p1[r] = __builtin_amdgcn_exp2f(p1[r]); }
            lsum += sum32pk(p0, p1);
            bf16x8 pf[2][2];
            pf[0][0] = pack8(p0[0], p0[1], p0[2], p0[3], p0[4], p0[5], p0[6], p0[7]); pf[0][1] = pack8(p0[8], p0[9], p0[10], p0[11], p0[12], p0[13], p0[14], p0[15]);
            pf[1][0] = pack8(p1[0], p1[1], p1[2], p1[3], p1[4], p1[5], p1[6], p1[7]); pf[1][1] = pack8(p1[8], p1[9], p1[10], p1[11], p1[12], p1[13], p1[14], p1[15]);
            asm volatile("s_waitcnt lgkmcnt(0)" ::: "memory");
#pragma unroll
            for (int d = 0; d < ND0; ++d)
#pragma unroll
                for (int hf = 0; hf < 2; ++hf)
#pragma unroll
                    for (int jj = 0; jj < 2; ++jj) o[d] = MFMA32(vfr[4 * d + 2 * hf + jj], pf[hf][jj], o[d]);
        }
    };
    for (int pass = 0; pass < (PAIR ? 2 : 1); ++pass) {
        if (PAIR && pass) { Qp = A.Qb; Kp = A.Kb; }
#pragma unroll
        for (int ks = 0; ks < NKS; ++ks) { if (ks < 4) qf[ks] = *(const bf16x8*)(Qp + (size_t)qrow * A.ldq + ks * 16 + hi * 8); else qf[ks] = *(const bf16x8*)(A.Q1 + (size_t)qrow * A.ldq + (ks - 4) * 16 + hi * 8); }
#pragma unroll
        for (int d = 0; d < ND0; ++d)
#pragma unroll
            for (int r = 0; r < 16; ++r) o[d][r] = 0.f;
        lsum = 0.f; mhat = 0.f;
        gload(t_lo, kA, vA); sstore(0, kA, vA); if (t_lo + 1 < t_hi) gload(t_lo + 1, kA, vA); __syncthreads();
#pragma unroll
        for (int ks = 0; ks < NKS; ++ks) asm volatile("" :: "v"(qf[ks]));
        float q2n = 0.f;
#pragma unroll
        for (int ks = 0; ks < NKS; ++ks) { const v4u w = __builtin_bit_cast(v4u, qf[ks]);
            q2n += (bflo(w.x) * bflo(w.x) + bfhi(w.x) * bfhi(w.x)) + (bflo(w.y) * bflo(w.y) + bfhi(w.y) * bfhi(w.y))
                 + (bflo(w.z) * bflo(w.z) + bfhi(w.z) * bfhi(w.z)) + (bflo(w.w) * bflo(w.w) + bfhi(w.w) * bfhi(w.w)); }
        q2n += swap32f(q2n, hi);
        const bool fast = !__any(!(q2n * A.kbound <= 4096.0f));
        auto run = [&](auto ft) {
        for (int t = t_lo; t < t_hi; ++t) {
            const int buf = (t - t_lo) & 1;
            if (t + 1 < t_hi) sstore(buf ^ 1, kA, vA);
            if (t + 2 < t_hi) gload(t + 2, kA, vA);
            constexpr bool HOST = decltype(ft)::value;
            if constexpr (HOST) bg.begin();
            compute(t, buf, ft);
            if constexpr (HOST) bg.end();
            __syncthreads();
        } };
        if (fast) run(BoolC<true>{}); else run(BoolC<false>{});
        if (PAIR && pass == 0) {
            const float lt0 = lsum + swap32f(lsum, hi); const float inv0 = lt0 > 0.f ? 1.0f / lt0 : 0.f;
            LAS unsigned char* oa = lds + OA_OFF + (32 * wave + r32) * OA_ROWB + 8 * hi;
#pragma unroll
            for (int d = 0; d < ND0; ++d)
#pragma unroll
                for (int g4 = 0; g4 < 4; ++g4) { v2u w; w.x = pk2(o[d][4 * g4] * inv0, o[d][4 * g4 + 1] * inv0); w.y = pk2(o[d][4 * g4 + 2] * inv0, o[d][4 * g4 + 3] * inv0);
                    *(LAS v2u*)(oa + (32 * d + 8 * g4) * 2) = w; }
        }
    }
    const float lt = lsum + swap32f(lsum, hi); const float inv = lt > 0.f ? 1.0f / lt : 0.f;
    const int dep_e = __builtin_amdgcn_readfirstlane(__builtin_bit_cast(int, lt));
    const int lane_e = (int)__builtin_amdgcn_mbcnt_hi(~0u, __builtin_amdgcn_mbcnt_lo(~0u, (unsigned)dep_e)) - dep_e;
    bf16* orow = A.O + (size_t)(qw0 + (lane_e & 31)) * A.ldo - 4 * hi + 4 * (lane_e >> 5);
    if constexpr (PAIR) {
        const LAS unsigned char* oa = lds + OA_OFF + (32 * wave + r32) * OA_ROWB + 8 * hi;
        float ss = 0.f;
#pragma unroll
        for (int d = 0; d < ND0; ++d)
#pragma unroll
            for (int g4 = 0; g4 < 4; ++g4) { const v2u w = *(const LAS v2u*)(oa + (32 * d + 8 * g4) * 2);
                const float d0 = bflo(w.x) - A.lam * (o[d][4 * g4] * inv), d1 = bfhi(w.x) - A.lam * (o[d][4 * g4 + 1] * inv), d2 = bflo(w.y) - A.lam * (o[d][4 * g4 + 2] * inv), d3 = bfhi(w.y) - A.lam * (o[d][4 * g4 + 3] * inv);
                o[d][4 * g4] = d0; o[d][4 * g4 + 1] = d1; o[d][4 * g4 + 2] = d2; o[d][4 * g4 + 3] = d3; ss += (d0 * d0 + d1 * d1) + (d2 * d2 + d3 * d3); }
        ss += swap32f(ss, hi);
        const float rr = A.gscale / sqrtf(ss * (1.0f / DV) + LN_EPS);
#pragma unroll
        for (int d = 0; d < ND0; ++d)
#pragma unroll
            for (int g4 = 0; g4 < 4; ++g4) { const f32x4 gg = *(const f32x4*)(A.gain + 32 * d + 8 * g4 + 4 * hi);
                v2u w; w.x = pk2(o[d][4 * g4] * rr * gg[0], o[d][4 * g4 + 1] * rr * gg[1]); w.y = pk2(o[d][4 * g4 + 2] * rr * gg[2], o[d][4 * g4 + 3] * rr * gg[3]);
                *(v2u*)(orow + 32 * d + 8 * g4 + 4 * hi) = w; }
    } else {
#pragma unroll
    for (int d = 0; d < ND0; ++d)
#pragma unroll
        for (int g4 = 0; g4 < 4; ++g4) { v2u w; w.x = pk2(o[d][4 * g4] * inv, o[d][4 * g4 + 1] * inv); w.y = pk2(o[d][4 * g4 + 2] * inv, o[d][4 * g4 + 3] * inv);
            *(v2u*)(orow + 32 * d + 8 * g4 + 4 * hi) = w; }
    }
}

constexpr int CMP_IMP_B = 64 * 257 * 4, CMP_KB = 64 * 144;
__device__ __forceinline__ float quad_sum(float v) {
    v += __builtin_bit_cast(float, __builtin_amdgcn_update_dpp(0, __builtin_bit_cast(int, v), 0xB1, 0xF, 0xF, true));
    v += __builtin_bit_cast(float, __builtin_amdgcn_update_dpp(0, __builtin_bit_cast(int, v), 0x4E, 0xF, 0xF, true));
    return v;
}
__device__ __forceinline__ void nsa_cmp_unit(LAS unsigned char* lds, const Args& a, int T, int g, int tid_in, int lane_in, int wave, float kbound) {
    const int lane = (int)__builtin_amdgcn_mbcnt_hi(~0u, __builtin_amdgcn_mbcnt_lo(~0u, (unsigned)T)) - T; const int tid = wave * 64 + lane; (void)tid_in; (void)lane_in;
    const bf16* R = WSP(bf16, WS_QK); const bf16* Kc = WSP(bf16, WS_MISC + NSA_KC); const bf16* VcT = WSP(bf16, WS_MISC + NSA_VCT);
    bf16* Oc = WSP(bf16, WS_OH); unsigned* selm = WSP(unsigned, WS_MISC + NSA_SEL);
    const int r32 = lane & 31, hi = lane >> 5, q0 = 64 * T;
    const int ql = 8 * wave + (r32 >> 2), hd = r32 & 3, h = 4 * g + hd, qrow = q0 + ql;
    const int nlim = (qrow >= 31) ? ((qrow - 31) >> 4) : -1;
    const int qw_lo = q0 + 8 * wave, qw_hi = qw_lo + 7;
    const int nlim_lo = (qw_lo >= 31) ? ((qw_lo - 31) >> 4) : -1, nlim_hi = (qw_hi >= 31) ? ((qw_hi - 31) >> 4) : -1;
    const int NT = (((q0 + 32) >> 4) >> 6) + 1;
    LAS float* imp = (LAS float*)lds;
    LAS unsigned char* kb0 = lds + CMP_IMP_B; LAS unsigned char* vb0 = kb0 + 2 * CMP_KB;
    for (int i = tid; i < 64 * 257; i += NTHREADS) imp[i] = 0.f;
    bf16x8 qf[4];
#pragma unroll
    for (int ks = 0; ks < 4; ++ks) qf[ks] = *(const bf16x8*)(R + (size_t)qrow * 1024 + 64 * h + ks * 16 + hi * 8);
    const int pr = pi32(r32);
    const int lrow = tid >> 3, lch = tid & 7;
    const bf16* Ksrc = Kc + (size_t)(g * 1024) * 64 + tid * 8;
    const bf16* Vsrc = VcT + (size_t)lrow * 4096 + g * 1024 + lch * 8;
    const int soff = lrow * 144 + lch * 16;
    v4u kreg, vreg;
    float mhat = 0.f, lsum = 0.f;
    auto qk = [&](const LAS unsigned char* Kb, int n0, f32x16& p0, f32x16& p1, auto ft) {
        constexpr bool FAST = decltype(ft)::value;
#pragma unroll
        for (int r = 0; r < 16; ++r) { p0[r] = FAST ? 0.f : -mhat; p1[r] = FAST ? 0.f : -mhat; }
        bf16x8 kfr[8];
#pragma unroll
        for (int ks = 0; ks < 4; ++ks) { kfr[2 * ks] = *(const LAS bf16x8*)(Kb + pr * 144 + ks * 32 + hi * 16); kfr[2 * ks + 1] = *(const LAS bf16x8*)(Kb + (32 + pr) * 144 + ks * 32 + hi * 16); }
        asm volatile("s_waitcnt lgkmcnt(0)" ::: "memory");
        __builtin_amdgcn_sched_barrier(0);
#pragma unroll
        for (int ks = 0; ks < 4; ++ks) { p0 = MFMA32(kfr[2 * ks], qf[ks], p0); p1 = MFMA32(kfr[2 * ks + 1], qf[ks], p1); }
        if (n0 + 63 > nlim_lo) {
#pragma unroll
            for (int r = 0; r < 16; ++r) { const int n = n0 + 16 * (r >> 3) + 8 * hi + (r & 7); p0[r] = (n <= nlim) ? p0[r] : -INFINITY; p1[r] = (n + 32 <= nlim) ? p1[r] : -INFINITY; }
        }
    };
    kreg = *(const v4u*)Ksrc; *(LAS v4u*)(kb0 + soff) = kreg; if (1 < NT) kreg = *(const v4u*)(Ksrc + 4096); __syncthreads();
#pragma unroll
    for (int ks = 0; ks < 4; ++ks) asm volatile("" :: "v"(qf[ks]));
    float q2n = 0.f;
#pragma unroll
    for (int ks = 0; ks < 4; ++ks) { const v4u w = __builtin_bit_cast(v4u, qf[ks]);
        q2n += (bflo(w.x) * bflo(w.x) + bfhi(w.x) * bfhi(w.x)) + (bflo(w.y) * bflo(w.y) + bfhi(w.y) * bfhi(w.y))
             + (bflo(w.z) * bflo(w.z) + bfhi(w.z) * bfhi(w.z)) + (bflo(w.w) * bflo(w.w) + bfhi(w.w) * bfhi(w.w)); }
    q2n += swap32f(q2n, hi);
    const bool fast = !__any(!(q2n * kbound <= 4096.0f));
    auto pass1 = [&](auto ft) {
    constexpr bool FAST = decltype(ft)::value;
    for (int t = 0; t < NT; ++t) {
        const int buf = t & 1, n0 = 64 * t;
        if (t + 1 < NT) *(LAS v4u*)(kb0 + (buf ^ 1) * CMP_KB + soff) = kreg;
        if (t + 2 < NT) kreg = *(const v4u*)(Ksrc + (size_t)(t + 2) * 4096);
        if (n0 <= nlim_hi) {
            f32x16 p0, p1; qk(kb0 + buf * CMP_KB, n0, p0, p1, ft);
            if constexpr (!FAST) {
            float mx = fmaxf(max16(p0), max16(p1)); mx = fmaxf(mx, swap32f(mx, hi));
            const bool move = (mx > 8.0f) || (lsum == 0.f && mx != 0.f && mx != -INFINITY);
            if (__any(move)) { const float d = move ? mx : 0.f; mhat += d; lsum *= __builtin_amdgcn_exp2f(-d);
#pragma unroll
                for (int r = 0; r < 16; ++r) { p0[r] -= d; p1[r] -= d; } }
            }
#pragma unroll
            for (int r = 0; r < 16; ++r) { p0[r] = __builtin_amdgcn_exp2f(p0[r]); p1[r] = __builtin_amdgcn_exp2f(p1[r]); }
            lsum += sum32pk(p0, p1);
        }
        __syncthreads();
    } };
    if (fast) pass1(BoolC<true>{}); else pass1(BoolC<false>{});
    const float lt = lsum + swap32f(lsum, hi); const float inv = lt > 0.f ? 1.0f / lt : 0.f;
    f32x16 o[2];
#pragma unroll
    for (int d = 0; d < 2; ++d)
#pragma unroll
        for (int r = 0; r < 16; ++r) o[d][r] = 0.f;
    kreg = *(const v4u*)Ksrc; vreg = *(const v4u*)Vsrc;
    *(LAS v4u*)(kb0 + soff) = kreg; *(LAS v4u*)(vb0 + soff) = vreg;
    if (1 < NT) { kreg = *(const v4u*)(Ksrc + 4096); vreg = *(const v4u*)(Vsrc + 64); }
    __syncthreads();
    LAS float* irow = imp + ql * 257 + 4 * hd + 2 * hi;
    for (int t = 0; t < NT; ++t) {
        const int buf = t & 1, n0 = 64 * t;
        if (t + 1 < NT) { *(LAS v4u*)(kb0 + (buf ^ 1) * CMP_KB + soff) = kreg; *(LAS v4u*)(vb0 + (buf ^ 1) * CMP_KB + soff) = vreg; }
        if (t + 2 < NT) { kreg = *(const v4u*)(Ksrc + (size_t)(t + 2) * 4096); vreg = *(const v4u*)(Vsrc + 64 * (t + 2)); }
        if (n0 <= nlim_hi) {
            const LAS unsigned char* Vb = vb0 + buf * CMP_KB;
            f32x16 p0, p1; qk(kb0 + buf * CMP_KB, n0, p0, p1, BoolC<false>{});
            bf16x8 vfr[8];
#pragma unroll
            for (int d = 0; d < 2; ++d)
#pragma unroll
                for (int q = 0; q < 4; ++q) vfr[4 * d + q] = *(const LAS bf16x8*)(Vb + (32 * d + r32) * 144 + (16 * q + 8 * hi) * 2);
#pragma unroll
            for (int r = 0; r < 16; ++r) { p0[r] = __builtin_amdgcn_exp2f(p0[r]) * inv; p1[r] = __builtin_amdgcn_exp2f(p1[r]) * inv; }
            float s0[4], s1[4], s2[4];
#pragma unroll
            for (int gq = 0; gq < 4; ++gq) { const f32x16& p = (gq >> 1) ? p1 : p0; const int b8 = 8 * (gq & 1);
                s0[gq] = quad_sum(2.f * (p[b8] + p[b8 + 1] + p[b8 + 2]) + p[b8 + 3]);
                s1[gq] = quad_sum(p[b8 + 3] + 2.f * (p[b8 + 4] + p[b8 + 5] + p[b8 + 6]) + p[b8 + 7]);
                s2[gq] = quad_sum(p[b8 + 7]); }
            const float a0 = hd == 0 ? s0[0] : hd == 1 ? s0[1] : hd == 2 ? s0[2] : s0[3];
            const float a1 = hd == 0 ? s1[0] : hd == 1 ? s1[1] : hd == 2 ? s1[2] : s1[3];
            const float a2 = hd == 0 ? s2[0] : hd == 1 ? s2[1] : hd == 2 ? s2[2] : s2[3];
            LAS float* ip = irow + (n0 >> 2);
            { const float x0 = ip[0], x1 = ip[1]; ip[0] = x0 + a0; ip[1] = x1 + a1; }
            asm volatile("s_waitcnt lgkmcnt(0)" ::: "memory");
            { const float x2 = ip[2]; ip[2] = x2 + a2; }
            bf16x8 pf[4];
            pf[0] = pack8(p0[0], p0[1], p0[2], p0[3], p0[4], p0[5], p0[6], p0[7]); pf[1] = pack8(p0[8], p0[9], p0[10], p0[11], p0[12], p0[13], p0[14], p0[15]);
            pf[2] = pack8(p1[0], p1[1], p1[2], p1[3], p1[4], p1[5], p1[6], p1[7]); pf[3] = pack8(p1[8], p1[9], p1[10], p1[11], p1[12], p1[13], p1[14], p1[15]);
            asm volatile("s_waitcnt lgkmcnt(0)" ::: "memory");
#pragma unroll
            for (int d = 0; d < 2; ++d)
#pragma unroll
                for (int q = 0; q < 4; ++q) o[d] = MFMA32(vfr[4 * d + q], pf[q], o[d]);
        }
        __syncthreads();
    }
    { bf16* orow = Oc + (size_t)qrow * 1024 + 64 * h;
#pragma unroll
      for (int d = 0; d < 2; ++d)
#pragma unroll
          for (int g4 = 0; g4 < 4; ++g4) { v2u w; w.x = pk2(o[d][4 * g4], o[d][4 * g4 + 1]); w.y = pk2(o[d][4 * g4 + 2], o[d][4 * g4 + 3]); *(v2u*)(orow + 32 * d + 8 * g4 + 4 * hi) = w; } }
    for (int i = 0; i < 8; ++i) {
        const int qq = 8 * wave + i;
        unsigned kb[4]; bool selb[4], cand[4];
#pragma unroll
        for (int s = 0; s < 4; ++s) { const int j = lane + 64 * s; selb[s] = (j <= T) && (T <= 15 || j == 0 || j >= T - 1);
            cand[s] = (T > 15) && (j >= 1) && (j <= T - 2);
            kb[s] = cand[s] ? __float_as_uint(imp[qq * 257 + j]) : 0u; }
        if (T > 15) {
            unsigned prefix = 0u;
            const int ns = ((T - 2) >> 6) + 1;
            for (int b = 30; b >= 0; --b) { const unsigned t = prefix | (1u << b);
                int cnt = __popcll(__ballot(cand[0] && kb[0] >= t));
                if (ns > 1) cnt += __popcll(__ballot(cand[1] && kb[1] >= t));
                if (ns > 2) cnt += __popcll(__ballot(cand[2] && kb[2] >= t));
                if (ns > 3) cnt += __popcll(__ballot(cand[3] && kb[3] >= t));
                if (cnt >= 13) prefix = t;
                if (cnt == 13) break; }
            const int ngt = __popcll(__ballot(cand[0] && kb[0] > prefix)) + __popcll(__ballot(cand[1] && kb[1] > prefix)) + __popcll(__ballot(cand[2] && kb[2] > prefix)) + __popcll(__ballot(cand[3] && kb[3] > prefix));
            const int need = 13 - ngt; int running = 0;
#pragma unroll
            for (int s = 0; s < 4; ++s) { const bool eq = cand[s] && kb[s] == prefix; const unsigned long long mk = __ballot(eq);
                const int rank = running + (int)__builtin_amdgcn_mbcnt_hi((unsigned)(mk >> 32), __builtin_amdgcn_mbcnt_lo((unsigned)mk, 0u));
                if (cand[s] && (kb[s] > prefix || (eq && rank < need))) selb[s] = true;
                running += __popcll(mk); }
        }
        const unsigned long long m0 = __ballot(selb[0]), m1 = __ballot(selb[1]), m2 = __ballot(selb[2]), m3 = __ballot(selb[3]);
        if (lane == 0) { unsigned* dst = selm + ((size_t)(q0 + qq) * 4 + g) * 8;
            *(v4u*)dst = (v4u){(unsigned)m0, (unsigned)(m0 >> 32), (unsigned)m1, (unsigned)(m1 >> 32)};
            *(v4u*)(dst + 4) = (v4u){(unsigned)m2, (unsigned)(m2 >> 32), (unsigned)m3, (unsigned)(m3 >> 32)}; }
    }
    __syncthreads();
}

__device__ __forceinline__ void nsa_sel_unit(LAS unsigned char* lds, const Args& a, int T, int g, int tid_in, int lane_in, int wave, float kbound) {
    const int lane = (int)__builtin_amdgcn_mbcnt_hi(~0u, __builtin_amdgcn_mbcnt_lo(~0u, (unsigned)T)) - T; const int tid = wave * 64 + lane; (void)tid_in; (void)lane_in;
    const bf16* R = WSP(bf16, WS_QK); const bf16* VT = WSP(bf16, WS_VT); const bf16* P = WSP(bf16, WS_MISC + NSA_P);
    const bf16* Oc = WSP(bf16, WS_OH); const bf16* Ow = WSP(bf16, WS_OH + 32 * MiB); bf16* Ao = WSP(bf16, WS_AO);
    const unsigned* selm = WSP(unsigned, WS_MISC + NSA_SEL);
    constexpr int KSB = 144, VSB = 144, KBUF = 64 * KSB, BUFB = 2 * KBUF;
    const int r32 = lane & 31, hi = lane >> 5, q0 = 64 * T;
    const int ql = 8 * wave + (r32 >> 2), hd = r32 & 3, h = 4 * g + hd, qrow = q0 + ql;
    bf16x8 qf[4];
#pragma unroll
    for (int ks = 0; ks < 4; ++ks) qf[ks] = *(const bf16x8*)(R + (size_t)qrow * 1024 + 64 * h + ks * 16 + hi * 8);
    const unsigned* selp = selm + ((size_t)qrow * 4 + g) * 8; unsigned selw = 0u;
    const v4u sm0 = *(const v4u*)selp, sm1 = *(const v4u*)(selp + 4);
    f32x16 o[2];
#pragma unroll
    for (int d = 0; d < 2; ++d)
#pragma unroll
        for (int r = 0; r < 16; ++r) o[d][r] = 0.f;
    float lsum = 0.f, mhat = 0.f;
    const int lrow = tid >> 3, lch = tid & 7, soff = lrow * 144 + lch * 16;
    const bf16* Ksrc = WSP(bf16, WS_KH) + (size_t)g * S * 64 + tid * 8; const bf16* Vsrc = VT + (size_t)g * S * 64 + tid * 8;
    v4u kA, vA, kB, vB, kC, vC;
    const int NP = T / 3 + 1;
    kA = *(const v4u*)Ksrc; vA = *(const v4u*)Vsrc;
    *(LAS v4u*)(lds + soff) = kA; *(LAS v4u*)(lds + KBUF + soff) = vA;
    if (1 <= T) { kB = *(const v4u*)(Ksrc + 4096); vB = *(const v4u*)(Vsrc + 4096); *(LAS v4u*)(lds + BUFB + soff) = kB; *(LAS v4u*)(lds + BUFB + KBUF + soff) = vB; }
    if (2 <= T) { kC = *(const v4u*)(Ksrc + 2 * 4096); vC = *(const v4u*)(Vsrc + 2 * 4096); *(LAS v4u*)(lds + 2 * BUFB + soff) = kC; *(LAS v4u*)(lds + 2 * BUFB + KBUF + soff) = vC; }
    if (3 <= T) { kA = *(const v4u*)(Ksrc + 3 * 4096); vA = *(const v4u*)(Vsrc + 3 * 4096); }
    if (4 <= T) { kB = *(const v4u*)(Ksrc + 4 * 4096); vB = *(const v4u*)(Vsrc + 4 * 4096); }
    if (5 <= T) { kC = *(const v4u*)(Ksrc + 5 * 4096); vC = *(const v4u*)(Vsrc + 5 * 4096); }
    __syncthreads();
#pragma unroll
    for (int ks = 0; ks < 4; ++ks) asm volatile("" :: "v"(qf[ks]));
    LAS unsigned* smk = (LAS unsigned*)(lds + 6 * BUFB) + tid * 8;
    *(LAS v4u*)smk = sm0; *(LAS v4u*)(smk + 4) = sm1;
    const int pr = pi32(r32);
    auto compute = [&](int j, int boff, auto ft) {
        constexpr bool FAST = decltype(ft)::value;
        if ((j & 31) == 0) selw = smk[j >> 5];
        const bool mine = (selw >> (j & 31)) & 1u;
        if (__any(mine)) {
            const LAS unsigned char* Kb = lds + boff; const LAS unsigned char* Vb = Kb + KBUF;
            f32x16 p0, p1;
            { const float init = mine ? (FAST ? 0.f : -mhat) : -INFINITY;
#pragma unroll
              for (int r = 0; r < 16; ++r) { p0[r] = init; p1[r] = init; } }
            bf16x8 kfr[8];
#pragma unroll
            for (int ks = 0; ks < 4; ++ks) { kfr[2 * ks] = *(const LAS bf16x8*)(Kb + pr * KSB + ks * 32 + hi * 16); kfr[2 * ks + 1] = *(const LAS bf16x8*)(Kb + (32 + pr) * KSB + ks * 32 + hi * 16); }
            asm volatile("s_waitcnt lgkmcnt(0)" ::: "memory");
            bf16x8 vfr[8];
#pragma unroll
            for (int d = 0; d < 2; ++d)
#pragma unroll
                for (int hf = 0; hf < 2; ++hf)
#pragma unroll
                    for (int jj = 0; jj < 2; ++jj) vfr[4 * d + 2 * hf + jj] = *(const LAS bf16x8*)(Vb + (32 * d + r32) * VSB + (32 * hf + 16 * jj + 8 * hi) * 2);
            __builtin_amdgcn_sched_barrier(0);
#pragma unroll
            for (int ks = 0; ks < 4; ++ks) { p0 = MFMA32(kfr[2 * ks], qf[ks], p0); p1 = MFMA32(kfr[2 * ks + 1], qf[ks], p1); }
            if (j == T) {
#pragma unroll
                for (int r = 0; r < 16; ++r) { const int kvl = 16 * (r >> 3) + 8 * hi + (r & 7);
                    p0[r] = (kvl <= ql) ? p0[r] : -INFINITY; p1[r] = (kvl + 32 <= ql) ? p1[r] : -INFINITY; }
            }
            if constexpr (!FAST) {
            float mx = fmaxf(max16(p0), max16(p1)); mx = fmaxf(mx, swap32f(mx, hi));
            const bool move = (mx > 8.0f) || (lsum == 0.f && mx != 0.f && mx != -INFINITY);
            if (__any(move)) {
                const float d = move ? mx : 0.f; const float alpha = __builtin_amdgcn_exp2f(-d);
                mhat += d; lsum *= alpha;
#pragma unroll
                for (int r = 0; r < 16; ++r) { p0[r] -= d; p1[r] -= d; }
#pragma unroll
                for (int d0 = 0; d0 < 2; ++d0)
#pragma unroll
                    for (int r = 0; r < 16; ++r) o[d0][r] *= alpha;
            }
            }
#pragma unroll
            for (int r = 0; r < 16; ++r) { p0[r] = __builtin_amdgcn_exp2f(p0[r]); p1[r] = __builtin_amdgcn_exp2f(p1[r]); }
            lsum += sum32pk(p0, p1);
            bf16x8 pf[2][2];
            pf[0][0] = pack8(p0[0], p0[1], p0[2], p0[3], p0[4], p0[5], p0[6], p0[7]); pf[0][1] = pack8(p0[8], p0[9], p0[10], p0[11], p0[12], p0[13], p0[14], p0[15]);
            pf[1][0] = pack8(p1[0], p1[1], p1[2], p1[3], p1[4], p1[5], p1[6], p1[7]); pf[1][1] = pack8(p1[8], p1[9], p1[10], p1[11], p1[12], p1[13], p1[14], p1[15]);
            asm volatile("s_waitcnt lgkmcnt(0)" ::: "memory");
#pragma unroll
            for (int d = 0; d < 2; ++d)
#pragma unroll
                for (int hf = 0; hf < 2; ++hf)
#pragma unroll
                    for (int jj = 0; jj < 2; ++jj) o[d] = MFMA32(vfr[4 * d + 2 * hf + jj], pf[hf][jj], o[d]);
        }
    };
    float q2n = 0.f;
#pragma unroll
    for (int ks = 0; ks < 4; ++ks) { const v4u w = __builtin_bit_cast(v4u, qf[ks]);
        q2n += (bflo(w.x) * bflo(w.x) + bfhi(w.x) * bfhi(w.x)) + (bflo(w.y) * bflo(w.y) + bfhi(w.y) * bfhi(w.y))
             + (bflo(w.z) * bflo(w.z) + bfhi(w.z) * bfhi(w.z)) + (bflo(w.w) * bflo(w.w) + bfhi(w.w) * bfhi(w.w)); }
    q2n += swap32f(q2n, hi);
    const bool fast = !__any(!(q2n * kbound <= 4096.0f));
    auto run = [&](auto ft) {
    for (int jp = 0; jp < NP; ++jp) {
        const int so = (jp & 1) * (3 * BUFB), sn = 3 * BUFB - so;
        const int j0 = 3 * jp;
        if (j0 + 3 <= T) { *(LAS v4u*)(lds + sn + soff) = kA; *(LAS v4u*)(lds + sn + KBUF + soff) = vA; }
        if (j0 + 4 <= T) { *(LAS v4u*)(lds + sn + BUFB + soff) = kB; *(LAS v4u*)(lds + sn + BUFB + KBUF + soff) = vB; }
        if (j0 + 5 <= T) { *(LAS v4u*)(lds + sn + 2 * BUFB + soff) = kC; *(LAS v4u*)(lds + sn + 2 * BUFB + KBUF + soff) = vC; }
        if (j0 + 6 <= T) { kA = *(const v4u*)(Ksrc + (size_t)(j0 + 6) * 4096); vA = *(const v4u*)(Vsrc + (size_t)(j0 + 6) * 4096); }
        if (j0 + 7 <= T) { kB = *(const v4u*)(Ksrc + (size_t)(j0 + 7) * 4096); vB = *(const v4u*)(Vsrc + (size_t)(j0 + 7) * 4096); }
        if (j0 + 8 <= T) { kC = *(const v4u*)(Ksrc + (size_t)(j0 + 8) * 4096); vC = *(const v4u*)(Vsrc + (size_t)(j0 + 8) * 4096); }
        compute(j0, so, ft);
        if (j0 + 1 <= T) compute(j0 + 1, so + BUFB, ft);
        if (j0 + 2 <= T) compute(j0 + 2, so + 2 * BUFB, ft);
        __syncthreads();
    } };
    if (fast) run(BoolC<true>{}); else run(BoolC<false>{});
    { const float lt = lsum + swap32f(lsum, hi); const float inv = lt > 0.f ? 1.0f / lt : 0.f;
      const size_t rb = (size_t)qrow * 1024 + 64 * h;
      const bf16* gp = P + (size_t)qrow * 768 + 512 + 3 * h;
      const float g0 = 1.0f / (1.0f + __expf(-bf2f(gp[0]))), g1 = inv / (1.0f + __expf(-bf2f(gp[1]))), g2 = 1.0f / (1.0f + __expf(-bf2f(gp[2])));
#pragma unroll
      for (int d = 0; d < 2; ++d)
#pragma unroll
          for (int g4 = 0; g4 < 4; ++g4) { const int dv = 32 * d + 8 * g4 + 4 * hi;
              const v2u wc = *(const v2u*)(Oc + rb + dv), ww = *(const v2u*)(Ow + rb + dv);
              v2u w; w.x = pk2(g0 * bflo(wc.x) + g1 * o[d][4 * g4] + g2 * bflo(ww.x), g0 * bfhi(wc.x) + g1 * o[d][4 * g4 + 1] + g2 * bfhi(ww.x));
              w.y = pk2(g0 * bflo(wc.y) + g1 * o[d][4 * g4 + 2] + g2 * bflo(ww.y), g0 * bfhi(wc.y) + g1 * o[d][4 * g4 + 3] + g2 * bfhi(ww.y));
              *(v2u*)(Ao + rb + dv) = w; } }
}
#ifndef REP
#define REP 0
#endif
#define REPN(bit) (((REP >> (bit)) & 1) ? 2 : 1)
struct Ctx { LAS unsigned char* lds; LAS unsigned* lc; int wave, G, cb; XcdBarrier bar; int ph; };
#define RUN (c.ph >= a.ph_lo && c.ph < a.ph_hi)
#define LANE_ID(K) ((int)__builtin_amdgcn_mbcnt_hi(~0u, __builtin_amdgcn_mbcnt_lo(~0u, (unsigned)(K))) - (K))
#define IDS_(K) const int wave = c.wave; const int lane = LANE_ID(K); const int tid = wave * 64 + lane; (void)lane; (void)tid
#define IDS_T const int tid = threadIdx.x, lane = tid & 63, wave = c.wave; (void)lane; (void)tid
#define IDS_M IDS_(c.ph + 1)
#ifndef MSEL
#define MSEL 31
#endif
#if (MSEL >> 0) & 1
#define IDS0 IDS_M
#else
#define IDS0 IDS_T
#endif
#if (MSEL >> 1) & 1
#define IDS1 IDS_M
#else
#define IDS1 IDS_T
#endif
#if (MSEL >> 2) & 1
#define IDS2 IDS_M
#else
#define IDS2 IDS_T
#endif
#if (MSEL >> 3) & 1
#define IDS3 IDS_M
#else
#define IDS3 IDS_T
#endif
#if (MSEL >> 4) & 1
#define IDS4 IDS_M
#else
#define IDS4 IDS_T
#endif

#define SEAM() do { if (RUN && c.ph + 1 < a.ph_hi) xcd_barrier(c.bar, c.wave * 64 + LANE_ID(c.ph + 77)); ++c.ph; } while (0)
#define CTX_LOCALS LAS unsigned char* lds = c.lds; LAS unsigned* lc = c.lc; const int G = c.G, cb = c.cb; (void)lc; (void)lds; (void)G; (void)cb; \
    const float QS64 = 0.125f * LOG2E, QS96 = 0.10206207261596575f * LOG2E; (void)QS64; (void)QS96; \
    const cs_t* cs64 = WSP(cs_t, WS_CS64); const cs_t* cs32 = WSP(cs_t, WS_CS32); (void)cs64; (void)cs32; \
    bf16* XB = WSP(bf16, WS_XB); bf16* AO = WSP(bf16, WS_AO); bf16* QK = WSP(bf16, WS_QK); bf16* VT = WSP(bf16, WS_VT); bf16* OH = WSP(bf16, WS_OH); bf16* KH = WSP(bf16, WS_KH); (void)KH; bf16* Y16 = WSP(bf16, WS_Y); \
    (void)XB; (void)AO; (void)QK; (void)VT; (void)OH; (void)Y16; unsigned* AMX = WSP(unsigned, WS_CTL) + CW_KMAX; (void)AMX;

template <int LAYER> __device__ __forceinline__ void da_layer(const Args& a, Ctx& c) {
    CTX_LOCALS
    constexpr int j = LAYER / 3; const float lam_init = 0.8f - 0.6f * __expf(-0.3f * (float)LAYER);
    bf16* Wb = WSP(bf16, WS_WDA + (size_t)j * 8 * MiB);
    if (RUN) { IDS0;
        { pg8::Gemm g{XB, Wb, S, 2048, 1024}; pg8::StaticOrder So; So.init(S, 2048, G, cb);
          pg8::EpiRope64 E{QK, 1024, cs64, 32, 4, QS64, 0x7fffffff, 1, 0, 16, KH, S, AMX + (j ? 4 : 0)};
          pg8::gemm_phase<pg8::EpiRope64, pg8::StaticOrder, true, true, 1001>(lds, g, So, E, wave, c.ph + 1000); }
        { pg8::Gemm g{Wb + 2048 * 1024, XB, 1024, S, 1024}; pg8::StaticOrder So; So.init(1024, S, G, cb);
          pg8::EpiVtTiled E{VT, 7, S};
          pg8::gemm_phase<pg8::EpiVtTiled, pg8::StaticOrder, true, true, 1002>(lds, g, So, E, wave, c.ph + 1000); }
    }
    SEAM();
    if (RUN) { IDS0;
        const float lam = da_lambda(a, j, lam_init, lane);
        const float kbound = 2.04f * __builtin_bit_cast(float, xb_ld(AMX + (j ? 4 : 0)));
        const int hp = cb & 7, aa = cb >> 3;
        for (int i_ = 0; i_ < 2 * REPN(1); ++i_) { const int i = i_ & 1; const int qt = (i == 0) ? 63 - aa : aa;
            AttnArgs A; A.Q0 = QK + 64 * (2 * hp); A.Q1 = nullptr; A.ldq = 1024; A.K0 = KH + (size_t)(2 * hp) * S * 64; A.ldk0 = 64; A.K1 = nullptr; A.ldk1 = 0;
            A.Qb = QK + 64 * (2 * hp + 1); A.Kb = KH + (size_t)(2 * hp + 1) * S * 64; A.lam = lam; A.gain = a.in[I_DA_SUBLN] + j * 128; A.gscale = 1.0f - lam_init;
            A.Vt = VT + (size_t)(128 * hp) * S; A.ldv = S; A.O = AO + 128 * hp; A.ldo = 1024; A.window = 0; A.kbound = kbound;
            { BgNone nb_; attn_unit<64, 128, true>(lds, A, qt * 256, tid, lane, wave, nb_); } }
    }
    SEAM();
    if (RUN) { IDS0; pg8::Gemm g{AO, Wb + 3072 * 1024, S, 1024, 1024}; pg8::StaticOrder So; So.init(S, 1024, G, cb); pg8::EpiBf16P E{Y16, 1024, 1.0f};
        pg8::gemm_phase<pg8::EpiBf16P, pg8::StaticOrder, true, true, 1003>(lds, g, So, E, wave, c.ph + 1000); }
    SEAM();
}
__device__ __forceinline__ void mla_layer(const Args& a, Ctx& c) {
    CTX_LOCALS
    bf16* Wb = WSP(bf16, WS_WMLA);
    float* C = WSP(float, WS_MISC + MLA_C); bf16* cqn = WSP(bf16, WS_MISC + MLA_CQN); bf16* ckvn = WSP(bf16, WS_MISC + MLA_CKVN); bf16* Kr = WSP(bf16, WS_MISC + MLA_KR);
    if (RUN) { IDS1; pg8::Gemm g{XB, Wb, S, 512, 1024}; pg8::StaticOrder So; So.init(S, 512, G, cb); pg8::EpiF32 E{C, 512, AMX + 1};
        pg8::gemm_phase<pg8::EpiF32, pg8::StaticOrder, true, true, 1004>(lds, g, So, E, wave, c.ph + 1000); }
    SEAM();
    if (RUN) { IDS1; phase_mla_norm(a, tid, lane, wave); }
    SEAM();
    if (RUN) { IDS1;
        { pg8::Gemm g{cqn, Wb + 1 * MiB / 2, S, 1024, 256}; pg8::StaticOrder So; So.init(S, 1024, G, cb);
          pg8::EpiBf16P E{QK, 1536, QS96};
          pg8::gemm_phase<pg8::EpiBf16P, pg8::StaticOrder, true, true, 1901>(lds, g, So, E, wave, c.ph + 1000); }
        { pg8::Gemm g{cqn, Wb + 1 * MiB / 2 + 1024 * 256, S, 512, 256}; pg8::StaticOrder So; So.init(S, 512, G, (cb + 128) & 255);
          pg8::EpiRope16 E{QK + 1024, 1536, cs32, QS96};
          pg8::gemm_phase<pg8::EpiRope16, pg8::StaticOrder, true, true, 1902>(lds, g, So, E, wave, c.ph + 1000); }
        { pg8::Gemm g{ckvn, Wb + 2 * MiB / 2, S, 1024, 128}; pg8::StaticOrder So; So.init(S, 1024, G, cb);
          pg8::EpiHeadMajor64 E{KH, S, AMX + 1};
          pg8::gemm_phase<pg8::EpiHeadMajor64, pg8::StaticOrder, true, true, 1006>(lds, g, So, E, wave, c.ph + 1000); }
        { pg8::Gemm g{Wb + 2 * MiB / 2 + 1024 * 128, ckvn, 1024, S, 128}; pg8::StaticOrder So; So.init(1024, S, G, (cb + 128) & 255);
          pg8::EpiVtTiled E{VT, 6, S};
          pg8::gemm_phase<pg8::EpiVtTiled, pg8::StaticOrder, true, true, 1007>(lds, g, So, E, wave, c.ph + 1000); }
    }
    SEAM();
    if (RUN) { IDS1;
        const int hh = cb & 15, aa = cb >> 4;
        const float kbound = 3.06f * __builtin_bit_cast(float, xb_ld(AMX + 1));
        BgConv bg; bg.init(&a.jobs[18], 3, cb * NWAVES + wave, G * NWAVES, lane, 3, lds + 49152 + wave * 9216);
        for (int i_ = 0; i_ < 4 * REPN(2); ++i_) { const int i = i_ & 3; const int qt = (i == 0) ? 63 - aa : (i == 1) ? aa : (i == 2) ? 47 - aa : 16 + aa;
            AttnArgs A; A.Q0 = QK + 64 * hh; A.Q1 = QK + 1024 + 32 * hh; A.ldq = 1536; A.K0 = KH + (size_t)hh * S * 64; A.ldk0 = 64; A.K1 = Kr; A.ldk1 = 32;
            A.Vt = VT + (size_t)(64 * hh) * S; A.ldv = S; A.O = AO + 64 * hh; A.ldo = 1024; A.window = 0; A.Qb = nullptr; A.Kb = nullptr; A.lam = 0.f; A.gain = nullptr; A.gscale = 0.f; A.kbound = kbound;
            attn_unit<96, 64, false, BgConv>(lds, A, qt * 256, tid, lane, wave, bg); }
        bg.drain();
    }
    SEAM();
    if (RUN) { IDS1; pg8::Gemm g{AO, Wb + 3 * MiB / 2, S, 1024, 1024}; pg8::StaticOrder So; So.init(S, 1024, G, cb); pg8::EpiBf16P E{Y16, 1024, 1.0f};
        pg8::gemm_phase<pg8::EpiBf16P, pg8::StaticOrder, true, true, 1008>(lds, g, So, E, wave, c.ph + 1000); }
    SEAM();
}
__device__ __forceinline__ void nsa_layer(const Args& a, Ctx& c) {
    CTX_LOCALS
    bf16* Wb = WSP(bf16, WS_WNSA);
    bf16* P = WSP(bf16, WS_MISC + NSA_P); bf16* ACK = WSP(bf16, WS_MISC + NSA_ACK); bf16* ACV = WSP(bf16, WS_MISC + NSA_ACV);
    bf16* HK = WSP(bf16, WS_MISC + NSA_HK); bf16* HV = WSP(bf16, WS_MISC + NSA_HV); bf16* KC = WSP(bf16, WS_MISC + NSA_KC); bf16* VCT = WSP(bf16, WS_MISC + NSA_VCT);
    if (RUN) { IDS2;
        { pg8::Gemm g{XB, Wb, S, 1536, 1024}; pg8::StaticOrder So; So.init(S, 1536, G, cb);
          pg8::EpiRope64 E{QK, 1024, cs64, 24, 4, QS64, 0x7fffffff, 1, 0, 16, KH, S, AMX + 2};
          pg8::gemm_phase<pg8::EpiRope64, pg8::StaticOrder, true, true, 1009>(lds, g, So, E, wave, c.ph + 1000); }
        { pg8::Gemm g{XB, Wb + 1536 * 1024, S, 768, 1024}; pg8::StaticOrder So; So.init(S, 768, G, (cb + 128) & 255);
          pg8::EpiBf16P E{P, 768, 1.0f};
          pg8::gemm_phase<pg8::EpiBf16P, pg8::StaticOrder, true, true, 1010>(lds, g, So, E, wave, c.ph + 1000); }
        { pg8::Gemm g{Wb + 2304 * 1024, XB, 512, S, 1024}; pg8::StaticOrder So; So.init(512, S, G, (cb + 192) & 255);
          pg8::EpiVtTiled E{VT, 6, S};
          pg8::gemm_phase<pg8::EpiVtTiled, pg8::StaticOrder, true, true, 1011>(lds, g, So, E, wave, c.ph + 1000); }
    }
    SEAM();
    if (RUN) { IDS2; phase_nsa_cmp_gather(a, tid); }
    SEAM();
    if (RUN) { IDS2;
        { pg8::Gemm g{ACK, Wb + 6 * MiB / 2, 4096, 256, 2048}; pg8::StaticOrder So; So.init(4096, 256, G, cb); pg8::EpiGeluBf16 E{HK, 256};
          pg8::gemm_phase<pg8::EpiGeluBf16, pg8::StaticOrder, true, true, 1012>(lds, g, So, E, wave, c.ph + 1000); }
        { pg8::Gemm g{ACV, Wb + 7 * MiB / 2, 4096, 256, 2048}; pg8::StaticOrder So; So.init(4096, 256, G, (cb + 240) & 255); pg8::EpiGeluBf16 E{HV, 256};
          pg8::gemm_phase<pg8::EpiGeluBf16, pg8::StaticOrder, true, true, 1013>(lds, g, So, E, wave, c.ph + 1000); }
        if (cb >= 32) {
        for (int idx = cb - 32; idx < 1024 * REPN(6); idx += 224) { const int qt = (idx & 1023) >> 4, hh = idx & 15;
            AttnArgs A; A.Q0 = QK + 64 * hh; A.Q1 = nullptr; A.ldq = 1024; A.K0 = KH + (size_t)(4 + (hh >> 2)) * S * 64; A.ldk0 = 64; A.K1 = nullptr; A.ldk1 = 0;
            A.Vt = VT + (size_t)(256 + 64 * (hh >> 2)) * S; A.ldv = S; A.O = OH + (size_t)S * 1024 + 64 * hh; A.ldo = 1024; A.window = 512; A.Qb = nullptr; A.Kb = nullptr; A.lam = 0.f; A.gain = nullptr; A.gscale = 0.f; A.kbound = 2.04f * __builtin_bit_cast(float, xb_ld(AMX + 2));
            { BgNone nb_; attn_unit<64, 64>(lds, A, qt * 256, tid, lane, wave, nb_); } }
        }
    }
    SEAM();
    if (RUN) { IDS2;
        { pg8::Gemm g{HK, Wb + 8 * MiB / 2, 4096, 256, 256}; pg8::StaticOrder So; So.init(4096, 256, G, cb);
          pg8::EpiRope64 E{KC, 64, cs64, 1, 0, 1.0f, 1023, 16, 31, 1 << 30, nullptr, 0, AMX + 3};
          pg8::gemm_phase<pg8::EpiRope64, pg8::StaticOrder, true, true, 1014>(lds, g, So, E, wave, c.ph + 1000); }
        { pg8::Gemm g{Wb + 8 * MiB / 2 + 65536, HV, 256, 4096, 256}; pg8::StaticOrder So; So.init(256, 4096, G, (cb + 240) & 255);
          pg8::EpiBf16P E{VCT, 4096, 1.0f};
          pg8::gemm_phase<pg8::EpiBf16P, pg8::StaticOrder, true, true, 1015>(lds, g, So, E, wave, c.ph + 1000); }
    }
    SEAM();
    if (RUN) { IDS2;
        const float kb_sel = 2.04f * __builtin_bit_cast(float, xb_ld(AMX + 2)), kb_cmp = 2.04f * __builtin_bit_cast(float, xb_ld(AMX + 3)); (void)kb_cmp;
        for (int i_ = 0; i_ < 4 * REPN(3); ++i_) { const int i = i_ & 3; const int idx = i * 256 + cb, gg = idx & 3, aa = cb >> 2;
            const int T = (i == 0) ? 255 - aa : (i == 1) ? aa : (i == 2) ? 191 - aa : 64 + aa;
            nsa_cmp_unit(lds, a, T, gg, tid, lane, wave, kb_cmp);
            asm volatile("s_waitcnt vmcnt(0)" ::: "memory"); __syncthreads();
            nsa_sel_unit(lds, a, T, gg, tid, lane, wave, kb_sel);
            __syncthreads(); }
    }
    SEAM();
    if (RUN) { IDS2; pg8::Gemm g{AO, Wb + 9 * MiB / 2, S, 1024, 1024}; pg8::StaticOrder So; So.init(S, 1024, G, cb); pg8::EpiBf16P E{Y16, 1024, 1.0f};
        pg8::gemm_phase<pg8::EpiBf16P, pg8::StaticOrder, true, true, 1016>(lds, g, So, E, wave, c.ph + 1000); }
    SEAM();
}
template <int LAYER> __device__ __forceinline__ void moe_layer(const Args& a, Ctx& c) {
    CTX_LOCALS
    bf16* Wm = WSP(bf16, WS_WMOE + (size_t)LAYER * 192 * MiB);
    bf16* Act = WSP(bf16, WS_ACT); bf16* Ys = WSP(bf16, WS_YS);
    if (RUN) { IDS3; phase_ln1_router(a, lds, LAYER, tid, lane, wave); }
    SEAM();
    if (RUN) { IDS3; phase_place(a, lds, LAYER, tid, lane, wave); }
    SEAM();
    if (RUN) { IDS3;
        const int ntl = (int)lc[LC_NT], xcd = cb & 7, t0 = (ntl * xcd) >> 3, t1 = (ntl * (xcd + 1)) >> 3;
        { const v4u* src = (const v4u*)(WSP(unsigned short, WS_ROUTE + 2 * MiB) + (size_t)t0 * 256); LAS v4u* dst = (LAS v4u*)(lds + LDS_GIDX_OFF);
          for (int q = tid; q < (t1 - t0) * 32; q += NTHREADS) dst[q] = src[q]; }
        __syncthreads();
        pg8::MoeOrder So{8, G, cb, ntl, (const LAS int*)(lc + LC_TILEE), REPN(5)};
        {
        pg8::Gemm g{WSP(bf16, WS_AS), Wm, MOE_ROWS, 32 * 2048, 512, (const LAS unsigned short*)(lds + LDS_GIDX_OFF), t0};
        pg8::EpiSwiglu E{Act, a.in[I_MOE_BGU] + (size_t)LAYER * 32 * 2048, 1.0f / 64.0f, (unsigned char*)Act};
        pg8::gemm_phase<pg8::EpiSwiglu, pg8::MoeOrder, true, true, 1702, true, true, false, 1>(lds, g, So, E, wave, c.ph + 1000); } }
    SEAM();
    if (RUN) { IDS3; pg8::MoeOrder So{4, G, cb, (int)lc[LC_NT], (const LAS int*)(lc + LC_TILEE), REPN(5)};
        {
        pg8::Gemm g{Act, Wm + 64 * MiB, MOE_ROWS, 32 * 1024, 512};
        pg8::EpiDown E{Ys, a.in[I_MOE_BDN] + (size_t)LAYER * 32 * 1024, WSP(float, WS_ROUTE + 786432), (unsigned char*)Ys, 1.0f / 64.0f};
        pg8::gemm_phase<pg8::EpiDown, pg8::MoeOrder, true, true, 1019, false, true, false, 1>(lds, g, So, E, wave, c.ph + 1000); } }
    SEAM();
    if (RUN) { IDS3; phase_ln2(a, LAYER, LAYER == NLAYER - 1 ? a.out : nullptr, tid, lane, wave); }
    SEAM();
}

__global__ void __launch_bounds__(NTHREADS, 2) fwd_kernel(Args a) {
    extern __shared__ __attribute__((aligned(16))) unsigned char lds_raw[];
    Ctx c;
    c.lds = (LAS unsigned char*)lds_raw;
    { const int tid0 = threadIdx.x;
      c.wave = __builtin_amdgcn_readfirstlane(tid0 >> 6);
      c.G = gridDim.x; c.cb = blockIdx.x;
      c.lc = (LAS unsigned*)(c.lds + LDSCTL_OFF);
      for (int u = tid0; u < (LDS_BYTES - LDSCTL_OFF) / 4; u += NTHREADS) c.lc[u] = 0u;
      __syncthreads();
      c.bar = xcd_barrier_post(WSP(unsigned, WS_CTL) + CW_BAR, (volatile LAS unsigned*)c.lc, tid0); }
    c.ph = 0;
    if (RUN) { IDS4; for (int rep = 0; rep < REPN(0); ++rep) phase_prologue(a, c.lds, tid, lane, wave); }
    SEAM();
    da_layer<0>(a, c);  moe_layer<0>(a, c);
    mla_layer(a, c);    moe_layer<1>(a, c);
    nsa_layer(a, c);    moe_layer<2>(a, c);
    da_layer<3>(a, c);  moe_layer<3>(a, c);
}

static int add_job(Args& a, const float* src, bf16* dst, long long sbs, long long dbs, int ld, int K, int ncols, int col0, int mode, int nbatch, int f8 = 0) {
    Job& J = a.jobs[a.njobs]; J.src = src; J.dst = dst; J.sbs = sbs; J.dbs = dbs; J.ld = ld; J.K = K; J.ncols = ncols; J.col0 = col0; J.mode = mode; J.nbatch = nbatch; J.item0 = a.nitems; J.pad = f8;
    a.nitems += nbatch * (K / (f8 ? 128 : 64)) * ((ncols + 63) / 64); return a.njobs++;
}
extern "C" void kernel_launch(void* const* d_in, const int* in_sizes, int n_in, void* d_out, int out_size, void* d_ws, size_t ws_size, hipStream_t stream) {
    static int grid = 0;
    if (grid == 0) {
        if (n_in != N_IN || out_size != S * D || ws_size < WS_END) { fprintf(stderr, "kernel_launch: unexpected shapes: n_in %d out %d ws %zu (need %zu)\n", n_in, out_size, ws_size, (size_t)WS_END); grid = -1; return; }
        int dev = 0, cus = 0, per_cu = 0;
        hipGetDevice(&dev); hipDeviceGetAttribute(&cus, hipDeviceAttributeMultiprocessorCount, dev);
        if (hipFuncSetAttribute((const void*)fwd_kernel, hipFuncAttributeMaxDynamicSharedMemorySize, LDS_BYTES) != hipSuccess) { fprintf(stderr, "kernel_launch: hipFuncSetAttribute failed\n"); grid = -1; return; }
        hipOccupancyMaxActiveBlocksPerMultiprocessor(&per_cu, (const void*)fwd_kernel, NTHREADS, LDS_BYTES);
        (void)hipGetLastError();
        if (per_cu < 1 || cus < 256) { fprintf(stderr, "kernel_launch: occupancy %d, CUs %d: this kernel needs 256 resident workgroups\n", per_cu, cus); grid = -1; return; }
        grid = 256;
    }
    if (grid < 0) return;
    hipMemsetAsync((char*)d_ws + WS_CTL, 0, CTL_ZERO_BYTES, stream);
    Args a; memset(&a, 0, sizeof(a));
    for (int i = 0; i < N_IN; ++i) a.in[i] = (const float*)d_in[i];
    a.out = (float*)d_out; a.ws = (unsigned char*)d_ws;
    unsigned char* ws = (unsigned char*)d_ws;
    const long long KK = 1024;
    for (int j = 0; j < 2; ++j) {
        bf16* Wb = (bf16*)(ws + WS_WDA + (size_t)j * 8 * MiB);
        add_job(a, a.in[I_DA_WIN] + (size_t)j * 1024 * 3072, Wb, 0, 0, 3072, 1024, 2048, 0, CM_ROPE64, 1);
        add_job(a, a.in[I_DA_WIN] + (size_t)j * 1024 * 3072, Wb + 2048 * 1024, 0, 0, 3072, 1024, 1024, 2048, CM_IDENT, 1);
        add_job(a, a.in[I_DA_WOUT] + (size_t)j * 1024 * 1024, Wb + 3072 * 1024, 0, 0, 1024, 1024, 1024, 0, CM_IDENT, 1);
    }
    { bf16* Wb = (bf16*)(ws + WS_WMLA);
      add_job(a, a.in[I_MLA_WIN], Wb, 0, 0, 416, 1024, 416, 0, CM_IDENT, 1);
      add_job(a, a.in[I_MLA_WUQ], Wb + 1 * MiB / 2, 0, 0, 1536, 256, 1536, 0, CM_MLAQ, 1);
      add_job(a, a.in[I_MLA_WUKV], Wb + 2 * MiB / 2, 0, 0, 2048, 128, 2048, 0, CM_MLAKV, 1);
      add_job(a, a.in[I_MLA_WOUT], Wb + 3 * MiB / 2, 0, 0, 1024, 1024, 1024, 0, CM_IDENT, 1); }
    { bf16* Wb = (bf16*)(ws + WS_WNSA);
      add_job(a, a.in[I_NSA_WIN], Wb, 0, 0, 2608, 1024, 2608, 0, CM_NSAIN, 1);
      add_job(a, a.in[I_NSA_KW1], Wb + 6 * MiB / 2, 0, 0, 256, 2048, 256, 0, CM_IDENT, 1);
      add_job(a, a.in[I_NSA_VW1], Wb + 7 * MiB / 2, 0, 0, 256, 2048, 256, 0, CM_IDENT, 1);
      add_job(a, a.in[I_NSA_KW2], Wb + 8 * MiB / 2, 0, 0, 64, 256, 64, 0, CM_ROPE64, 1);
      add_job(a, a.in[I_NSA_VW2], Wb + 8 * MiB / 2 + 65536, 0, 0, 64, 256, 64, 0, CM_IDENT, 1);
      add_job(a, a.in[I_NSA_WOUT], Wb + 9 * MiB / 2, 0, 0, 1024, 1024, 1024, 0, CM_IDENT, 1); }
    for (int L = 0; L < NLAYER; ++L) {
        bf16* Wm = (bf16*)(ws + WS_WMOE + (size_t)L * 192 * MiB);
        add_job(a, a.in[I_MOE_WGU] + (size_t)L * 32 * KK * 2048, Wm, KK * 2048, 2048 * KK, 2048, 1024, 2048, 0, CM_SWIGLU, 32, 2);
        add_job(a, a.in[I_MOE_WDN] + (size_t)L * 32 * KK * 1024, Wm + 64 * MiB, KK * 1024, 1024 * KK, 1024, 1024, 1024, 0, CM_IDENT, 32, 2);
    }
    a.nitems = a.jobs[18].item0;
    a.ph_lo = 0; a.ph_hi = 1 << 20;
    hipLaunchKernelGGL(fwd_kernel, dim3(grid), dim3(NTHREADS), LDS_BYTES, stream, a);
    const hipError_t le = hipPeekAtLastError();
    if (le != hipSuccess) fprintf(stderr, "kernel_launch: launch failed: %s\n", hipGetErrorName(le));
}
```
